# Optimizing an MI355X kernel written in HIP

```python
import math
import jax, jax.numpy as jnp
from jax import lax
import numpy as np

D_MODEL = 1024
BATCH = 2
SEQ = 8192
DEPTH = 2

HEAD_DIM = 64
SB_HEADS = 8
SB_WIDTH = SB_HEADS * HEAD_DIM
SB_BLOCK = 128
LRU_WIDTH = 512
LRU_BLOCKS = 8
LRU_BLOCK_DIM = LRU_WIDTH // LRU_BLOCKS
LRU_C = 8.0
CONV_WIDTH = 4
AB_IN_WIDTH = 3 * SB_WIDTH + 2 * LRU_WIDTH
AB_MIX_WIDTH = SB_WIDTH + LRU_WIDTH
SWA_HEADS = 16
SWA_KV_HEADS = 4
SWA_GROUP = SWA_HEADS // SWA_KV_HEADS
SWA_WINDOW = 128
C_IN_WIDTH = (SWA_HEADS + 2 * SWA_KV_HEADS) * HEAD_DIM
C_MIX_WIDTH = SWA_HEADS * HEAD_DIM
ROPE_THETA = 10000.0
N_EXPERTS = 16
N_GROUPS = 4
GROUP_SIZE = N_EXPERTS // N_GROUPS
TOP_K = 2
D_FF = 512
PLE_DIM = 256
N_EVEN = (DEPTH + 1) // 2
N_ODD = DEPTH // 2
DEEPNORM_ALPHA = (2 * DEPTH) ** 0.25
DEEPNORM_BETA = (8 * DEPTH) ** -0.25
LN_EPS = 1e-5

kernel_name = "hybrid_sb_lru_swa_grouped_moe_deepnorm"


def layer_norm(x, g, b):
    xf = x.astype(jnp.float32)
    mu = jnp.mean(xf, axis=-1, keepdims=True)
    var = jnp.mean(jnp.square(xf - mu), axis=-1, keepdims=True)
    y = (xf - mu) * lax.rsqrt(var + LN_EPS) * g.astype(jnp.float32) + b.astype(jnp.float32)
    return y.astype(x.dtype)


def stick_breaking_attention(q, k, v):
    b, s = q.shape[0], q.shape[1]
    n_blk = s // SB_BLOCK
    qb = (q * (HEAD_DIM ** -0.5)).reshape(b, n_blk, SB_BLOCK, SB_HEADS, HEAD_DIM).transpose(1, 0, 3, 2, 4)
    kh = k.transpose(0, 2, 1, 3)
    vh = v.transpose(0, 2, 1, 3)
    key_idx = jnp.arange(s)

    def one_block(args):
        q_blk, blk = args
        z = jnp.einsum('bhqd,bhkd->bhqk', q_blk, kh, preferred_element_type=jnp.float32)
        q_idx = blk * SB_BLOCK + jnp.arange(SB_BLOCK)
        causal = key_idx[None, :] < q_idx[:, None]
        log_keep = jnp.where(causal, -jax.nn.softplus(z), 0.0)
        after = lax.cumsum(log_keep, axis=3, reverse=True) - log_keep
        w = jnp.where(causal, jnp.exp(jax.nn.log_sigmoid(z) + after), 0.0)
        return jnp.einsum('bhqk,bhkd->bqhd', w.astype(vh.dtype), vh)

    out = lax.map(one_block, (qb, jnp.arange(n_blk)))
    return out.transpose(1, 0, 2, 3, 4).reshape(b, s, SB_WIDTH)


def causal_depthwise_conv(x, w, bias):
    y = lax.conv_general_dilated(
        x, w[:, None, :].astype(x.dtype), window_strides=(1,),
        padding=[(CONV_WIDTH - 1, 0)], dimension_numbers=('NWC', 'WIO', 'NWC'),
        feature_group_count=x.shape[-1])
    return y + bias.astype(x.dtype)


def rg_lru(x, w_r, b_r, w_i, b_i, lam):
    b, s, _ = x.shape
    xb = x.reshape(b, s, LRU_BLOCKS, LRU_BLOCK_DIM)
    gate_r = jnp.einsum('bsnc,ncd->bsnd', xb, w_r).reshape(b, s, LRU_WIDTH) + b_r
    gate_i = jnp.einsum('bsnc,ncd->bsnd', xb, w_i).reshape(b, s, LRU_WIDTH) + b_i
    r = jax.nn.sigmoid(gate_r.astype(jnp.float32))
    i = jax.nn.sigmoid(gate_i.astype(jnp.float32))
    log_a = -LRU_C * r * jax.nn.softplus(-lam.astype(jnp.float32))
    a = jnp.exp(log_a)
    u = jnp.sqrt(-jnp.expm1(2.0 * log_a)) * (i * x.astype(jnp.float32))

    def combine(left, right):
        a_l, u_l = left
        a_r, u_r = right
        return a_l * a_r, a_r * u_l + u_r

    _, h = lax.associative_scan(combine, (a, u), axis=1)
    return h.astype(x.dtype)


def mixer_sb_lru(x, w_in, w_out, conv_w, conv_b, w_r, b_r, w_i, b_i, lam):
    b, s, _ = x.shape
    proj = x @ w_in
    q, k, v, xr, gr = jnp.split(
        proj, [SB_WIDTH, 2 * SB_WIDTH, 3 * SB_WIDTH, 3 * SB_WIDTH + LRU_WIDTH], axis=-1)
    heads = lambda t: t.reshape(b, s, SB_HEADS, HEAD_DIM)
    y_sb = stick_breaking_attention(heads(q), heads(k), heads(v))
    h = rg_lru(causal_depthwise_conv(xr, conv_w, conv_b), w_r, b_r, w_i, b_i, lam)
    y_lru = jax.nn.gelu(gr) * h
    return jnp.concatenate([y_sb, y_lru], axis=-1) @ w_out


def rope(x, positions):
    half = HEAD_DIM // 2
    inv_freq = ROPE_THETA ** (-jnp.arange(half, dtype=jnp.float32) / half)
    ang = positions.astype(jnp.float32)[..., None] * inv_freq
    cos = jnp.cos(ang)[:, :, None, :]
    sin = jnp.sin(ang)[:, :, None, :]
    x1 = x[..., :half].astype(jnp.float32)
    x2 = x[..., half:].astype(jnp.float32)
    return jnp.concatenate([x1 * cos - x2 * sin, x2 * cos + x1 * sin], axis=-1).astype(x.dtype)


def sliding_window_attention_with_sinks(q, k, v, sinks):
    b, s = q.shape[0], q.shape[1]
    n_blk = s // SWA_WINDOW
    qb = q.reshape(b, n_blk, SWA_WINDOW, SWA_KV_HEADS, SWA_GROUP, HEAD_DIM)

    def with_prev(t):
        tb = t.reshape(b, n_blk, SWA_WINDOW, SWA_KV_HEADS, HEAD_DIM)
        prev = jnp.pad(tb[:, :-1], ((0, 0), (1, 0), (0, 0), (0, 0), (0, 0)))
        return jnp.concatenate([prev, tb], axis=2)

    kk, vv = with_prev(k), with_prev(v)
    scores = jnp.einsum('bnqkgd,bnskd->bnkgqs', qb, kk,
                        preferred_element_type=jnp.float32) * (HEAD_DIM ** -0.5)
    qi = jnp.arange(SWA_WINDOW)[:, None] + SWA_WINDOW
    si = jnp.arange(2 * SWA_WINDOW)[None, :]
    dist = qi - si
    band = (dist >= 0) & (dist < SWA_WINDOW)
    not_pad = (jnp.arange(n_blk)[:, None, None] > 0) | (si[None] >= SWA_WINDOW)
    mask = band[None] & not_pad
    scores = jnp.where(mask[None, :, None, None], scores, -jnp.inf)
    sink = jnp.broadcast_to(
        sinks.astype(jnp.float32).reshape(SWA_KV_HEADS, SWA_GROUP)[None, None, :, :, None, None],
        scores.shape[:-1] + (1,))
    probs = jax.nn.softmax(jnp.concatenate([scores, sink], axis=-1), axis=-1)[..., :-1]
    out = jnp.einsum('bnkgqs,bnskd->bnqkgd', probs.astype(vv.dtype), vv)
    return out.reshape(b, s, C_MIX_WIDTH)


def mixer_swa(x, positions, w_qkv, w_out, sinks):
    b, s, _ = x.shape
    proj = x @ w_qkv
    q, k, v = jnp.split(proj, [SWA_HEADS * HEAD_DIM, (SWA_HEADS + SWA_KV_HEADS) * HEAD_DIM], axis=-1)
    q = rope(q.reshape(b, s, SWA_HEADS, HEAD_DIM), positions)
    k = rope(k.reshape(b, s, SWA_KV_HEADS, HEAD_DIM), positions)
    v = v.reshape(b, s, SWA_KV_HEADS, HEAD_DIM)
    return sliding_window_attention_with_sinks(q, k, v, sinks) @ w_out


def grouped_moe(x, w_router, b_router, w_gate, w_up, w_down):
    logits = jnp.einsum('bsd,de->bse', x, w_router,
                        preferred_element_type=jnp.float32) + b_router.astype(jnp.float32)
    probs = jax.nn.softmax(logits, axis=-1)
    grouped = probs.reshape(probs.shape[:-1] + (N_GROUPS, GROUP_SIZE))
    group_score = jnp.sum(lax.top_k(grouped, TOP_K)[0], axis=-1)
    g_sel = jnp.argmax(group_score, axis=-1)
    in_group = jnp.take_along_axis(grouped, g_sel[..., None, None], axis=-2)[..., 0, :]
    top_w, top_i = lax.top_k(in_group, TOP_K)
    top_w = top_w / jnp.sum(top_w, axis=-1, keepdims=True)
    expert_idx = g_sel[..., None] * GROUP_SIZE + top_i
    gates = jnp.sum(jax.nn.one_hot(expert_idx, N_EXPERTS, dtype=jnp.float32) * top_w[..., None], axis=-2)
    hidden = jax.nn.silu(jnp.einsum('bsd,edf->bsef', x, w_gate)) * jnp.einsum('bsd,edf->bsef', x, w_up)
    hidden = hidden * gates[..., None].astype(hidden.dtype)
    return jnp.einsum('bsef,efd->bsd', hidden, w_down).astype(x.dtype)


def per_layer_embedding(x, p_i, w_proj, w_gate, b_gate):
    gate = jax.nn.sigmoid(x @ w_gate + b_gate)
    return x + gate * (p_i @ w_proj)


def setup_inputs(seed: int = 0) -> dict:
    key = jax.random.key(seed)
    ks = jax.random.split(key, 28)

    def nrm(k, shape, scale):
        return jax.random.normal(k, shape, jnp.float32) * scale

    x = nrm(ks[0], (BATCH, SEQ, D_MODEL), 1.0)
    p = nrm(ks[1], (DEPTH, BATCH, SEQ, PLE_DIM), 1.0)
    positions = (jnp.arange(SEQ, dtype=jnp.int32)[None, :]
                 + jax.random.randint(ks[2], (BATCH, 1), 0, 1024, dtype=jnp.int32))
    w_in_ab = nrm(ks[3], (N_EVEN, D_MODEL, AB_IN_WIDTH), D_MODEL ** -0.5)
    w_out_ab = nrm(ks[4], (N_EVEN, AB_MIX_WIDTH, D_MODEL), DEEPNORM_BETA * AB_MIX_WIDTH ** -0.5)
    conv_w = nrm(ks[5], (N_EVEN, CONV_WIDTH, LRU_WIDTH), CONV_WIDTH ** -0.5)
    conv_b = nrm(ks[6], (N_EVEN, LRU_WIDTH), 0.01)
    lru_w_r = nrm(ks[7], (N_EVEN, LRU_BLOCKS, LRU_BLOCK_DIM, LRU_BLOCK_DIM), LRU_BLOCK_DIM ** -0.5)
    lru_b_r = nrm(ks[8], (N_EVEN, LRU_WIDTH), 0.01)
    lru_w_i = nrm(ks[9], (N_EVEN, LRU_BLOCKS, LRU_BLOCK_DIM, LRU_BLOCK_DIM), LRU_BLOCK_DIM ** -0.5)
    lru_b_i = nrm(ks[10], (N_EVEN, LRU_WIDTH), 0.01)
    a_c = jax.random.uniform(ks[11], (N_EVEN, LRU_WIDTH), jnp.float32, 0.9, 0.999)
    a0 = a_c ** (1.0 / LRU_C)
    lru_lambda = jnp.log(a0) - jnp.log1p(-a0)
    w_qkv_c = nrm(ks[12], (N_ODD, D_MODEL, C_IN_WIDTH), D_MODEL ** -0.5)
    w_out_c = nrm(ks[13], (N_ODD, C_MIX_WIDTH, D_MODEL), DEEPNORM_BETA * C_MIX_WIDTH ** -0.5)
    sinks_c = nrm(ks[14], (N_ODD, SWA_HEADS), 0.5)
    ln_mix_g = 1.0 + nrm(ks[15], (DEPTH, D_MODEL), 0.01)
    ln_mix_b = nrm(ks[16], (DEPTH, D_MODEL), 0.01)
    ln_ffn_g = 1.0 + nrm(ks[17], (DEPTH, D_MODEL), 0.01)
    ln_ffn_b = nrm(ks[18], (DEPTH, D_MODEL), 0.01)
    w_router = nrm(ks[19], (D_MODEL, N_EXPERTS), D_MODEL ** -0.5)
    b_router = nrm(ks[20], (N_EXPERTS,), 0.01)
    exp_w_gate = nrm(ks[21], (DEPTH, N_EXPERTS, D_MODEL, D_FF), D_MODEL ** -0.5)
    exp_w_up = nrm(ks[22], (DEPTH, N_EXPERTS, D_MODEL, D_FF), D_MODEL ** -0.5)
    exp_w_down = nrm(ks[23], (DEPTH, N_EXPERTS, D_FF, D_MODEL), DEEPNORM_BETA * D_FF ** -0.5)
    ple_w_proj = nrm(ks[24], (DEPTH, PLE_DIM, D_MODEL), PLE_DIM ** -0.5)
    ple_w_gate = nrm(ks[25], (DEPTH, D_MODEL, D_MODEL), D_MODEL ** -0.5)
    ple_b_gate = nrm(ks[26], (DEPTH, D_MODEL), 0.01)
    return {
        'x': x, 'p': p, 'positions': positions,
        'w_in_ab': w_in_ab, 'w_out_ab': w_out_ab, 'conv_w': conv_w, 'conv_b': conv_b,
        'lru_w_r': lru_w_r, 'lru_b_r': lru_b_r, 'lru_w_i': lru_w_i, 'lru_b_i': lru_b_i,
        'lru_lambda': lru_lambda,
        'w_qkv_c': w_qkv_c, 'w_out_c': w_out_c, 'sinks_c': sinks_c,
        'ln_mix_g': ln_mix_g, 'ln_mix_b': ln_mix_b, 'ln_ffn_g': ln_ffn_g, 'ln_ffn_b': ln_ffn_b,
        'w_router': w_router, 'b_router': b_router,
        'exp_w_gate': exp_w_gate, 'exp_w_up': exp_w_up, 'exp_w_down': exp_w_down,
        'ple_w_proj': ple_w_proj, 'ple_w_gate': ple_w_gate, 'ple_b_gate': ple_b_gate,
    }


def reference(x, p, positions, w_in_ab, w_out_ab, conv_w, conv_b, lru_w_r, lru_b_r, lru_w_i,
              lru_b_i, lru_lambda, w_qkv_c, w_out_c, sinks_c, ln_mix_g, ln_mix_b, ln_ffn_g,
              ln_ffn_b, w_router, b_router, exp_w_gate, exp_w_up, exp_w_down, ple_w_proj,
              ple_w_gate, ple_b_gate):
    for i in range(DEPTH):
        j = i // 2
        if i % 2 == 0:
            h = mixer_sb_lru(x, w_in_ab[j], w_out_ab[j], conv_w[j], conv_b[j], lru_w_r[j],
                             lru_b_r[j], lru_w_i[j], lru_b_i[j], lru_lambda[j])
        else:
            h = mixer_swa(x, positions, w_qkv_c[j], w_out_c[j], sinks_c[j])
        x = layer_norm(DEEPNORM_ALPHA * x + h, ln_mix_g[i], ln_mix_b[i])
        m = grouped_moe(x, w_router, b_router, exp_w_gate[i], exp_w_up[i], exp_w_down[i])
        x = layer_norm(DEEPNORM_ALPHA * x + m, ln_ffn_g[i], ln_ffn_b[i])
        x = per_layer_embedding(x, p[i], ple_w_proj[i], ple_w_gate[i], ple_b_gate[i])
    return x
```

```cpp
#include <hip/hip_runtime.h>
#include <cstdint>
#include <cstdio>

namespace {
constexpr int D_MODEL = 1024, BATCH = 2, SEQ = 8192, NTOK = BATCH * SEQ;
constexpr int AB_IN = 2560, C_IN = 1536;
constexpr int N_EXP = 16, D_FF = 512, PLE_DIM = 256;
constexpr float ALPHA = 1.4142135623730951f;
constexpr float LN_EPS = 1e-5f;

__device__ __forceinline__ float softplusf(float z) { return fmaxf(z, 0.f) + log1pf(expf(-fabsf(z))); }
__device__ __forceinline__ float sigmoidf_(float z) { return 1.f / (1.f + expf(-z)); }
__device__ __forceinline__ float wave_sum(float v) {
#pragma unroll
    for (int o = 1; o < 64; o <<= 1) v += __shfl_xor(v, o);
    return v;
}

__global__ void __launch_bounds__(256) k_gemm_f32(const float* __restrict__ A, int lda, const float* __restrict__ B, int ldb,
                                                  float* __restrict__ C, int ldc, int K) {
    __shared__ float As[16][68];
    __shared__ float Bs[16][68];
    const int tid = threadIdx.x, tx = tid & 15, ty = tid >> 4;
    const int m0 = blockIdx.y * 64, n0 = blockIdx.x * 64;
    float acc[4][4];
#pragma unroll
    for (int i = 0; i < 4; ++i)
#pragma unroll
        for (int j = 0; j < 4; ++j) acc[i][j] = 0.f;
    const int ar = tid >> 2, ac = (tid & 3) * 4;
    const int br = tid >> 4, bc = (tid & 15) * 4;
    for (int k0 = 0; k0 < K; k0 += 16) {
        const float4 av = *(const float4*)(A + (size_t)(m0 + ar) * lda + k0 + ac);
        const float4 bv = *(const float4*)(B + (size_t)(k0 + br) * ldb + n0 + bc);
        __syncthreads();
        As[ac + 0][ar] = av.x; As[ac + 1][ar] = av.y; As[ac + 2][ar] = av.z; As[ac + 3][ar] = av.w;
        *(float4*)&Bs[br][bc] = bv;
        __syncthreads();
#pragma unroll
        for (int kk = 0; kk < 16; ++kk) {
            const float4 a4 = *(const float4*)&As[kk][ty * 4];
            const float4 b4 = *(const float4*)&Bs[kk][tx * 4];
            const float a_[4] = {a4.x, a4.y, a4.z, a4.w}, b_[4] = {b4.x, b4.y, b4.z, b4.w};
#pragma unroll
            for (int i = 0; i < 4; ++i)
#pragma unroll
                for (int j = 0; j < 4; ++j) acc[i][j] += a_[i] * b_[j];
        }
    }
#pragma unroll
    for (int i = 0; i < 4; ++i)
        *(float4*)(C + (size_t)(m0 + ty * 4 + i) * ldc + n0 + tx * 4) = make_float4(acc[i][0], acc[i][1], acc[i][2], acc[i][3]);
}

__global__ void __launch_bounds__(64) k_sb_attn(const float* __restrict__ proj, float* __restrict__ mix) {
    const int qb = blockIdx.x, h = blockIdx.y, b = blockIdx.z, i = threadIdx.x;
    const int t = qb * 64 + i;
    __shared__ float Ks[64][64];
    __shared__ float Vs[64][64];
    float q[64], acc[64];
    const float* qp = proj + (size_t)(b * SEQ + t) * AB_IN + h * 64;
#pragma unroll
    for (int d = 0; d < 64; ++d) { q[d] = qp[d] * 0.125f; acc[d] = 0.f; }
    float cum = 0.f;
    for (int kt = qb; kt >= 0; --kt) {
        __syncthreads();
        for (int r = 0; r < 64; ++r) {
            const float* rp = proj + (size_t)(b * SEQ + kt * 64 + r) * AB_IN + h * 64;
            Ks[r][i] = rp[512 + i];
            Vs[r][i] = rp[1024 + i];
        }
        __syncthreads();
        for (int j = 63; j >= 0; --j) {
            const int s = kt * 64 + j;
            float z = 0.f;
#pragma unroll
            for (int d = 0; d < 64; ++d) z += q[d] * Ks[j][d];
            const bool valid = s < t;
            const float sp = softplusf(z);
            const float w = valid ? expf(z - sp + cum) : 0.f;
#pragma unroll
            for (int d = 0; d < 64; ++d) acc[d] += w * Vs[j][d];
            if (valid) cum -= sp;
        }
    }
    float* op = mix + (size_t)(b * SEQ + t) * D_MODEL + h * 64;
#pragma unroll
    for (int d = 0; d < 64; ++d) op[d] = acc[d];
}

__global__ void __launch_bounds__(256) k_lru_gates(const float* __restrict__ proj, const float* __restrict__ conv_w, const float* __restrict__ conv_b,
                                                   const float* __restrict__ w_r, const float* __restrict__ b_r, const float* __restrict__ w_i,
                                                   const float* __restrict__ b_i, const float* __restrict__ lam, float* __restrict__ a_out, float* __restrict__ u_out) {
    const int tok = blockIdx.x;
    const int tpos = tok % SEQ;
    __shared__ float xc[512];
    for (int c = threadIdx.x; c < 512; c += 256) {
        float y = conv_b[c];
#pragma unroll
        for (int k = 0; k < 4; ++k) {
            const int tt = tpos - 3 + k;
            if (tt >= 0) y += conv_w[k * 512 + c] * proj[(size_t)(tok - 3 + k) * AB_IN + 1536 + c];
        }
        xc[c] = y;
    }
    __syncthreads();
    for (int c = threadIdx.x; c < 512; c += 256) {
        const int n = c >> 6, d = c & 63;
        float gr = b_r[c], gi = b_i[c];
        for (int cc = 0; cc < 64; ++cc) {
            const float xv = xc[n * 64 + cc];
            gr += xv * w_r[(n * 64 + cc) * 64 + d];
            gi += xv * w_i[(n * 64 + cc) * 64 + d];
        }
        const float r = sigmoidf_(gr), ig = sigmoidf_(gi);
        const float log_a = -8.0f * r * softplusf(-lam[c]);
        const float a = expf(log_a);
        const float u = sqrtf(-expm1f(2.0f * log_a)) * (ig * xc[c]);
        a_out[(size_t)tok * 512 + c] = a;
        u_out[(size_t)tok * 512 + c] = u;
    }
}
__device__ __forceinline__ float gelu_tanh(float x) {
    const float c = 0.7978845608028654f;
    return 0.5f * x * (1.f + tanhf(c * (x + 0.044715f * x * x * x)));
}
__global__ void __launch_bounds__(64) k_lru_scan(const float* __restrict__ a_in, const float* __restrict__ u_in, const float* __restrict__ proj, float* __restrict__ mix) {
    const int idx = blockIdx.x * 64 + threadIdx.x;
    const int b = idx >> 9, c = idx & 511;
    float h = 0.f;
    for (int t = 0; t < SEQ; ++t) {
        const size_t tok = (size_t)b * SEQ + t;
        h = a_in[tok * 512 + c] * h + u_in[tok * 512 + c];
        const float g = proj[tok * AB_IN + 2048 + c];
        mix[tok * D_MODEL + 512 + c] = gelu_tanh(g) * h;
    }
}

__global__ void __launch_bounds__(256) k_res_ln(const float* x, const float* __restrict__ h, const float* __restrict__ g, const float* __restrict__ bta, float* out) {
    const int row = blockIdx.x * 4 + (threadIdx.x >> 6), lane = threadIdx.x & 63;
    const float4* xr = (const float4*)(x + (size_t)row * D_MODEL);
    const float4* hr = (const float4*)(h + (size_t)row * D_MODEL);
    float4 v[4];
    float s = 0.f;
#pragma unroll
    for (int j = 0; j < 4; ++j) {
        const float4 a = xr[lane + 64 * j], c = hr[lane + 64 * j];
        v[j] = make_float4(ALPHA * a.x + c.x, ALPHA * a.y + c.y, ALPHA * a.z + c.z, ALPHA * a.w + c.w);
        s += (v[j].x + v[j].y) + (v[j].z + v[j].w);
    }
    const float mean = wave_sum(s) * (1.f / D_MODEL);
    float s2 = 0.f;
#pragma unroll
    for (int j = 0; j < 4; ++j) {
        v[j].x -= mean; v[j].y -= mean; v[j].z -= mean; v[j].w -= mean;
        s2 += (v[j].x * v[j].x + v[j].y * v[j].y) + (v[j].z * v[j].z + v[j].w * v[j].w);
    }
    const float rstd = 1.f / sqrtf(wave_sum(s2) * (1.f / D_MODEL) + LN_EPS);
    float4* orow = (float4*)(out + (size_t)row * D_MODEL);
#pragma unroll
    for (int j = 0; j < 4; ++j) {
        const float4 gg = ((const float4*)g)[lane + 64 * j], bb = ((const float4*)bta)[lane + 64 * j];
        orow[lane + 64 * j] = make_float4(v[j].x * rstd * gg.x + bb.x, v[j].y * rstd * gg.y + bb.y, v[j].z * rstd * gg.z + bb.z, v[j].w * rstd * gg.w + bb.w);
    }
}

__global__ void __launch_bounds__(256) k_router(const float* __restrict__ x, const float* __restrict__ w_router, const float* __restrict__ b_router,
                                                int* __restrict__ eidx, float* __restrict__ gatew) {
    const int tok = blockIdx.x * 4 + (threadIdx.x >> 6), lane = threadIdx.x & 63;
    float lg[16];
#pragma unroll
    for (int e = 0; e < 16; ++e) lg[e] = 0.f;
    for (int j = 0; j < 16; ++j) {
        const int d = lane + 64 * j;
        const float xv = x[(size_t)tok * D_MODEL + d];
        const float4* wr = (const float4*)(w_router + d * 16);
#pragma unroll
        for (int q4 = 0; q4 < 4; ++q4) {
            const float4 w = wr[q4];
            lg[q4 * 4 + 0] += xv * w.x; lg[q4 * 4 + 1] += xv * w.y; lg[q4 * 4 + 2] += xv * w.z; lg[q4 * 4 + 3] += xv * w.w;
        }
    }
#pragma unroll
    for (int e = 0; e < 16; ++e) lg[e] = wave_sum(lg[e]) + b_router[e];
    if (lane == 0) {
        float mx = lg[0];
#pragma unroll
        for (int e = 1; e < 16; ++e) mx = fmaxf(mx, lg[e]);
        float p[16], sum = 0.f;
#pragma unroll
        for (int e = 0; e < 16; ++e) { p[e] = expf(lg[e] - mx); sum += p[e]; }
        const float inv = 1.f / sum;
#pragma unroll
        for (int e = 0; e < 16; ++e) p[e] *= inv;
        int gsel = 0; float gbest = -1.f;
#pragma unroll
        for (int g = 0; g < 4; ++g) {
            float m1 = -1.f, m2 = -1.f;
#pragma unroll
            for (int k = 0; k < 4; ++k) { const float v = p[g * 4 + k]; if (v > m1) { m2 = m1; m1 = v; } else if (v > m2) { m2 = v; } }
            const float sc = m1 + m2;
            if (sc > gbest) { gbest = sc; gsel = g; }
        }
        float m1 = -1.f, m2 = -1.f; int i1 = 0, i2 = 0;
#pragma unroll
        for (int g = 0; g < 4; ++g) {
            if (g == gsel) {
#pragma unroll
                for (int k = 0; k < 4; ++k) { const float v = p[g * 4 + k]; if (v > m1) { m2 = m1; i2 = i1; m1 = v; i1 = k; } else if (v > m2) { m2 = v; i2 = k; } }
            }
        }
        const float ws = m1 + m2;
        eidx[tok * 2 + 0] = gsel * 4 + i1; eidx[tok * 2 + 1] = gsel * 4 + i2;
        gatew[tok * 2 + 0] = m1 / ws; gatew[tok * 2 + 1] = m2 / ws;
    }
}

__global__ void __launch_bounds__(256) k_moe_naive(const float* __restrict__ x, const int* __restrict__ eidx, const float* __restrict__ gatew,
                                                   const float* __restrict__ wg, const float* __restrict__ wu, const float* __restrict__ wd, float* __restrict__ m) {
    const int tok = blockIdx.x, tid = threadIdx.x;
    __shared__ float xs[1024];
    __shared__ float hs[512];
    for (int d = tid; d < 1024; d += 256) xs[d] = x[(size_t)tok * D_MODEL + d];
    float o[4] = {0.f, 0.f, 0.f, 0.f};
    for (int kk = 0; kk < 2; ++kk) {
        const int e = eidx[tok * 2 + kk];
        const float gw = gatew[tok * 2 + kk];
        const float* wge = wg + (size_t)e * D_MODEL * D_FF;
        const float* wue = wu + (size_t)e * D_MODEL * D_FF;
        const float* wde = wd + (size_t)e * D_FF * D_MODEL;
        __syncthreads();
        float g0 = 0.f, g1 = 0.f, u0 = 0.f, u1 = 0.f;
        for (int d = 0; d < 1024; ++d) {
            const float xv = xs[d];
            g0 += xv * wge[(size_t)d * D_FF + tid]; g1 += xv * wge[(size_t)d * D_FF + tid + 256];
            u0 += xv * wue[(size_t)d * D_FF + tid]; u1 += xv * wue[(size_t)d * D_FF + tid + 256];
        }
        hs[tid] = g0 * sigmoidf_(g0) * u0 * gw;
        hs[tid + 256] = g1 * sigmoidf_(g1) * u1 * gw;
        __syncthreads();
        for (int f = 0; f < 512; ++f) {
            const float hv = hs[f];
#pragma unroll
            for (int j = 0; j < 4; ++j) o[j] += hv * wde[(size_t)f * D_MODEL + tid + 256 * j];
        }
    }
#pragma unroll
    for (int j = 0; j < 4; ++j) m[(size_t)tok * D_MODEL + tid + 256 * j] = o[j];
}

__global__ void __launch_bounds__(256) k_ple_combine(const float* __restrict__ x, const float* __restrict__ G, const float* __restrict__ bg, const float* __restrict__ PP, float* __restrict__ out) {
    const size_t i = (size_t)blockIdx.x * 256 + threadIdx.x;
    const int c = (int)(i & 1023);
    out[i] = x[i] + sigmoidf_(G[i] + bg[c]) * PP[i];
}

__global__ void __launch_bounds__(256) k_rope(float* __restrict__ proj, const int* __restrict__ positions) {
    const size_t idx = (size_t)blockIdx.x * 256 + threadIdx.x;
    const int i = (int)(idx & 31), hh = (int)((idx >> 5) % 20);
    const size_t tok = idx / (32 * 20);
    const float inv_freq = powf(10000.0f, -(float)i / 32.0f);
    const float ang = (float)positions[tok] * inv_freq;
    const float c = cosf(ang), s = sinf(ang);
    float* p = proj + tok * C_IN + hh * 64;
    const float x1 = p[i], x2 = p[i + 32];
    p[i] = x1 * c - x2 * s;
    p[i + 32] = x2 * c + x1 * s;
}

__global__ void __launch_bounds__(64) k_swa_attn(const float* __restrict__ proj, const float* __restrict__ sinks, float* __restrict__ mix) {
    const int qb = blockIdx.x, hq = blockIdx.y, b = blockIdx.z, i = threadIdx.x;
    const int t = qb * 64 + i, kv = hq >> 2;
    __shared__ float Ks[64][64];
    __shared__ float Vs[64][64];
    float q[64], acc[64];
    const float* qp = proj + (size_t)(b * SEQ + t) * C_IN + hq * 64;
#pragma unroll
    for (int d = 0; d < 64; ++d) { q[d] = qp[d] * 0.125f; acc[d] = 0.f; }
    float mrun = sinks[hq], l = 1.f;
    for (int kt = qb - 2; kt <= qb; ++kt) {
        if (kt < 0) continue;
        __syncthreads();
        for (int r = 0; r < 64; ++r) {
            const float* rp = proj + (size_t)(b * SEQ + kt * 64 + r) * C_IN;
            Ks[r][i] = rp[1024 + kv * 64 + i];
            Vs[r][i] = rp[1280 + kv * 64 + i];
        }
        __syncthreads();
        for (int j = 0; j < 64; ++j) {
            const int s = kt * 64 + j;
            float z = 0.f;
#pragma unroll
            for (int d = 0; d < 64; ++d) z += q[d] * Ks[j][d];
            const bool valid = (s <= t) && (t - s < 128);
            if (valid) {
                const float mn = fmaxf(mrun, z);
                const float sc = expf(mrun - mn), pw = expf(z - mn);
                l = l * sc + pw;
#pragma unroll
                for (int d = 0; d < 64; ++d) acc[d] = acc[d] * sc + pw * Vs[j][d];
                mrun = mn;
            }
        }
    }
    const float inv = 1.f / l;
    float* op = mix + (size_t)(b * SEQ + t) * D_MODEL + hq * 64;
#pragma unroll
    for (int d = 0; d < 64; ++d) op[d] = acc[d] * inv;
}

}

extern "C" void kernel_launch(void* const* d_in, const int* in_sizes, int n_in, void* d_out, int out_size, void* d_ws, size_t ws_size,
                              hipStream_t stream) {
    const float* x_in = (const float*)d_in[0];
    const float* p_in = (const float*)d_in[1];
    const int* positions = (const int*)d_in[2];
    const float* w_in_ab = (const float*)d_in[3];
    const float* w_out_ab = (const float*)d_in[4];
    const float* conv_w = (const float*)d_in[5];
    const float* conv_b = (const float*)d_in[6];
    const float* lru_w_r = (const float*)d_in[7];
    const float* lru_b_r = (const float*)d_in[8];
    const float* lru_w_i = (const float*)d_in[9];
    const float* lru_b_i = (const float*)d_in[10];
    const float* lru_lambda = (const float*)d_in[11];
    const float* w_qkv_c = (const float*)d_in[12];
    const float* w_out_c = (const float*)d_in[13];
    const float* sinks_c = (const float*)d_in[14];
    const float* ln_mix_g = (const float*)d_in[15];
    const float* ln_mix_b = (const float*)d_in[16];
    const float* ln_ffn_g = (const float*)d_in[17];
    const float* ln_ffn_b = (const float*)d_in[18];
    const float* w_router = (const float*)d_in[19];
    const float* b_router = (const float*)d_in[20];
    const float* exp_w_gate = (const float*)d_in[21];
    const float* exp_w_up = (const float*)d_in[22];
    const float* exp_w_down = (const float*)d_in[23];
    const float* ple_w_proj = (const float*)d_in[24];
    const float* ple_w_gate = (const float*)d_in[25];
    const float* ple_b_gate = (const float*)d_in[26];
    float* out = (float*)d_out;

    char* ws = (char*)d_ws;
    const size_t MB = 1u << 20;
    float* PROJ = (float*)(ws);
    float* MIX = (float*)(ws + 160 * MB);
    float* XA = (float*)(ws + 224 * MB);
    int* EIDX = (int*)(ws + 288 * MB);
    float* GATEW = (float*)(ws + 289 * MB);
    float* MOE_M = PROJ;
    float* PLE_G = PROJ + (size_t)NTOK * 1024;
    float* PLE_P = MIX;
    float* LRU_A = XA;
    float* LRU_U = XA + (size_t)NTOK * 512;

    for (int layer = 0; layer < 2; ++layer) {
        const float* xin = (layer == 0) ? x_in : out;
        if (layer == 0) {
            k_gemm_f32<<<dim3(AB_IN / 64, NTOK / 64), 256, 0, stream>>>(xin, D_MODEL, w_in_ab, AB_IN, PROJ, AB_IN, D_MODEL);
            k_sb_attn<<<dim3(SEQ / 64, 8, BATCH), 64, 0, stream>>>(PROJ, MIX);
            k_lru_gates<<<NTOK, 256, 0, stream>>>(PROJ, conv_w, conv_b, lru_w_r, lru_b_r, lru_w_i, lru_b_i, lru_lambda, LRU_A, LRU_U);
            k_lru_scan<<<16, 64, 0, stream>>>(LRU_A, LRU_U, PROJ, MIX);
            k_gemm_f32<<<dim3(D_MODEL / 64, NTOK / 64), 256, 0, stream>>>(MIX, D_MODEL, w_out_ab, D_MODEL, PROJ, D_MODEL, D_MODEL);
        } else {
            k_gemm_f32<<<dim3(C_IN / 64, NTOK / 64), 256, 0, stream>>>(xin, D_MODEL, w_qkv_c, C_IN, PROJ, C_IN, D_MODEL);
            k_rope<<<(NTOK * 20 * 32) / 256, 256, 0, stream>>>(PROJ, positions);
            k_swa_attn<<<dim3(SEQ / 64, 16, BATCH), 64, 0, stream>>>(PROJ, sinks_c, MIX);
            k_gemm_f32<<<dim3(D_MODEL / 64, NTOK / 64), 256, 0, stream>>>(MIX, D_MODEL, w_out_c, D_MODEL, PROJ, D_MODEL, D_MODEL);
        }
        k_res_ln<<<NTOK / 4, 256, 0, stream>>>(xin, PROJ, ln_mix_g + layer * D_MODEL, ln_mix_b + layer * D_MODEL, XA);
        k_router<<<NTOK / 4, 256, 0, stream>>>(XA, w_router, b_router, EIDX, GATEW);
        k_moe_naive<<<NTOK, 256, 0, stream>>>(XA, EIDX, GATEW, exp_w_gate + (size_t)layer * N_EXP * D_MODEL * D_FF, exp_w_up + (size_t)layer * N_EXP * D_MODEL * D_FF,
                                              exp_w_down + (size_t)layer * N_EXP * D_FF * D_MODEL, MOE_M);
        k_res_ln<<<NTOK / 4, 256, 0, stream>>>(XA, MOE_M, ln_ffn_g + layer * D_MODEL, ln_ffn_b + layer * D_MODEL, XA);
        k_gemm_f32<<<dim3(D_MODEL / 64, NTOK / 64), 256, 0, stream>>>(XA, D_MODEL, ple_w_gate + (size_t)layer * D_MODEL * D_MODEL, D_MODEL, PLE_G, D_MODEL, D_MODEL);
        k_gemm_f32<<<dim3(D_MODEL / 64, NTOK / 64), 256, 0, stream>>>(p_in + (size_t)layer * NTOK * PLE_DIM, PLE_DIM, ple_w_proj + (size_t)layer * PLE_DIM * D_MODEL, D_MODEL, PLE_P,
                                                                     D_MODEL, PLE_DIM);
        k_ple_combine<<<(NTOK * D_MODEL) / 256, 256, 0, stream>>>(XA, PLE_G, ple_b_gate + layer * D_MODEL, PLE_P, out);
    }
}
```

```cpp
#include <hip/hip_runtime.h>
#include <hip/hip_cooperative_groups.h>
#include <cstdint>
#include <cstdio>
namespace cg = cooperative_groups;

namespace {
constexpr int D_MODEL = 1024, BATCH = 2, SEQ = 8192, NTOK = BATCH * SEQ;
constexpr int AB_IN = 2560, C_IN = 1536;
constexpr int N_EXP = 16, D_FF = 512, PLE_DIM = 256;
constexpr float ALPHA = 1.4142135623730951f;
constexpr float LN_EPS = 1e-5f;
constexpr int NTHREADS = 512;
constexpr int LDS_BYTES = 147456;

__device__ __forceinline__ float softplusf(float z) { return fmaxf(z, 0.f) + log1pf(expf(-fabsf(z))); }
__device__ __forceinline__ float sigmoidf_(float z) { return 1.f / (1.f + expf(-z)); }
__device__ __forceinline__ float wave_sum(float v) {
#pragma unroll
    for (int o = 1; o < 64; o <<= 1) v += __shfl_xor(v, o);
    return v;
}
__device__ __forceinline__ float gelu_tanh(float x) {
    const float c = 0.7978845608028654f;
    return 0.5f * x * (1.f + tanhf(c * (x + 0.044715f * x * x * x)));
}

__device__ __forceinline__ void ph_gemm_f32(unsigned char* lds, const float* A, int lda, const float* B, int ldb, float* C, int ldc, int M, int N, int K) {
    const int half = threadIdx.x >> 8, tid = threadIdx.x & 255, tx = tid & 15, ty = tid >> 4;
    float (*As)[68] = (float (*)[68])(lds + half * 8704);
    float (*Bs)[68] = (float (*)[68])(lds + half * 8704 + 4352);
    const int ntn = N / 64, total = ntn * (M / 64);
    const int ar = tid >> 2, ac = (tid & 3) * 4, br = tid >> 4, bc = (tid & 15) * 4;
    for (int vb = 2 * blockIdx.x + half; vb < total; vb += 2 * gridDim.x) {
        const int m0 = (vb / ntn) * 64, n0 = (vb % ntn) * 64;
        float acc[4][4];
#pragma unroll
        for (int i = 0; i < 4; ++i)
#pragma unroll
            for (int j = 0; j < 4; ++j) acc[i][j] = 0.f;
        for (int k0 = 0; k0 < K; k0 += 16) {
            const float4 av = *(const float4*)(A + (size_t)(m0 + ar) * lda + k0 + ac);
            const float4 bv = *(const float4*)(B + (size_t)(k0 + br) * ldb + n0 + bc);
            __syncthreads();
            As[ac + 0][ar] = av.x; As[ac + 1][ar] = av.y; As[ac + 2][ar] = av.z; As[ac + 3][ar] = av.w;
            *(float4*)&Bs[br][bc] = bv;
            __syncthreads();
#pragma unroll
            for (int kk = 0; kk < 16; ++kk) {
                const float4 a4 = *(const float4*)&As[kk][ty * 4];
                const float4 b4 = *(const float4*)&Bs[kk][tx * 4];
                const float a_[4] = {a4.x, a4.y, a4.z, a4.w}, b_[4] = {b4.x, b4.y, b4.z, b4.w};
#pragma unroll
                for (int i = 0; i < 4; ++i)
#pragma unroll
                    for (int j = 0; j < 4; ++j) acc[i][j] += a_[i] * b_[j];
            }
        }
#pragma unroll
        for (int i = 0; i < 4; ++i)
            *(float4*)(C + (size_t)(m0 + ty * 4 + i) * ldc + n0 + tx * 4) = make_float4(acc[i][0], acc[i][1], acc[i][2], acc[i][3]);
    }
}

__device__ __forceinline__ void ph_sb_attn(unsigned char* lds, const float* proj, float* mix) {
    float (*Ks)[64] = (float (*)[64])(lds);
    float (*Vs)[64] = (float (*)[64])(lds + 16384);
    const int tid = threadIdx.x, qi = tid >> 1, hf = tid & 1;
    for (int unit = blockIdx.x; unit < BATCH * 8 * (SEQ / 256); unit += gridDim.x) {
        const int qc = (SEQ / 256 - 1) - unit / (BATCH * 8), bh = unit % (BATCH * 8), b = bh >> 3, h = bh & 7;
        const int t = qc * 256 + qi;
        float q[32], acc[32];
        const float* qp = proj + (size_t)(b * SEQ + t) * AB_IN + h * 64 + hf * 32;
#pragma unroll
        for (int d = 0; d < 32; ++d) { q[d] = qp[d] * 0.125f; acc[d] = 0.f; }
        float cum = 0.f;
        for (int kt = qc * 4 + 3; kt >= 0; --kt) {
            __syncthreads();
#pragma unroll
            for (int e = 0; e < 8; ++e) {
                const int idx = tid + e * 512, r = idx >> 6, c = idx & 63;
                const float* rp = proj + (size_t)(b * SEQ + kt * 64 + r) * AB_IN + h * 64;
                Ks[r][c] = rp[512 + c];
                Vs[r][c] = rp[1024 + c];
            }
            __syncthreads();
            for (int j = 63; j >= 0; --j) {
                const int s = kt * 64 + j;
                float z = 0.f;
#pragma unroll
                for (int d = 0; d < 32; ++d) z += q[d] * Ks[j][hf * 32 + d];
                z += __shfl_xor(z, 1);
                const bool valid = s < t;
                const float sp = softplusf(z);
                const float w = valid ? expf(z - sp + cum) : 0.f;
#pragma unroll
                for (int d = 0; d < 32; ++d) acc[d] += w * Vs[j][hf * 32 + d];
                if (valid) cum -= sp;
            }
        }
        float* op = mix + (size_t)(b * SEQ + t) * D_MODEL + h * 64 + hf * 32;
#pragma unroll
        for (int d = 0; d < 32; ++d) op[d] = acc[d];
    }
}

__device__ __forceinline__ void ph_lru_gates(unsigned char* lds, const float* proj, const float* conv_w, const float* conv_b, const float* w_r, const float* b_r,
                                             const float* w_i, const float* b_i, const float* lam, float* a_out, float* u_out) {
    float* xc = (float*)(lds + 65536);
    const int c = threadIdx.x;
    for (int tok = blockIdx.x; tok < NTOK; tok += gridDim.x) {
        asm volatile("" ::: "memory");
        const int tpos = tok % SEQ;
        float y = conv_b[c];
#pragma unroll
        for (int k = 0; k < 4; ++k) {
            const int tt = tpos - 3 + k;
            if (tt >= 0) y += conv_w[k * 512 + c] * proj[(size_t)(tok - 3 + k) * AB_IN + 1536 + c];
        }
        __syncthreads();
        xc[c] = y;
        __syncthreads();
        const int n = c >> 6, d = c & 63;
        float gr = b_r[c], gi = b_i[c];
#pragma unroll 4
        for (int cc = 0; cc < 64; ++cc) {
            const float xv = xc[n * 64 + cc];
            gr += xv * w_r[(n * 64 + cc) * 64 + d];
            gi += xv * w_i[(n * 64 + cc) * 64 + d];
        }
        const float r = sigmoidf_(gr), ig = sigmoidf_(gi);
        const float log_a = -8.0f * r * softplusf(-lam[c]);
        a_out[(size_t)tok * 512 + c] = expf(log_a);
        u_out[(size_t)tok * 512 + c] = sqrtf(-expm1f(2.0f * log_a)) * (ig * y);
    }
}
__device__ __forceinline__ void ph_lru_scan(const float* a_in, const float* u_in, const float* proj, float* mix) {
    if (blockIdx.x >= BATCH) return;
    const int b = blockIdx.x, c = threadIdx.x;
    float h = 0.f;
#pragma unroll 8
    for (int t = 0; t < SEQ; ++t) {
        const size_t tok = (size_t)b * SEQ + t;
        h = a_in[tok * 512 + c] * h + u_in[tok * 512 + c];
        const float g = proj[tok * AB_IN + 2048 + c];
        mix[tok * D_MODEL + 512 + c] = gelu_tanh(g) * h;
    }
}

template <bool ROUTER>
__device__ __forceinline__ void ph_res_ln(const float* x, const float* h, const float* g, const float* bta, float* out, const float* w_router, const float* b_router,
                                          int* eidx, float* gatew) {
    const int lane = threadIdx.x & 63, wave = threadIdx.x >> 6;
    for (int row = blockIdx.x * 8 + wave; row < NTOK; row += gridDim.x * 8) {
        asm volatile("" ::: "memory");
        const float4* xr = (const float4*)(x + (size_t)row * D_MODEL);
        const float4* hr = (const float4*)(h + (size_t)row * D_MODEL);
        float4 v[4];
        float s = 0.f;
#pragma unroll
        for (int j = 0; j < 4; ++j) {
            const float4 a = xr[lane + 64 * j], c = hr[lane + 64 * j];
            v[j] = make_float4(ALPHA * a.x + c.x, ALPHA * a.y + c.y, ALPHA * a.z + c.z, ALPHA * a.w + c.w);
            s += (v[j].x + v[j].y) + (v[j].z + v[j].w);
        }
        const float mean = wave_sum(s) * (1.f / D_MODEL);
        float s2 = 0.f;
#pragma unroll
        for (int j = 0; j < 4; ++j) {
            v[j].x -= mean; v[j].y -= mean; v[j].z -= mean; v[j].w -= mean;
            s2 += (v[j].x * v[j].x + v[j].y * v[j].y) + (v[j].z * v[j].z + v[j].w * v[j].w);
        }
        const float rstd = 1.f / sqrtf(wave_sum(s2) * (1.f / D_MODEL) + LN_EPS);
        float4* orow = (float4*)(out + (size_t)row * D_MODEL);
#pragma unroll
        for (int j = 0; j < 4; ++j) {
            const float4 gg = ((const float4*)g)[lane + 64 * j], bb = ((const float4*)bta)[lane + 64 * j];
            v[j] = make_float4(v[j].x * rstd * gg.x + bb.x, v[j].y * rstd * gg.y + bb.y, v[j].z * rstd * gg.z + bb.z, v[j].w * rstd * gg.w + bb.w);
            orow[lane + 64 * j] = v[j];
        }
        if (ROUTER) {
            float lg[16];
#pragma unroll
            for (int e = 0; e < 16; ++e) lg[e] = 0.f;
#pragma unroll
            for (int j = 0; j < 4; ++j) {
                const float xv[4] = {v[j].x, v[j].y, v[j].z, v[j].w};
#pragma unroll
                for (int k = 0; k < 4; ++k) {
                    const int d = 4 * (lane + 64 * j) + k;
                    const float4* wr = (const float4*)(w_router + d * 16);
#pragma unroll
                    for (int q4 = 0; q4 < 4; ++q4) {
                        const float4 w = wr[q4];
                        lg[q4 * 4 + 0] += xv[k] * w.x; lg[q4 * 4 + 1] += xv[k] * w.y; lg[q4 * 4 + 2] += xv[k] * w.z; lg[q4 * 4 + 3] += xv[k] * w.w;
                    }
                }
            }
#pragma unroll
            for (int e = 0; e < 16; ++e) lg[e] = wave_sum(lg[e]) + b_router[e];
            if (lane == 0) {
                float mx = lg[0];
#pragma unroll
                for (int e = 1; e < 16; ++e) mx = fmaxf(mx, lg[e]);
                float p[16], sum = 0.f;
#pragma unroll
                for (int e = 0; e < 16; ++e) { p[e] = expf(lg[e] - mx); sum += p[e]; }
                const float inv = 1.f / sum;
#pragma unroll
                for (int e = 0; e < 16; ++e) p[e] *= inv;
                int gsel = 0; float gbest = -1.f;
#pragma unroll
                for (int gq = 0; gq < 4; ++gq) {
                    float m1 = -1.f, m2 = -1.f;
#pragma unroll
                    for (int k = 0; k < 4; ++k) { const float pv = p[gq * 4 + k]; if (pv > m1) { m2 = m1; m1 = pv; } else if (pv > m2) { m2 = pv; } }
                    const float sc = m1 + m2;
                    if (sc > gbest) { gbest = sc; gsel = gq; }
                }
                float m1 = -1.f, m2 = -1.f; int i1 = 0, i2 = 0;
#pragma unroll
                for (int gq = 0; gq < 4; ++gq) {
                    if (gq == gsel) {
#pragma unroll
                        for (int k = 0; k < 4; ++k) { const float pv = p[gq * 4 + k]; if (pv > m1) { m2 = m1; i2 = i1; m1 = pv; i1 = k; } else if (pv > m2) { m2 = pv; i2 = k; } }
                    }
                }
                const float wsum = m1 + m2;
                eidx[row * 2 + 0] = gsel * 4 + i1; eidx[row * 2 + 1] = gsel * 4 + i2;
                gatew[row * 2 + 0] = m1 / wsum; gatew[row * 2 + 1] = m2 / wsum;
            }
        }
    }
}

__device__ __forceinline__ void ph_moe_naive(unsigned char* lds, const float* x, const int* eidx, const float* gatew, const float* wg, const float* wu, const float* wd, float* m) {
    float* xs = (float*)(lds + 65536);
    float* hs = (float*)(lds + 65536 + 4096);
    const int tid = threadIdx.x;
    for (int tok = blockIdx.x; tok < NTOK; tok += gridDim.x) {
        __syncthreads();
        xs[tid] = x[(size_t)tok * D_MODEL + tid]; xs[tid + 512] = x[(size_t)tok * D_MODEL + tid + 512];
        float o0 = 0.f, o1 = 0.f;
        for (int kk = 0; kk < 2; ++kk) {
            const int e = eidx[tok * 2 + kk];
            const float gw = gatew[tok * 2 + kk];
            const float* wge = wg + (size_t)e * D_MODEL * D_FF;
            const float* wue = wu + (size_t)e * D_MODEL * D_FF;
            const float* wde = wd + (size_t)e * D_FF * D_MODEL;
            __syncthreads();
            float g0 = 0.f, u0 = 0.f;
#pragma unroll 4
            for (int d = 0; d < 1024; ++d) {
                const float xv = xs[d];
                g0 += xv * wge[(size_t)d * D_FF + tid];
                u0 += xv * wue[(size_t)d * D_FF + tid];
            }
            hs[tid] = g0 * sigmoidf_(g0) * u0 * gw;
            __syncthreads();
#pragma unroll 4
            for (int f = 0; f < 512; ++f) {
                const float hv = hs[f];
                o0 += hv * wde[(size_t)f * D_MODEL + tid];
                o1 += hv * wde[(size_t)f * D_MODEL + tid + 512];
            }
        }
        m[(size_t)tok * D_MODEL + tid] = o0; m[(size_t)tok * D_MODEL + tid + 512] = o1;
    }
}

__device__ __forceinline__ void ph_ple_combine(const float* x, const float* G, const float* bg, const float* PP, float* out) {
    for (size_t i = (size_t)blockIdx.x * NTHREADS + threadIdx.x; i < (size_t)NTOK * D_MODEL; i += (size_t)gridDim.x * NTHREADS) {
        const int c = (int)(i & 1023);
        out[i] = x[i] + sigmoidf_(G[i] + bg[c]) * PP[i];
    }
}

__device__ __forceinline__ void ph_rope(float* proj, const int* positions) {
    for (size_t idx = (size_t)blockIdx.x * NTHREADS + threadIdx.x; idx < (size_t)NTOK * 20 * 32; idx += (size_t)gridDim.x * NTHREADS) {
        const int i = (int)(idx & 31), hh = (int)((idx >> 5) % 20);
        const size_t tok = idx / (32 * 20);
        const float inv_freq = powf(10000.0f, -(float)i / 32.0f);
        const float ang = (float)positions[tok] * inv_freq;
        const float c = cosf(ang), s = sinf(ang);
        float* p = proj + tok * C_IN + hh * 64;
        const float x1 = p[i], x2 = p[i + 32];
        p[i] = x1 * c - x2 * s;
        p[i + 32] = x2 * c + x1 * s;
    }
}

__device__ __forceinline__ void ph_swa_attn(unsigned char* lds, const float* proj, const float* sinks, float* mix) {
    float (*Ks)[64] = (float (*)[64])(lds);
    float (*Vs)[64] = (float (*)[64])(lds + 16384);
    const int tid = threadIdx.x, qi = tid >> 1, hf = tid & 1;
    for (int unit = blockIdx.x; unit < BATCH * 16 * (SEQ / 256); unit += gridDim.x) {
        const int qc = unit / (BATCH * 16), bh = unit % (BATCH * 16), b = bh >> 4, hq = bh & 15, kv = hq >> 2;
        const int t = qc * 256 + qi;
        float q[32], acc[32];
        const float* qp = proj + (size_t)(b * SEQ + t) * C_IN + hq * 64 + hf * 32;
#pragma unroll
        for (int d = 0; d < 32; ++d) { q[d] = qp[d] * 0.125f; acc[d] = 0.f; }
        float mrun = sinks[hq], l = 1.f;
        for (int kt = qc * 4 - 2; kt <= qc * 4 + 3; ++kt) {
            if (kt < 0) continue;
            __syncthreads();
#pragma unroll
            for (int e = 0; e < 8; ++e) {
                const int idx = tid + e * 512, r = idx >> 6, c = idx & 63;
                const float* rp = proj + (size_t)(b * SEQ + kt * 64 + r) * C_IN;
                Ks[r][c] = rp[1024 + kv * 64 + c];
                Vs[r][c] = rp[1280 + kv * 64 + c];
            }
            __syncthreads();
            for (int j = 0; j < 64; ++j) {
                const int s = kt * 64 + j;
                float z = 0.f;
#pragma unroll
                for (int d = 0; d < 32; ++d) z += q[d] * Ks[j][hf * 32 + d];
                z += __shfl_xor(z, 1);
                const bool valid = (s <= t) && (t - s < 128);
                if (valid) {
                    const float mn = fmaxf(mrun, z);
                    const float sc = expf(mrun - mn), pw = expf(z - mn);
                    l = l * sc + pw;
#pragma unroll
                    for (int d = 0; d < 32; ++d) acc[d] = acc[d] * sc + pw * Vs[j][hf * 32 + d];
                    mrun = mn;
                }
            }
        }
        const float inv = 1.f / l;
        float* op = mix + (size_t)(b * SEQ + t) * D_MODEL + hq * 64 + hf * 32;
#pragma unroll
        for (int d = 0; d < 32; ++d) op[d] = acc[d] * inv;
    }
}

struct Args {
    const void* in[27];
    float* out;
    unsigned char* ws;
};

__global__ void __launch_bounds__(NTHREADS, 2) fwd_megakernel(Args args) {
    extern __shared__ __attribute__((aligned(16))) unsigned char lds[];
    cg::grid_group grid = cg::this_grid();
#define GRID_BAR() grid.sync()
    const float* x_in = (const float*)args.in[0];
    const float* p_in = (const float*)args.in[1];
    const int* positions = (const int*)args.in[2];
    const float* w_in_ab = (const float*)args.in[3];
    const float* w_out_ab = (const float*)args.in[4];
    const float* conv_w = (const float*)args.in[5];
    const float* conv_b = (const float*)args.in[6];
    const float* lru_w_r = (const float*)args.in[7];
    const float* lru_b_r = (const float*)args.in[8];
    const float* lru_w_i = (const float*)args.in[9];
    const float* lru_b_i = (const float*)args.in[10];
    const float* lru_lambda = (const float*)args.in[11];
    const float* w_qkv_c = (const float*)args.in[12];
    const float* w_out_c = (const float*)args.in[13];
    const float* sinks_c = (const float*)args.in[14];
    const float* ln_mix_g = (const float*)args.in[15];
    const float* ln_mix_b = (const float*)args.in[16];
    const float* ln_ffn_g = (const float*)args.in[17];
    const float* ln_ffn_b = (const float*)args.in[18];
    const float* w_router = (const float*)args.in[19];
    const float* b_router = (const float*)args.in[20];
    const float* exp_w_gate = (const float*)args.in[21];
    const float* exp_w_up = (const float*)args.in[22];
    const float* exp_w_down = (const float*)args.in[23];
    const float* ple_w_proj = (const float*)args.in[24];
    const float* ple_w_gate = (const float*)args.in[25];
    const float* ple_b_gate = (const float*)args.in[26];
    float* out = args.out;
    unsigned char* ws = args.ws;
    const size_t MB = 1u << 20;
    float* PROJ = (float*)(ws);
    float* MIX = (float*)(ws + 160 * MB);
    float* XA = (float*)(ws + 224 * MB);
    int* EIDX = (int*)(ws + 288 * MB);
    float* GATEW = (float*)(ws + 289 * MB);
    float* MOE_M = PROJ;
    float* PLE_G = PROJ + (size_t)NTOK * 1024;
    float* PLE_P = MIX;
    float* LRU_A = XA;
    float* LRU_U = XA + (size_t)NTOK * 512;

#pragma unroll
    for (int layer = 0; layer < 2; ++layer) {
        const float* xin = (layer == 0) ? x_in : out;
        if (layer == 0) {
            ph_gemm_f32(lds, xin, D_MODEL, w_in_ab, AB_IN, PROJ, AB_IN, NTOK, AB_IN, D_MODEL);
            GRID_BAR();
            ph_sb_attn(lds, PROJ, MIX);
            ph_lru_gates(lds, PROJ, conv_w, conv_b, lru_w_r, lru_b_r, lru_w_i, lru_b_i, lru_lambda, LRU_A, LRU_U);
            GRID_BAR();
            ph_lru_scan(LRU_A, LRU_U, PROJ, MIX);
            GRID_BAR();
            ph_gemm_f32(lds, MIX, D_MODEL, w_out_ab, D_MODEL, PROJ, D_MODEL, NTOK, D_MODEL, D_MODEL);
        } else {
            ph_gemm_f32(lds, xin, D_MODEL, w_qkv_c, C_IN, PROJ, C_IN, NTOK, C_IN, D_MODEL);
            GRID_BAR();
            ph_rope(PROJ, positions);
            GRID_BAR();
            ph_swa_attn(lds, PROJ, sinks_c, MIX);
            GRID_BAR();
            ph_gemm_f32(lds, MIX, D_MODEL, w_out_c, D_MODEL, PROJ, D_MODEL, NTOK, D_MODEL, D_MODEL);
        }
        GRID_BAR();
        ph_res_ln<true>(xin, PROJ, ln_mix_g + layer * D_MODEL, ln_mix_b + layer * D_MODEL, XA, w_router, b_router, EIDX, GATEW);
        GRID_BAR();
        ph_moe_naive(lds, XA, EIDX, GATEW, exp_w_gate + (size_t)layer * N_EXP * D_MODEL * D_FF, exp_w_up + (size_t)layer * N_EXP * D_MODEL * D_FF,
                     exp_w_down + (size_t)layer * N_EXP * D_FF * D_MODEL, MOE_M);
        GRID_BAR();
        ph_res_ln<false>(XA, MOE_M, ln_ffn_g + layer * D_MODEL, ln_ffn_b + layer * D_MODEL, XA, nullptr, nullptr, nullptr, nullptr);
        GRID_BAR();
        ph_gemm_f32(lds, XA, D_MODEL, ple_w_gate + (size_t)layer * D_MODEL * D_MODEL, D_MODEL, PLE_G, D_MODEL, NTOK, D_MODEL, D_MODEL);
        ph_gemm_f32(lds, p_in + (size_t)layer * NTOK * PLE_DIM, PLE_DIM, ple_w_proj + (size_t)layer * PLE_DIM * D_MODEL, D_MODEL, PLE_P, D_MODEL, NTOK, D_MODEL, PLE_DIM);
        GRID_BAR();
        ph_ple_combine(XA, PLE_G, ple_b_gate + layer * D_MODEL, PLE_P, out);
        if (layer == 0) GRID_BAR();
    }
}
}

extern "C" void kernel_launch(void* const* d_in, const int* in_sizes, int n_in, void* d_out, int out_size, void* d_ws, size_t ws_size,
                              hipStream_t stream) {
    static int grid_blocks = 0;
    if (grid_blocks == 0) {
        int dev = 0, cus = 0, per_cu = 0;
        (void)hipGetDevice(&dev);
        (void)hipDeviceGetAttribute(&cus, hipDeviceAttributeMultiprocessorCount, dev);
        if (hipFuncSetAttribute((const void*)fwd_megakernel, hipFuncAttributeMaxDynamicSharedMemorySize, LDS_BYTES) != hipSuccess)
            fprintf(stderr, "kernel_launch: hipFuncSetAttribute failed\n");
        if (hipOccupancyMaxActiveBlocksPerMultiprocessor(&per_cu, (const void*)fwd_megakernel, NTHREADS, LDS_BYTES) != hipSuccess || per_cu < 1) {
            fprintf(stderr, "kernel_launch: occupancy query gave %d\n", per_cu);
            per_cu = 1;
        }
        (void)hipGetLastError();
        grid_blocks = cus * 1;
        if (n_in != 27 || ws_size < (size_t)290 * 1024 * 1024) fprintf(stderr, "kernel_launch: unexpected n_in %d / ws %zu\n", n_in, ws_size);
    }
    Args a{};
    for (int i = 0; i < 27; ++i) a.in[i] = d_in[i];
    a.out = (float*)d_out;
    a.ws = (unsigned char*)d_ws;
    void* kargs[] = {&a};
    hipError_t e = hipLaunchCooperativeKernel((const void*)fwd_megakernel, dim3(grid_blocks), dim3(NTHREADS), kargs, LDS_BYTES, stream);
    if (e != hipSuccess) fprintf(stderr, "cooperative launch failed: %s (grid %d)\n", hipGetErrorString(e), grid_blocks);
}
```

```cpp
#include <hip/hip_runtime.h>
#include <hip/hip_cooperative_groups.h>
#include <cstdint>
#include <cstdio>
namespace cg = cooperative_groups;
namespace pg8 {
#define PG8_LAS __attribute__((address_space(3)))
typedef unsigned short bf16_t;
typedef short bf16x8 __attribute__((ext_vector_type(8)));
typedef float f32x4 __attribute__((ext_vector_type(4)));
typedef unsigned u32x4 __attribute__((ext_vector_type(4)));
constexpr int BM = 256, BK = 64, HALF = 128, HTB = HALF * BK * 2  , STAGE_BYTES = 8 * HTB, NXCD = 8, WGM = 8;

__host__ __device__ __forceinline__ int lds_byte(int r, int c) { const int st = (r >> 4) * 2 + (c >> 5), rr = r & 15, cc = c & 31, ob = rr * 64 + cc * 2; return st * 1024 + (ob ^ (((ob >> 9) & 1) << 5)); }
__host__ __device__ __forceinline__ void stage_rc(int b, int& R, int& C) { const int st = b / 1024, sb = b % 1024, swz = sb ^ (((sb >> 9) & 1) << 5); R = (st >> 1) * 16 + swz / 64; C = (st & 1) * 32 + (swz % 64) / 2; }
__host__ __device__ __forceinline__ int perm32(int rho) { const int n = rho >> 4, i = rho & 15; return 8 * (i >> 2) + 4 * n + (i & 3); }

struct Unit { int pm, pn; };
struct Gemm { const bf16_t* A; const bf16_t* Bt; int M, N, K; };

struct StaticOrder {
    int nM, nN, nwg, G, c;
    __host__ __device__ void init(int M, int N, int G_, int c_) { nM = M / BM; nN = N / BM; nwg = nM * nN; G = G_; c = c_; }
    __host__ __device__ bool next(int i, Unit& u) const {
        const long L = (long)i * G + c; if (L >= nwg) return false;
        int wgid = (int)L; { const int q = nwg / NXCD, r = nwg % NXCD, xcd = wgid % NXCD, off = wgid / NXCD; wgid = (xcd < r ? xcd * (q + 1) : r * (q + 1) + (xcd - r) * q) + off; }
        const int nig = WGM * nN, gid = wgid / nig, fm = gid * WGM, gsz = (nM - fm) < WGM ? (nM - fm) : WGM;
        u.pm = fm + ((wgid % nig) % gsz); u.pn = (wgid % nig) / gsz; return true;
    }
    __device__ __forceinline__ void a_ready(const Unit&) const {}
    __device__ __forceinline__ void done(const Unit&) const {}
};

__device__ __forceinline__ unsigned cvt_pk_bf16(float lo, float hi) { unsigned r; asm volatile("v_cvt_pk_bf16_f32 %0, %1, %2" : "=v"(r) : "v"(lo), "v"(hi)); return r; }
typedef float f32x2 __attribute__((ext_vector_type(2)));
__device__ __forceinline__ f32x2 gelu_pk(f32x2 v) {
    const f32x2 av = __builtin_elementwise_abs(v), d = av * 0.2316418882f + 1.0f;
    f32x2 t; t.x = __builtin_amdgcn_rcpf(d.x); t.y = __builtin_amdgcn_rcpf(d.y);
    f32x2 q = t * 0.5307027145f + (-0.7265760135f); q = q * t + 0.7107068705f; q = q * t + (-0.142248368f); q = q * t + 0.127414796f; q = q * t;
    const f32x2 s = (v * v) * (-0.72134752044f);
    f32x2 e; e.x = __builtin_amdgcn_exp2f(s.x); e.y = __builtin_amdgcn_exp2f(s.y);
    const f32x2 m = v * (q * e), r = v - m;
    f32x2 o; o.x = v.x < 0.f ? m.x : r.x; o.y = v.y < 0.f ? m.y : r.y; return o;
}

template <int ACT  > struct EpiBf16 {
    static constexpr bool PERM = true, AFTER_DRAIN = false; static_assert(ACT == 0 || ACT == 1, "EpiBf16: ACT is 0 (none) or 1 (gelu_pk)");
    bf16_t* O; int ldc; const float* bias; int split_cols; size_t split_stride; float scale0;
    __device__ __forceinline__ void operator()(const f32x4 (&acc)[2][2][4][2], const Unit& u, int wr, int wc, int fr, int fq) const {
        const int row0 = u.pm * BM + wr * 64 + fr; int colt = u.pn * BM; bf16_t* base = O;
        float sc = 1.f; if (split_cols) { const int t = colt / split_cols; base += (size_t)t * split_stride; colt -= t * split_cols; if (t == 0) sc = scale0; }
        const int col0 = colt + wc * 32 + 8 * fq, bcol0 = u.pn * BM + wc * 32 + 8 * fq;
        f32x4 bv[2][2];
#pragma unroll
        for (int bj = 0; bj < 2; ++bj)
#pragma unroll
            for (int n = 0; n < 2; ++n) bv[bj][n] = bias ? *(const f32x4*)(bias + bcol0 + bj * HALF + 4 * n) : (f32x4){0.f, 0.f, 0.f, 0.f};
#pragma unroll
        for (int ai = 0; ai < 2; ++ai)
#pragma unroll
            for (int m = 0; m < 4; ++m) { bf16_t* rowp = base + (size_t)(row0 + ai * HALF + m * 16) * ldc + col0;
#pragma unroll
                for (int bj = 0; bj < 2; ++bj) { f32x4 v0 = acc[ai][bj][m][0] + bv[bj][0], v1 = acc[ai][bj][m][1] + bv[bj][1];
                    if (ACT == 1) { f32x2 a = gelu_pk((f32x2){v0[0], v0[1]}), b = gelu_pk((f32x2){v0[2], v0[3]}), c = gelu_pk((f32x2){v1[0], v1[1]}), d = gelu_pk((f32x2){v1[2], v1[3]});
                        v0 = (f32x4){a.x, a.y, b.x, b.y}; v1 = (f32x4){c.x, c.y, d.x, d.y}; }
                    v0 = v0 * sc; v1 = v1 * sc; u32x4 w; w.x = cvt_pk_bf16(v0[0], v0[1]); w.y = cvt_pk_bf16(v0[2], v0[3]); w.z = cvt_pk_bf16(v1[0], v1[1]); w.w = cvt_pk_bf16(v1[2], v1[3]);
                    *(u32x4*)(rowp + bj * HALF) = w; } }
    }
};

struct PanelStats {
    unsigned* xbuf;
    unsigned* cnt;
    unsigned* tmo;
    int ntn; float eps;
    unsigned code;
    __device__ __forceinline__ bool run(const f32x4 (&v)[2][2][4][2], const Unit& u, int wr, int wc, int fr, int fq, PG8_LAS unsigned char* lds, int wid, int lane) const {
        typedef float f32x2v __attribute__((ext_vector_type(2)));
        PG8_LAS f32x2v* P = (PG8_LAS f32x2v*)lds;
        PG8_LAS f32x2v* S = (PG8_LAS f32x2v*)(lds + 8192);
        PG8_LAS unsigned* flag = (PG8_LAS unsigned*)(lds + 8192 + 2048);
#pragma unroll
        for (int ai = 0; ai < 2; ++ai)
#pragma unroll
            for (int m = 0; m < 4; ++m) {
                float s = 0.f;
#pragma unroll
                for (int bj = 0; bj < 2; ++bj)
#pragma unroll
                    for (int n = 0; n < 2; ++n) { const f32x4 x = v[ai][bj][m][n]; s += (x[0] + x[1]) + (x[2] + x[3]); }
                s += __shfl_xor(s, 16); s += __shfl_xor(s, 32);
                const float mw = s * (1.0f / 64.0f); float q = 0.f;
#pragma unroll
                for (int bj = 0; bj < 2; ++bj)
#pragma unroll
                    for (int n = 0; n < 2; ++n) { const f32x4 d = v[ai][bj][m][n] - mw; q += (d[0] * d[0] + d[1] * d[1]) + (d[2] * d[2] + d[3] * d[3]); }
                q += __shfl_xor(q, 16); q += __shfl_xor(q, 32);
                if (fq == 0) P[(ai * HALF + wr * 64 + m * 16 + fr) * 4 + wc] = (f32x2v){mw, q};
            }
        asm volatile("s_waitcnt lgkmcnt(0)" ::: "memory"); __builtin_amdgcn_s_barrier(); asm volatile("" ::: "memory");
#if defined(BROKEN_EXCHANGE_NO_WAIT)
#warning BROKEN CONTROL BUILD: the row-statistics exchange does not wait; results are wrong by design
        if (blockIdx.x >= 64) { const long long t0_ = clock64(); while (clock64() - t0_ < 60000) __builtin_amdgcn_s_sleep(8); }
#endif
        const int row = wid * 32 + (lane & 31);
        if (lane < 32) {
            const f32x2v a = P[row * 4 + 0], b = P[row * 4 + 1], c = P[row * 4 + 2], d = P[row * 4 + 3];
            const float mt = (a.x + b.x + c.x + d.x) * 0.25f;
            const float da = a.x - mt, db = b.x - mt, dc = c.x - mt, dd = d.x - mt;
            const float m2 = (a.y + b.y) + (c.y + d.y) + 64.0f * ((da * da + db * db) + (dc * dc + dd * dd));
            unsigned long long* slot = (unsigned long long*)xbuf + ((size_t)(u.pm * BM + row) * 4 + u.pn);
            __hip_atomic_store(slot, ((unsigned long long)__float_as_uint(m2) << 32) | __float_as_uint(mt), __ATOMIC_RELAXED, __HIP_MEMORY_SCOPE_AGENT);
        }
        asm volatile("s_waitcnt vmcnt(0)" ::: "memory");
        if (lane == 0) __hip_atomic_fetch_add(cnt + 64 * u.pm, 1u, __ATOMIC_RELAXED, __HIP_MEMORY_SCOPE_AGENT);
        if (wid == 0) {
            bool dead = false; const unsigned long long t0 = __builtin_amdgcn_s_memrealtime(); const unsigned want = 8u * (unsigned)ntn;
            for (;;) {
#if defined(BROKEN_EXCHANGE_NO_WAIT)
                break;
#endif
                if ((unsigned)__builtin_amdgcn_readfirstlane(__hip_atomic_load(cnt + 64 * u.pm, __ATOMIC_RELAXED, __HIP_MEMORY_SCOPE_AGENT)) >= want) break;
                if (__builtin_amdgcn_s_memrealtime() - t0 > 2000000ull) {
                    if (lane == 0) { unsigned expect = 0u; __hip_atomic_compare_exchange_strong(tmo + 1, &expect, code | (unsigned)(u.pm & 0xff), __ATOMIC_RELAXED, __ATOMIC_RELAXED, __HIP_MEMORY_SCOPE_AGENT);
                                     __hip_atomic_store(tmo, 1u, __ATOMIC_RELAXED, __HIP_MEMORY_SCOPE_AGENT); }
                    dead = true; break; }
                __builtin_amdgcn_s_sleep(2);
            }
            __builtin_amdgcn_fence(__ATOMIC_ACQUIRE, "agent");
            if (lane == 0) flag[0] = dead ? 1u : 0u;
        }
        asm volatile("s_waitcnt vmcnt(0) lgkmcnt(0)" ::: "memory"); __builtin_amdgcn_s_barrier(); asm volatile("" ::: "memory");
        const bool bad = flag[0] != 0u;
        if (lane < 32) {
            const unsigned long long* slot = (const unsigned long long*)xbuf + (size_t)(u.pm * BM + row) * 4; float mt[4], m2[4]; float ms = 0.f;
#pragma unroll
            for (int t = 0; t < 4; ++t) { if (t < ntn) { const unsigned long long w = __hip_atomic_load(slot + t, __ATOMIC_RELAXED, __HIP_MEMORY_SCOPE_AGENT); mt[t] = __uint_as_float((unsigned)w); m2[t] = __uint_as_float((unsigned)(w >> 32)); } else { mt[t] = 0.f; m2[t] = 0.f; } ms += mt[t]; }
            const float mean = ms / (float)ntn; float q = 0.f;
#pragma unroll
            for (int t = 0; t < 4; ++t) if (t < ntn) { const float dm = mt[t] - mean; q += m2[t] + 256.0f * dm * dm; }
            S[row] = (f32x2v){mean, 1.0f / sqrtf(q / (256.0f * (float)ntn) + eps)};
        }
        asm volatile("s_waitcnt lgkmcnt(0)" ::: "memory"); __builtin_amdgcn_s_barrier(); asm volatile("" ::: "memory");
        return bad;
    }
};
struct EpiLnRes {
    static constexpr bool PERM = false, AFTER_DRAIN = true;
    const float* base; float* out; int ldc; const float* bias; PanelStats st; unsigned poison;
    __device__ __forceinline__ void fused(f32x4 (&acc)[2][2][4][2], const Unit& u, int wr, int wc, int fr, int fq, PG8_LAS unsigned char* lds, int wid, int lane) const {
        typedef float f32x2v __attribute__((ext_vector_type(2)));
        const PG8_LAS f32x2v* S = (const PG8_LAS f32x2v*)(lds + 8192);
        const int col0 = u.pn * BM + wc * 32 + 4 * fq;
#pragma unroll
        for (int bj = 0; bj < 2; ++bj)
#pragma unroll
            for (int n = 0; n < 2; ++n) { const f32x4 bv = bias ? *(const f32x4*)(bias + col0 + bj * HALF + n * 16) : (f32x4){0.f, 0.f, 0.f, 0.f};
#pragma unroll
                for (int ai = 0; ai < 2; ++ai)
#pragma unroll
                    for (int m = 0; m < 4; ++m) acc[ai][bj][m][n] += bv; }
        f32x4 pre[4][2][2];
#pragma unroll
        for (int m = 0; m < 4; ++m) { const size_t off = (size_t)(u.pm * BM + wr * 64 + m * 16 + fr) * ldc + col0;
#pragma unroll
            for (int bj = 0; bj < 2; ++bj)
#pragma unroll
                for (int n = 0; n < 2; ++n) pre[m][bj][n] = *(const f32x4*)(base + off + bj * HALF + n * 16); }
        const bool bad = st.run(acc, u, wr, wc, fr, fq, lds, wid, lane) || poison != 0u;
        const float qnan = __builtin_nanf("");
#pragma unroll
        for (int ai = 0; ai < 2; ++ai)
#pragma unroll
            for (int m = 0; m < 4; ++m) { const int r = ai * HALF + wr * 64 + m * 16 + fr; const f32x2v sr = S[r]; const size_t off = (size_t)(u.pm * BM + r) * ldc + col0;
#pragma unroll
                for (int bj = 0; bj < 2; ++bj)
#pragma unroll
                    for (int n = 0; n < 2; ++n) { const f32x4 bs = ai == 0 ? pre[m][bj][n] : *(const f32x4*)(base + off + bj * HALF + n * 16); f32x4 o = bs + (acc[ai][bj][m][n] - sr.x) * sr.y;
                        if (bad) o = (f32x4){qnan, qnan, qnan, qnan}; *(f32x4*)(out + off + bj * HALF + n * 16) = o; }
                if (m & 1) asm volatile("" ::: "memory"); }
    }
};
struct EpiLnResLn {
    static constexpr bool PERM = false, AFTER_DRAIN = true;
    const float* base; float* out; bf16_t* xn; int ldc; const float* bias; PanelStats st1, st2; unsigned poison;
    __device__ __forceinline__ void fused(f32x4 (&acc)[2][2][4][2], const Unit& u, int wr, int wc, int fr, int fq, PG8_LAS unsigned char* lds, int wid, int lane) const {
        typedef float f32x2v __attribute__((ext_vector_type(2))); typedef unsigned u32x2v __attribute__((ext_vector_type(2)));
        const PG8_LAS f32x2v* S = (const PG8_LAS f32x2v*)(lds + 8192);
        const int col0 = u.pn * BM + wc * 32 + 4 * fq;
#pragma unroll
        for (int bj = 0; bj < 2; ++bj)
#pragma unroll
            for (int n = 0; n < 2; ++n) { const f32x4 bv = bias ? *(const f32x4*)(bias + col0 + bj * HALF + n * 16) : (f32x4){0.f, 0.f, 0.f, 0.f};
#pragma unroll
                for (int ai = 0; ai < 2; ++ai)
#pragma unroll
                    for (int m = 0; m < 4; ++m) acc[ai][bj][m][n] += bv; }
        bool bad = st1.run(acc, u, wr, wc, fr, fq, lds, wid, lane) || poison != 0u;
        const float qnan = __builtin_nanf("");
#pragma unroll
        for (int ai = 0; ai < 2; ++ai)
#pragma unroll
            for (int m = 0; m < 4; ++m) { const int r = ai * HALF + wr * 64 + m * 16 + fr; const f32x2v sr = S[r]; const size_t off = (size_t)(u.pm * BM + r) * ldc + col0;
#pragma unroll
                for (int bj = 0; bj < 2; ++bj)
#pragma unroll
                    for (int n = 0; n < 2; ++n) { const f32x4 bs = *(const f32x4*)(base + off + bj * HALF + n * 16); acc[ai][bj][m][n] = bs + (acc[ai][bj][m][n] - sr.x) * sr.y; }
                asm volatile("" : "+v"(acc[ai][0][m][0]), "+v"(acc[ai][0][m][1]), "+v"(acc[ai][1][m][0]), "+v"(acc[ai][1][m][1]));
                if (m & 1) asm volatile("" ::: "memory"); }
        const bool bad1 = bad;
        bad = st2.run(acc, u, wr, wc, fr, fq, lds, wid, lane) || bad;
#pragma unroll
        for (int ai = 0; ai < 2; ++ai)
#pragma unroll
            for (int m = 0; m < 4; ++m) { const int r = ai * HALF + wr * 64 + m * 16 + fr; const f32x2v sr = S[r]; const size_t off = (size_t)(u.pm * BM + r) * ldc + col0;
#pragma unroll
                for (int bj = 0; bj < 2; ++bj)
#pragma unroll
                    for (int n = 0; n < 2; ++n) { const f32x4 x1 = acc[ai][bj][m][n]; *(f32x4*)(out + off + bj * HALF + n * 16) = bad1 ? (f32x4){qnan, qnan, qnan, qnan} : x1;
                        const f32x4 o = (x1 - sr.x) * sr.y; u32x2v w; w.x = cvt_pk_bf16(o[0], o[1]); w.y = cvt_pk_bf16(o[2], o[3]);
                        if (bad) { w.x = 0x7fc07fc0u; w.y = 0x7fc07fc0u; } *(u32x2v*)(xn + off + bj * HALF + n * 16) = w; }
                asm volatile("" ::: "memory"); }
    }
};

template <class Epi, class Sched, bool ALIGN_EPI = false, bool SP2 = false>
__device__ __forceinline__ void gemm_phase(PG8_LAS unsigned char* lds, const Gemm g, const Sched& S, const Epi& E) {
    int tid_ = threadIdx.x; asm volatile("" : "+v"(tid_));
    const int tid = tid_, wid = __builtin_amdgcn_readfirstlane(tid >> 6), lane = tid & 63, wr = wid >> 2, wc = wid & 3, fr = lane & 15, fq = lane >> 4;
    const int K = g.K, nt = K / BK;
    unsigned voffA[2], voffB[2];
#pragma unroll
    for (int i = 0; i < 2; ++i) { int R, C; stage_rc(tid * 16 + i * 8192, R, C); const int Rb = Epi::PERM ? ((R & ~31) + perm32(R & 31)) : R;
        voffA[i] = (unsigned)(R * K + C) * 2u; voffB[i] = (unsigned)(Rb * K + C) * 2u; }
    const size_t kstep = (size_t)(BK * 2);
    const size_t hstep = (size_t)HALF * K * 2;
    const size_t tstep = 2 * hstep;
    const unsigned ldsw = (unsigned)wid * 1024u;
    const int aoff = lds_byte(wr * 64 + fr, fq * 8), boff = lds_byte(wc * 32 + fr, fq * 8);
#define PG8_SA(b, h) (((b) * 2 + (h)) * HTB)
#define PG8_SB(b, h) ((4 + (b) * 2 + (h)) * HTB)
#define PG8_STAGE(bufoff, gbase, voff) do { _Pragma("unroll") for (int _i = 0; _i < 2; ++_i) \
        __builtin_amdgcn_global_load_lds((const unsigned*)((const char*)(gbase) + (voff)[_i]), (PG8_LAS unsigned*)(lds + (bufoff) + ldsw + _i * 8192), 16, 0, 0); } while (0)
#define PG8_LDA(dst, b, h) do { _Pragma("unroll") for (int m = 0; m < 4; ++m) _Pragma("unroll") for (int k = 0; k < 2; ++k) dst[m][k] = *(const PG8_LAS bf16x8*)(lds + PG8_SA(b, h) + aoff + m * 2048 + k * 1024); } while (0)
#define PG8_LDB(dst, b, h) do { _Pragma("unroll") for (int n = 0; n < 2; ++n) _Pragma("unroll") for (int k = 0; k < 2; ++k) dst[n][k] = *(const PG8_LAS bf16x8*)(lds + PG8_SB(b, h) + boff + n * 2048 + k * 1024); } while (0)
#define PG8_MMA(ai, bj, At, Bt) do { __builtin_amdgcn_s_setprio(1); _Pragma("unroll") for (int m = 0; m < 4; ++m) _Pragma("unroll") for (int n = 0; n < 2; ++n) _Pragma("unroll") for (int k = 0; k < 2; ++k) \
        acc[ai][bj][m][n] = __builtin_amdgcn_mfma_f32_16x16x32_bf16(Bt[n][k], At[m][k], acc[ai][bj][m][n], 0, 0, 0); __builtin_amdgcn_s_setprio(0); } while (0)
#define PG8_WAIT_V(n) asm volatile("s_waitcnt vmcnt(" #n ")" ::: "memory")
#define PG8_WAIT_L(n) asm volatile("s_waitcnt lgkmcnt(" #n ")" ::: "memory")
#define PG8_BAR __builtin_amdgcn_s_barrier()
#define PG8_SCHED __builtin_amdgcn_sched_barrier(0)
    Unit cur, nxt; int ui = 0;
    if (!S.next(0, cur)) return;
    f32x4 acc[2][2][4][2];
#pragma unroll
    for (int a = 0; a < 2; ++a)
#pragma unroll
        for (int b = 0; b < 2; ++b)
#pragma unroll
            for (int m = 0; m < 4; ++m)
#pragma unroll
                for (int n = 0; n < 2; ++n) acc[a][b][m][n] = (f32x4){0.f, 0.f, 0.f, 0.f};
    bf16x8 At[4][2], B0[2][2], B1[2][2];
    const char* cA = (const char*)g.A + (size_t)cur.pm * tstep; const char* cB = (const char*)g.Bt + (size_t)cur.pn * tstep;
    S.a_ready(cur);
    if constexpr (SP2) {
        PG8_STAGE(PG8_SB(0, 0), cB, voffB); PG8_STAGE(PG8_SB(0, 1), cB + hstep, voffB); PG8_STAGE(PG8_SA(0, 0), cA, voffA); PG8_STAGE(PG8_SA(0, 1), cA + hstep, voffA);
        if (wr == 1) PG8_BAR;
        PG8_WAIT_V(2); PG8_BAR;
        PG8_STAGE(PG8_SB(1, 0), cB + kstep, voffB); PG8_STAGE(PG8_SA(1, 0), cA + kstep, voffA); PG8_STAGE(PG8_SB(1, 1), cB + hstep + kstep, voffB);
        PG8_WAIT_V(6); PG8_BAR;
    } else {
        PG8_STAGE(PG8_SB(0, 0), cB, voffB); PG8_STAGE(PG8_SA(0, 0), cA, voffA); PG8_STAGE(PG8_SB(0, 1), cB + hstep, voffB); PG8_STAGE(PG8_SA(0, 1), cA + hstep, voffA);
        if (wr == 1) PG8_BAR;
        PG8_WAIT_V(4); PG8_BAR;
        PG8_STAGE(PG8_SB(1, 0), cB + kstep, voffB); PG8_STAGE(PG8_SA(1, 0), cA + kstep, voffA); PG8_STAGE(PG8_SB(1, 1), cB + hstep + kstep, voffB);
        PG8_WAIT_V(6); PG8_BAR;
    }
    for (;;) {
        const bool has_next = S.next(ui + 1, nxt);
        const char* nA = has_next ? (const char*)g.A + (size_t)nxt.pm * tstep : cA; const char* nB = has_next ? (const char*)g.Bt + (size_t)nxt.pn * tstep : cB;
        for (int t = 0; t < nt; t += 2) {
            const bool last = (t == nt - 2);
            const char* a1 = cA + (size_t)(t + 1) * kstep;
            const char* a2 = last ? nA : cA + (size_t)(t + 2) * kstep; const char* b2 = last ? nB : cB + (size_t)(t + 2) * kstep;
            const char* a3 = a2 + kstep; const char* b3 = b2 + kstep;
            if (last && has_next) S.a_ready(nxt);
            if constexpr (SP2) {
            PG8_LDB(B0, 0, 0); PG8_LDB(B1, 0, 1); PG8_SCHED; PG8_LDA(At, 0, 0); PG8_STAGE(PG8_SA(1, 1), a1 + hstep, voffA);
            PG8_WAIT_V(8); PG8_WAIT_L(0); PG8_BAR; PG8_MMA(0, 0, At, B0); PG8_MMA(0, 1, At, B1); PG8_BAR; PG8_SCHED;
            PG8_LDA(At, 0, 1); PG8_STAGE(PG8_SB(0, 0), b2, voffB); PG8_STAGE(PG8_SB(0, 1), b2 + hstep, voffB); PG8_STAGE(PG8_SA(0, 0), a2, voffA);
            PG8_WAIT_V(8); PG8_WAIT_L(0); PG8_BAR; PG8_MMA(1, 0, At, B0); PG8_MMA(1, 1, At, B1); PG8_BAR; PG8_SCHED;
            PG8_LDB(B0, 1, 0); PG8_LDB(B1, 1, 1); PG8_SCHED; PG8_LDA(At, 1, 0); PG8_STAGE(PG8_SA(0, 1), a2 + hstep, voffA);
            PG8_WAIT_V(8); PG8_WAIT_L(0); PG8_BAR; PG8_MMA(0, 0, At, B0); PG8_MMA(0, 1, At, B1); PG8_BAR; PG8_SCHED;
            PG8_LDA(At, 1, 1); PG8_STAGE(PG8_SB(1, 0), b3, voffB); PG8_STAGE(PG8_SB(1, 1), b3 + hstep, voffB); PG8_STAGE(PG8_SA(1, 0), a3, voffA);
            PG8_WAIT_V(8); PG8_WAIT_L(0); PG8_BAR; PG8_MMA(1, 0, At, B0); PG8_MMA(1, 1, At, B1); PG8_BAR; PG8_SCHED;
            } else {
            PG8_LDB(B0, 0, 0); PG8_SCHED; PG8_LDA(At, 0, 0); PG8_STAGE(PG8_SA(1, 1), a1 + hstep, voffA);
            PG8_WAIT_L(8); PG8_BAR; PG8_WAIT_L(0); PG8_MMA(0, 0, At, B0); PG8_BAR; PG8_SCHED;
            PG8_LDB(B1, 0, 1); PG8_STAGE(PG8_SB(0, 0), b2, voffB);
            PG8_BAR; PG8_WAIT_L(0); PG8_MMA(0, 1, At, B1); PG8_BAR;
            PG8_LDA(At, 0, 1); PG8_STAGE(PG8_SA(0, 0), a2, voffA);
            PG8_BAR; PG8_WAIT_L(0); PG8_MMA(1, 0, At, B0); PG8_BAR; PG8_SCHED;
            PG8_STAGE(PG8_SB(0, 1), b2 + hstep, voffB);
            PG8_WAIT_V(6); PG8_BAR; PG8_MMA(1, 1, At, B1); PG8_BAR;
            PG8_LDB(B0, 1, 0); PG8_SCHED; PG8_LDA(At, 1, 0); PG8_STAGE(PG8_SA(0, 1), a2 + hstep, voffA);
            PG8_WAIT_L(8); PG8_BAR; PG8_WAIT_L(0); PG8_MMA(0, 0, At, B0); PG8_BAR; PG8_SCHED;
            PG8_LDB(B1, 1, 1); PG8_STAGE(PG8_SB(1, 0), b3, voffB);
            PG8_BAR; PG8_WAIT_L(0); PG8_MMA(0, 1, At, B1); PG8_BAR;
            PG8_LDA(At, 1, 1); PG8_STAGE(PG8_SA(1, 0), a3, voffA);
            PG8_BAR; PG8_WAIT_L(0); PG8_MMA(1, 0, At, B0); PG8_BAR; PG8_SCHED;
            PG8_STAGE(PG8_SB(1, 1), b3 + hstep, voffB);
            PG8_WAIT_V(6); PG8_BAR; PG8_MMA(1, 1, At, B1); PG8_BAR;
            }
        }
        if constexpr (ALIGN_EPI) { if (wr == 0) PG8_BAR; }
        if constexpr (!Epi::AFTER_DRAIN) { E(acc, cur, wr, wc, fr, fq); S.done(cur); }
        if (!has_next) break;
#pragma unroll
        for (int a = 0; a < 2; ++a)
#pragma unroll
            for (int b = 0; b < 2; ++b)
#pragma unroll
                for (int m = 0; m < 4; ++m)
#pragma unroll
                    for (int n = 0; n < 2; ++n) acc[a][b][m][n] = (f32x4){0.f, 0.f, 0.f, 0.f};
        cur = nxt; cA = nA; cB = nB; ++ui;
        if constexpr (ALIGN_EPI) { if (wr == 1) PG8_BAR; }
    }
    PG8_WAIT_V(0);
    if constexpr (!ALIGN_EPI) { if (wr == 0) PG8_BAR; }
    PG8_BAR;
    if constexpr (Epi::AFTER_DRAIN) { E.fused(acc, cur, wr, wc, fr, fq, lds, wid, lane); S.done(cur); }
#undef PG8_SA
#undef PG8_SB
#undef PG8_STAGE
#undef PG8_LDA
#undef PG8_LDB
#undef PG8_MMA
#undef PG8_WAIT_V
#undef PG8_WAIT_L
#undef PG8_BAR
#undef PG8_SCHED
}
}

#ifndef PG8_SP2
#define PG8_SP2 true
#endif
#ifndef PG8_ALIGN
#define PG8_ALIGN true
#endif

namespace {
constexpr int D_MODEL = 1024, BATCH = 2, SEQ = 8192, NTOK = BATCH * SEQ;
constexpr int AB_IN = 2560, C_IN = 1536;
constexpr int N_EXP = 16, D_FF = 512, PLE_DIM = 256;
constexpr float ALPHA = 1.4142135623730951f;
constexpr float LN_EPS = 1e-5f;
constexpr int NTHREADS = 512, NWAVES = 8;
constexpr int LDS_BYTES = 147456;
#define LAS __attribute__((address_space(3)))
#define GAS __attribute__((address_space(1)))
typedef unsigned short bf16_t;
typedef unsigned v4u __attribute__((ext_vector_type(4)));
typedef unsigned v2u __attribute__((ext_vector_type(2)));
typedef float f32x4 __attribute__((ext_vector_type(4)));

constexpr size_t MiB = 1u << 20;
constexpr size_t WS_CTL = 0;
constexpr size_t WS_W_IN = 1 * MiB, WS_W_OUTAB = 6 * MiB, WS_W_QKV = 8 * MiB, WS_W_OUTC = 11 * MiB, WS_W_PLEG = 13 * MiB, WS_W_PLEP = 17 * MiB;
constexpr size_t WS_W_GU = 18 * MiB, WS_W_DN = 50 * MiB;
constexpr size_t WS_PROJ = 66 * MiB;
constexpr size_t WS_MIX = 146 * MiB;
constexpr size_t WS_XNA = 182 * MiB, WS_XNB = 214 * MiB;
constexpr size_t WS_PP = 246 * MiB;
constexpr size_t WS_PB = 278 * MiB;
constexpr size_t WS_EIDX = 294 * MiB, WS_GATEW = 295 * MiB, WS_LIST = 296 * MiB, WS_POS = 297 * MiB;
constexpr size_t WS_END = 298 * MiB;
constexpr size_t WS_XS = WS_PROJ;
constexpr size_t WS_H = WS_MIX;
constexpr int MISC_OFF = 131072;
constexpr int CW_CNT = 64;

__device__ __forceinline__ float softplusf(float z) { return fmaxf(z, 0.f) + log1pf(expf(-fabsf(z))); }
__device__ __forceinline__ float sigmoidf_(float z) { return 1.f / (1.f + expf(-z)); }
__device__ __forceinline__ float wave_sum(float v) {
#pragma unroll
    for (int o = 1; o < 64; o <<= 1) v += __shfl_xor(v, o);
    return v;
}
__device__ __forceinline__ float gelu_tanh(float x) {
    const float c = 0.7978845608028654f;
    return 0.5f * x * (1.f + tanhf(c * (x + 0.044715f * x * x * x)));
}
__device__ __forceinline__ unsigned f2bf(float f) { unsigned u = __builtin_bit_cast(unsigned, f); return (u + 0x7fffu + ((u >> 16) & 1u)) >> 16; }
__device__ __forceinline__ unsigned pk2(float lo, float hi) { return f2bf(lo) | (f2bf(hi) << 16); }
__device__ __forceinline__ float bf2f(bf16_t v) { return __uint_as_float((unsigned)v << 16); }
__device__ __forceinline__ float bflo(unsigned w) { return __uint_as_float(w << 16); }
__device__ __forceinline__ float bfhi(unsigned w) { return __uint_as_float(w & 0xffff0000u); }
template <class T> __device__ __forceinline__ T* lnd(T* p) { asm volatile("" : "+s"(p)); return p; }
__device__ __forceinline__ int tid_opaque() { int t = threadIdx.x; asm volatile("" : "+v"(t)); return t; }

struct EpiF32 {
    static constexpr bool PERM = false, AFTER_DRAIN = false;
    float* O; int ldc;
    __device__ __forceinline__ void operator()(const pg8::f32x4 (&acc)[2][2][4][2], const pg8::Unit& u, int wr, int wc, int fr, int fq) const {
        const int row0 = u.pm * 256 + wr * 64 + fr, col0 = u.pn * 256 + wc * 32 + 4 * fq;
#pragma unroll
        for (int ai = 0; ai < 2; ++ai)
#pragma unroll
            for (int m = 0; m < 4; ++m) { float* rowp = O + (size_t)(row0 + ai * 128 + m * 16) * ldc + col0;
#pragma unroll
                for (int bj = 0; bj < 2; ++bj)
#pragma unroll
                    for (int n = 0; n < 2; ++n) *(pg8::f32x4*)(rowp + bj * 128 + n * 16) = acc[ai][bj][m][n]; }
    }
};
struct EpiPle {
    static constexpr bool PERM = false, AFTER_DRAIN = false;
    float* X; const bf16_t* PP; bf16_t* XB; const float* bias;
    __device__ __forceinline__ void operator()(const pg8::f32x4 (&acc)[2][2][4][2], const pg8::Unit& u, int wr, int wc, int fr, int fq) const {
        const int row0 = u.pm * 256 + wr * 64 + fr, col0 = u.pn * 256 + wc * 32 + 4 * fq;
        pg8::f32x4 bv[2][2];
#pragma unroll
        for (int bj = 0; bj < 2; ++bj)
#pragma unroll
            for (int n = 0; n < 2; ++n) bv[bj][n] = *(const pg8::f32x4*)(bias + col0 + bj * 128 + n * 16);
#pragma unroll
        for (int ai = 0; ai < 2; ++ai)
#pragma unroll
            for (int m = 0; m < 4; ++m) { const size_t off = (size_t)(row0 + ai * 128 + m * 16) * D_MODEL + col0;
#pragma unroll
                for (int bj = 0; bj < 2; ++bj)
#pragma unroll
                    for (int n = 0; n < 2; ++n) { const size_t o = off + bj * 128 + n * 16;
                        const pg8::f32x4 x2 = *(const pg8::f32x4*)(X + o); const v2u pw = *(const v2u*)(PP + o);
                        const pg8::f32x4 z = acc[ai][bj][m][n] + bv[bj][n];
                        pg8::f32x4 r;
                        r[0] = x2[0] + bflo(pw.x) * __builtin_amdgcn_rcpf(1.f + __expf(-z[0]));
                        r[1] = x2[1] + bfhi(pw.x) * __builtin_amdgcn_rcpf(1.f + __expf(-z[1]));
                        r[2] = x2[2] + bflo(pw.y) * __builtin_amdgcn_rcpf(1.f + __expf(-z[2]));
                        r[3] = x2[3] + bfhi(pw.y) * __builtin_amdgcn_rcpf(1.f + __expf(-z[3]));
                        *(pg8::f32x4*)(X + o) = r; v2u w; w.x = pk2(r[0], r[1]); w.y = pk2(r[2], r[3]); *(v2u*)(XB + o) = w; } }
    }
};

struct EpiGU {
    static constexpr bool PERM = true, AFTER_DRAIN = false;
    bf16_t* H;
    __device__ __forceinline__ void operator()(const pg8::f32x4 (&acc)[2][2][4][2], const pg8::Unit& u, int wr, int wc, int fr, int fq) const {
        const int row0 = u.pm * 256 + wr * 64 + fr, col0 = (u.pn & 3) * 128 + wc * 32 + 8 * fq;
#pragma unroll
        for (int ai = 0; ai < 2; ++ai)
#pragma unroll
            for (int m = 0; m < 4; ++m) { bf16_t* rowp = H + (size_t)(row0 + ai * 128 + m * 16) * D_FF + col0;
                float hv[8];
#pragma unroll
                for (int n = 0; n < 2; ++n)
#pragma unroll
                    for (int j = 0; j < 4; ++j) { const float g = acc[ai][0][m][n][j], up = acc[ai][1][m][n][j]; hv[n * 4 + j] = g * __builtin_amdgcn_rcpf(1.f + __expf(-g)) * up; }
                v4u w; w.x = pk2(hv[0], hv[1]); w.y = pk2(hv[2], hv[3]); w.z = pk2(hv[4], hv[5]); w.w = pk2(hv[6], hv[7]);
                *(v4u*)rowp = w; }
    }
};
struct EpiBf16N {
    static constexpr bool PERM = true, AFTER_DRAIN = false;
    bf16_t* O; int ldc;
    __device__ __forceinline__ void operator()(const pg8::f32x4 (&acc)[2][2][4][2], const pg8::Unit& u, int wr, int wc, int fr, int fq) const {
        const int row0 = u.pm * 256 + wr * 64 + fr, col0 = (u.pn & 3) * 256 + wc * 32 + 8 * fq;
#pragma unroll
        for (int ai = 0; ai < 2; ++ai)
#pragma unroll
            for (int m = 0; m < 4; ++m) { bf16_t* rowp = O + (size_t)(row0 + ai * 128 + m * 16) * ldc + col0;
#pragma unroll
                for (int bj = 0; bj < 2; ++bj) { const pg8::f32x4 v0 = acc[ai][bj][m][0], v1 = acc[ai][bj][m][1];
                    v4u w; w.x = pk2(v0[0], v0[1]); w.y = pk2(v0[2], v0[3]); w.z = pk2(v1[0], v1[1]); w.w = pk2(v1[2], v1[3]);
                    *(v4u*)(rowp + bj * 128) = w; } }
    }
};
struct MoeOrder {
    const LAS int* tile_off;
    int G, c;
    __device__ __forceinline__ bool next(int i, pg8::Unit& u) const {
        const int T = tile_off[16];
        const int L = i * G + c; if (L >= T * 4) return false;
        const int rt = L >> 2; int e = 0;
#pragma unroll
        for (int k = 1; k < 16; ++k) e += (rt >= tile_off[k]) ? 1 : 0;
        u.pm = rt; u.pn = __builtin_amdgcn_readfirstlane(e * 4 + (L & 3)); return true;
    }
    __device__ __forceinline__ void a_ready(const pg8::Unit&) const {}
    __device__ __forceinline__ void done(const pg8::Unit&) const {}
};

__device__ __forceinline__ void p0_transpose_item(const float* W, int K, int N, bf16_t* WT, int row_off, LAS float* scr, int item, int lane) {
    const int nblk = N / 32, kb = item / nblk, nb = item % nblk, k0 = 64 * kb, n0 = 32 * nb;
#pragma unroll 8
    for (int i = 0; i < 32; ++i) { const int kk = 2 * i + (lane >> 5); scr[kk * 33 + (lane & 31)] = W[(size_t)(k0 + kk) * N + n0 + (lane & 31)]; }
    asm volatile("s_waitcnt lgkmcnt(0)" ::: "memory");
    const int c = lane & 7;
#pragma unroll
    for (int j = 0; j < 4; ++j) { const int n = (lane >> 3) + 8 * j; const LAS float* s = scr + (8 * c) * 33 + n;
        v4u o; o.x = pk2(s[0 * 33], s[1 * 33]); o.y = pk2(s[2 * 33], s[3 * 33]); o.z = pk2(s[4 * 33], s[5 * 33]); o.w = pk2(s[6 * 33], s[7 * 33]);
        *(v4u*)(WT + (size_t)(row_off + n0 + n) * K + k0 + 8 * c) = o; }
    asm volatile("s_waitcnt lgkmcnt(0)" ::: "memory");
}
__device__ __forceinline__ void row1024_to_bf16(const float* xrow, bf16_t* orow, int lane) {
    const f32x4* xr = (const f32x4*)xrow + lane;
    v2u* o8 = (v2u*)orow + lane;
#pragma unroll
    for (int j = 0; j < 4; ++j) { const f32x4 v = xr[64 * j]; v2u w; w.x = pk2(v[0], v[1]); w.y = pk2(v[2], v[3]); o8[64 * j] = w; }
}

__device__ __forceinline__ void ph_sb_attn(unsigned char* lds, const bf16_t* proj, bf16_t* mix) {
    float (*Ks)[64] = (float (*)[64])(lds);
    float (*Vs)[64] = (float (*)[64])(lds + 16384);
    const int tid = tid_opaque(), qi = tid >> 1, hf = tid & 1;
    for (int unit = blockIdx.x; unit < BATCH * 8 * (SEQ / 256); unit += gridDim.x) {
        const int qc = (SEQ / 256 - 1) - unit / (BATCH * 8), bh = unit % (BATCH * 8), b = bh >> 3, h = bh & 7;
        const int t = qc * 256 + qi;
        float q[32], acc[32];
        const bf16_t* qp = proj + (size_t)(b * SEQ + t) * AB_IN + h * 64 + hf * 32;
#pragma unroll
        for (int d = 0; d < 32; ++d) { q[d] = bf2f(qp[d]) * 0.125f; acc[d] = 0.f; }
        float cum = 0.f;
        for (int kt = qc * 4 + 3; kt >= 0; --kt) {
            __syncthreads();
#pragma unroll
            for (int e = 0; e < 8; ++e) {
                const int idx = tid + e * 512, r = idx >> 6, c = idx & 63;
                const bf16_t* rp = proj + (size_t)(b * SEQ + kt * 64 + r) * AB_IN + h * 64;
                Ks[r][c] = bf2f(rp[512 + c]);
                Vs[r][c] = bf2f(rp[1024 + c]);
            }
            __syncthreads();
            for (int j = 63; j >= 0; --j) {
                const int s = kt * 64 + j;
                float z = 0.f;
#pragma unroll
                for (int d = 0; d < 32; ++d) z += q[d] * Ks[j][hf * 32 + d];
                z += __shfl_xor(z, 1);
                const bool valid = s < t;
                const float sp = softplusf(z);
                const float w = valid ? expf(z - sp + cum) : 0.f;
#pragma unroll
                for (int d = 0; d < 32; ++d) acc[d] += w * Vs[j][hf * 32 + d];
                if (valid) cum -= sp;
            }
        }
        bf16_t* op = mix + (size_t)(b * SEQ + t) * D_MODEL + h * 64 + hf * 32;
#pragma unroll
        for (int d = 0; d < 32; ++d) op[d] = (bf16_t)f2bf(acc[d]);
    }
}
__device__ __forceinline__ void ph_lru_gates(unsigned char* lds, const bf16_t* proj, const float* conv_w, const float* conv_b, const float* w_r, const float* b_r,
                                             const float* w_i, const float* b_i, const float* lam, float* a_out, float* u_out) {
    float* xc = (float*)(lds + 65536);
    const int c = tid_opaque();
    for (int tok = blockIdx.x; tok < NTOK; tok += gridDim.x) {
        asm volatile("" ::: "memory");
        const int tpos = tok % SEQ;
        float y = conv_b[c];
#pragma unroll
        for (int k = 0; k < 4; ++k) {
            const int tt = tpos - 3 + k;
            if (tt >= 0) y += conv_w[k * 512 + c] * bf2f(proj[(size_t)(tok - 3 + k) * AB_IN + 1536 + c]);
        }
        __syncthreads();
        xc[c] = y;
        __syncthreads();
        const int n = c >> 6, d = c & 63;
        float gr = b_r[c], gi = b_i[c];
#pragma unroll 4
        for (int cc = 0; cc < 64; ++cc) {
            const float xv = xc[n * 64 + cc];
            gr += xv * w_r[(n * 64 + cc) * 64 + d];
            gi += xv * w_i[(n * 64 + cc) * 64 + d];
        }
        const float r = sigmoidf_(gr), ig = sigmoidf_(gi);
        const float log_a = -8.0f * r * softplusf(-lam[c]);
        a_out[(size_t)tok * 512 + c] = expf(log_a);
        u_out[(size_t)tok * 512 + c] = sqrtf(-expm1f(2.0f * log_a)) * (ig * y);
    }
}
__device__ __forceinline__ void ph_lru_scan(const float* a_in, const float* u_in, const bf16_t* proj, bf16_t* mix) {
    if (blockIdx.x >= BATCH) return;
    const int b = blockIdx.x, c = tid_opaque();
    float h = 0.f;
#pragma unroll 8
    for (int t = 0; t < SEQ; ++t) {
        const size_t tok = (size_t)b * SEQ + t;
        h = a_in[tok * 512 + c] * h + u_in[tok * 512 + c];
        const float g = bf2f(proj[tok * AB_IN + 2048 + c]);
        mix[tok * D_MODEL + 512 + c] = (bf16_t)f2bf(gelu_tanh(g) * h);
    }
}
template <bool ROUTER>
__device__ __forceinline__ void ph_res_ln(const float* x, const float* h, const float* g, const float* bta, float* out, bf16_t* outb, const float* w_router,
                                          const float* b_router, int* eidx, float* gatew) {
    const int tid0 = tid_opaque(), lane = tid0 & 63, wave = tid0 >> 6;
    for (int row = blockIdx.x * 8 + wave; row < NTOK; row += gridDim.x * 8) {
        asm volatile("" ::: "memory");
        const float4* xr = (const float4*)(x + (size_t)row * D_MODEL);
        const float4* hr = (const float4*)(h + (size_t)row * D_MODEL);
        float4 v[4];
        float s = 0.f;
#pragma unroll
        for (int j = 0; j < 4; ++j) {
            const float4 a = xr[lane + 64 * j], c = hr[lane + 64 * j];
            v[j] = make_float4(ALPHA * a.x + c.x, ALPHA * a.y + c.y, ALPHA * a.z + c.z, ALPHA * a.w + c.w);
            s += (v[j].x + v[j].y) + (v[j].z + v[j].w);
        }
        const float mean = wave_sum(s) * (1.f / D_MODEL);
        float s2 = 0.f;
#pragma unroll
        for (int j = 0; j < 4; ++j) {
            v[j].x -= mean; v[j].y -= mean; v[j].z -= mean; v[j].w -= mean;
            s2 += (v[j].x * v[j].x + v[j].y * v[j].y) + (v[j].z * v[j].z + v[j].w * v[j].w);
        }
        const float rstd = 1.f / sqrtf(wave_sum(s2) * (1.f / D_MODEL) + LN_EPS);
        float4* orow = (float4*)(out + (size_t)row * D_MODEL);
        v2u* brow = (v2u*)(outb + (size_t)row * D_MODEL);
#pragma unroll
        for (int j = 0; j < 4; ++j) {
            const float4 gg = ((const float4*)g)[lane + 64 * j], bb = ((const float4*)bta)[lane + 64 * j];
            v[j] = make_float4(v[j].x * rstd * gg.x + bb.x, v[j].y * rstd * gg.y + bb.y, v[j].z * rstd * gg.z + bb.z, v[j].w * rstd * gg.w + bb.w);
            orow[lane + 64 * j] = v[j];
            v2u w; w.x = pk2(v[j].x, v[j].y); w.y = pk2(v[j].z, v[j].w); brow[lane + 64 * j] = w;
        }
        if (ROUTER) {
            float lg[16];
#pragma unroll
            for (int e = 0; e < 16; ++e) lg[e] = 0.f;
#pragma unroll
            for (int j = 0; j < 4; ++j) {
                const float xv[4] = {v[j].x, v[j].y, v[j].z, v[j].w};
#pragma unroll
                for (int k = 0; k < 4; ++k) {
                    const int d = 4 * (lane + 64 * j) + k;
                    const float4* wr = (const float4*)(w_router + d * 16);
#pragma unroll
                    for (int q4 = 0; q4 < 4; ++q4) {
                        const float4 w = wr[q4];
                        lg[q4 * 4 + 0] += xv[k] * w.x; lg[q4 * 4 + 1] += xv[k] * w.y; lg[q4 * 4 + 2] += xv[k] * w.z; lg[q4 * 4 + 3] += xv[k] * w.w;
                    }
                }
            }
#pragma unroll
            for (int e = 0; e < 16; ++e) lg[e] = wave_sum(lg[e]) + b_router[e];
            if (lane == 0) {
                float mx = lg[0];
#pragma unroll
                for (int e = 1; e < 16; ++e) mx = fmaxf(mx, lg[e]);
                float p[16], sum = 0.f;
#pragma unroll
                for (int e = 0; e < 16; ++e) { p[e] = expf(lg[e] - mx); sum += p[e]; }
                const float inv = 1.f / sum;
#pragma unroll
                for (int e = 0; e < 16; ++e) p[e] *= inv;
                int gsel = 0; float gbest = -1.f;
#pragma unroll
                for (int gq = 0; gq < 4; ++gq) {
                    float m1 = -1.f, m2 = -1.f;
#pragma unroll
                    for (int k = 0; k < 4; ++k) { const float pv = p[gq * 4 + k]; if (pv > m1) { m2 = m1; m1 = pv; } else if (pv > m2) { m2 = pv; } }
                    const float sc = m1 + m2;
                    if (sc > gbest) { gbest = sc; gsel = gq; }
                }
                float m1 = -1.f, m2 = -1.f; int i1 = 0, i2 = 0;
#pragma unroll
                for (int gq = 0; gq < 4; ++gq) {
                    if (gq == gsel) {
#pragma unroll
                        for (int k = 0; k < 4; ++k) { const float pv = p[gq * 4 + k]; if (pv > m1) { m2 = m1; i2 = i1; m1 = pv; i1 = k; } else if (pv > m2) { m2 = pv; i2 = k; } }
                    }
                }
                const float wsum = m1 + m2;
                eidx[row * 2 + 0] = gsel * 4 + i1; eidx[row * 2 + 1] = gsel * 4 + i2;
                gatew[row * 2 + 0] = m1 / wsum; gatew[row * 2 + 1] = m2 / wsum;
            }
        }
    }
}
__device__ __forceinline__ void ph_moe_naive(unsigned char* lds, const float* x, const int* eidx, const float* gatew, const float* wg, const float* wu, const float* wd, float* m) {
    float* xs = (float*)(lds + 65536);
    float* hs = (float*)(lds + 65536 + 4096);
    const int tid = tid_opaque();
    for (int tok = blockIdx.x; tok < NTOK; tok += gridDim.x) {
        __syncthreads();
        xs[tid] = x[(size_t)tok * D_MODEL + tid]; xs[tid + 512] = x[(size_t)tok * D_MODEL + tid + 512];
        float o0 = 0.f, o1 = 0.f;
        for (int kk = 0; kk < 2; ++kk) {
            const int e = eidx[tok * 2 + kk];
            const float gw = gatew[tok * 2 + kk];
            const float* wge = wg + (size_t)e * D_MODEL * D_FF;
            const float* wue = wu + (size_t)e * D_MODEL * D_FF;
            const float* wde = wd + (size_t)e * D_FF * D_MODEL;
            __syncthreads();
            float g0 = 0.f, u0 = 0.f;
#pragma unroll 4
            for (int d = 0; d < 1024; ++d) {
                const float xv = xs[d];
                g0 += xv * wge[(size_t)d * D_FF + tid];
                u0 += xv * wue[(size_t)d * D_FF + tid];
            }
            hs[tid] = g0 * sigmoidf_(g0) * u0 * gw;
            __syncthreads();
#pragma unroll 4
            for (int f = 0; f < 512; ++f) {
                const float hv = hs[f];
                o0 += hv * wde[(size_t)f * D_MODEL + tid];
                o1 += hv * wde[(size_t)f * D_MODEL + tid + 512];
            }
        }
        m[(size_t)tok * D_MODEL + tid] = o0; m[(size_t)tok * D_MODEL + tid + 512] = o1;
    }
}
__device__ __forceinline__ void ph_rope(bf16_t* proj, const int* positions) {
    for (size_t idx = (size_t)blockIdx.x * NTHREADS + tid_opaque(); idx < (size_t)NTOK * 20 * 32; idx += (size_t)gridDim.x * NTHREADS) {
        const int i = (int)(idx & 31), hh = (int)((idx >> 5) % 20);
        const size_t tok = idx / (32 * 20);
        const float inv_freq = powf(10000.0f, -(float)i / 32.0f);
        const float ang = (float)positions[tok] * inv_freq;
        const float c = cosf(ang), s = sinf(ang);
        bf16_t* p = proj + tok * C_IN + hh * 64;
        const float x1 = bf2f(p[i]), x2 = bf2f(p[i + 32]);
        p[i] = (bf16_t)f2bf(x1 * c - x2 * s);
        p[i + 32] = (bf16_t)f2bf(x2 * c + x1 * s);
    }
}
__device__ __forceinline__ void ph_swa_attn(unsigned char* lds, const bf16_t* proj, const float* sinks, bf16_t* mix) {
    float (*Ks)[64] = (float (*)[64])(lds);
    float (*Vs)[64] = (float (*)[64])(lds + 16384);
    const int tid = tid_opaque(), qi = tid >> 1, hf = tid & 1;
    for (int unit = blockIdx.x; unit < BATCH * 16 * (SEQ / 256); unit += gridDim.x) {
        const int qc = unit / (BATCH * 16), bh = unit % (BATCH * 16), b = bh >> 4, hq = bh & 15, kv = hq >> 2;
        const int t = qc * 256 + qi;
        float q[32], acc[32];
        const bf16_t* qp = proj + (size_t)(b * SEQ + t) * C_IN + hq * 64 + hf * 32;
#pragma unroll
        for (int d = 0; d < 32; ++d) { q[d] = bf2f(qp[d]) * 0.125f; acc[d] = 0.f; }
        float mrun = sinks[hq], l = 1.f;
        for (int kt = qc * 4 - 2; kt <= qc * 4 + 3; ++kt) {
            if (kt < 0) continue;
            __syncthreads();
#pragma unroll
            for (int e = 0; e < 8; ++e) {
                const int idx = tid + e * 512, r = idx >> 6, c = idx & 63;
                const bf16_t* rp = proj + (size_t)(b * SEQ + kt * 64 + r) * C_IN;
                Ks[r][c] = bf2f(rp[1024 + kv * 64 + c]);
                Vs[r][c] = bf2f(rp[1280 + kv * 64 + c]);
            }
            __syncthreads();
            for (int j = 0; j < 64; ++j) {
                const int s = kt * 64 + j;
                float z = 0.f;
#pragma unroll
                for (int d = 0; d < 32; ++d) z += q[d] * Ks[j][hf * 32 + d];
                z += __shfl_xor(z, 1);
                const bool valid = (s <= t) && (t - s < 128);
                if (valid) {
                    const float mn = fmaxf(mrun, z);
                    const float sc = expf(mrun - mn), pw = expf(z - mn);
                    l = l * sc + pw;
#pragma unroll
                    for (int d = 0; d < 32; ++d) acc[d] = acc[d] * sc + pw * Vs[j][hf * 32 + d];
                    mrun = mn;
                }
            }
        }
        const float inv = 1.f / l;
        bf16_t* op = mix + (size_t)(b * SEQ + t) * D_MODEL + hq * 64 + hf * 32;
#pragma unroll
        for (int d = 0; d < 32; ++d) op[d] = (bf16_t)f2bf(acc[d] * inv);
    }
}

__device__ __forceinline__ void ph_route(unsigned char* lds, const float* x1, const float* w_router, const float* b_router, float* gatew, unsigned* cnt, int* list) {
    const int tid = tid_opaque(), lane = tid & 63, wave = tid >> 6;
    int* s_e = (int*)(lds + MISC_OFF);
    int* s_rank = s_e + 128;
    int* s_cnt = s_rank + 128;
    int* s_base = s_cnt + 16;
    for (int base = blockIdx.x * 64; base < NTOK; base += gridDim.x * 64) {
        __syncthreads();
        if (tid < 16) s_cnt[tid] = 0;
        __syncthreads();
#pragma unroll 1
        for (int rr = 0; rr < 8; rr += 4) {
            asm volatile("" ::: "memory");
            const int row0 = base + wave * 8 + rr;
            float lg[4][16];
#pragma unroll
            for (int r = 0; r < 4; ++r)
#pragma unroll
                for (int e = 0; e < 16; ++e) lg[r][e] = 0.f;
#pragma unroll 1
            for (int j = 0; j < 4; ++j) {
                asm volatile("" ::: "memory");
                f32x4 xv[4];
#pragma unroll
                for (int r = 0; r < 4; ++r) xv[r] = *((const f32x4*)(x1 + (size_t)(row0 + r) * D_MODEL) + lane + 64 * j);
#pragma unroll
                for (int k = 0; k < 4; ++k) {
                    const int d = 4 * (lane + 64 * j) + k;
                    const f32x4* wr = (const f32x4*)(w_router + d * 16);
#pragma unroll
                    for (int q4 = 0; q4 < 4; ++q4) {
                        const f32x4 w = wr[q4];
#pragma unroll
                        for (int r = 0; r < 4; ++r) { lg[r][q4 * 4 + 0] += xv[r][k] * w[0]; lg[r][q4 * 4 + 1] += xv[r][k] * w[1]; lg[r][q4 * 4 + 2] += xv[r][k] * w[2]; lg[r][q4 * 4 + 3] += xv[r][k] * w[3]; }
                    }
                }
            }
#pragma unroll
            for (int r = 0; r < 4; ++r) {
#pragma unroll
                for (int e = 0; e < 16; ++e) lg[r][e] = wave_sum(lg[r][e]) + b_router[e];
                float mx = lg[r][0];
#pragma unroll
                for (int e = 1; e < 16; ++e) mx = fmaxf(mx, lg[r][e]);
                float p[16], sum = 0.f;
#pragma unroll
                for (int e = 0; e < 16; ++e) { p[e] = expf(lg[r][e] - mx); sum += p[e]; }
                const float inv = 1.f / sum;
#pragma unroll
                for (int e = 0; e < 16; ++e) p[e] *= inv;
                int gsel = 0; float gbest = -1.f;
#pragma unroll
                for (int gq = 0; gq < 4; ++gq) {
                    float m1 = -1.f, m2 = -1.f;
#pragma unroll
                    for (int k = 0; k < 4; ++k) { const float pv = p[gq * 4 + k]; if (pv > m1) { m2 = m1; m1 = pv; } else if (pv > m2) { m2 = pv; } }
                    const float sc = m1 + m2;
                    if (sc > gbest) { gbest = sc; gsel = gq; }
                }
                float m1 = -1.f, m2 = -1.f; int i1 = 0, i2 = 0;
#pragma unroll
                for (int gq = 0; gq < 4; ++gq) {
                    if (gq == gsel) {
#pragma unroll
                        for (int k = 0; k < 4; ++k) { const float pv = p[gq * 4 + k]; if (pv > m1) { m2 = m1; i2 = i1; m1 = pv; i1 = k; } else if (pv > m2) { m2 = pv; i2 = k; } }
                    }
                }
                if (lane == 0) {
                    const int row = row0 + r, tl = row - base, e1 = gsel * 4 + i1, e2 = gsel * 4 + i2;
                    const float wsum = m1 + m2;
                    gatew[row * 2 + 0] = m1 / wsum; gatew[row * 2 + 1] = m2 / wsum;
                    s_e[tl * 2 + 0] = e1; s_e[tl * 2 + 1] = e2;
                    s_rank[tl * 2 + 0] = atomicAdd(&s_cnt[e1], 1);
                    s_rank[tl * 2 + 1] = atomicAdd(&s_cnt[e2], 1);
                }
            }
        }
        __syncthreads();
        if (tid < 16) s_base[tid] = (int)__hip_atomic_fetch_add(cnt + tid, (unsigned)s_cnt[tid], __ATOMIC_RELAXED, __HIP_MEMORY_SCOPE_AGENT);
        __syncthreads();
        if (tid < 128) { const int e = s_e[tid]; list[e * NTOK + s_base[e] + s_rank[tid]] = (base + (tid >> 1)) * 2 + (tid & 1); }
    }
}
__device__ __forceinline__ void moe_offsets(unsigned char* lds, const unsigned* cnt) {
    int* t_off = (int*)(lds + MISC_OFF + 2048);
    __syncthreads();
    if (threadIdx.x == 0) {
        int acc = 0;
        for (int e = 0; e < 16; ++e) { const int c = (int)__hip_atomic_load(cnt + e, __ATOMIC_RELAXED, __HIP_MEMORY_SCOPE_AGENT); t_off[e] = acc; t_off[32 + e] = c; acc += (c + 255) >> 8; }
        t_off[16] = acc;
    }
    __syncthreads();
}
__device__ __forceinline__ void ph_permute(unsigned char* lds, const unsigned* cnt, const int* list, const bf16_t* x1b, bf16_t* xs, int* pos) {
    moe_offsets(lds, cnt);
    const int* t_off = (const int*)(lds + MISC_OFF + 2048);
    const int tid = tid_opaque(), lane = tid & 63, wave = tid >> 6;
    const int R = t_off[16] * 256;
    for (int r = blockIdx.x * NWAVES + wave; r < R; r += gridDim.x * NWAVES) {
        const int rt = r >> 8; int e = 0;
#pragma unroll
        for (int k = 1; k < 16; ++k) e += (rt >= t_off[k]) ? 1 : 0;
        const int i = r - t_off[e] * 256;
        if (i < t_off[32 + e]) {
            const int ent = list[e * NTOK + i], tok = ent >> 1;
            const v4u* src = (const v4u*)(x1b + (size_t)tok * D_MODEL);
            v4u* dst = (v4u*)(xs + (size_t)r * D_MODEL);
            dst[lane] = src[lane]; dst[lane + 64] = src[lane + 64];
            if (lane == 0) pos[ent] = r;
        }
    }
}
__device__ __forceinline__ void ph_combine_ln(const float* x, const bf16_t* Y, const int* pos, const float* gatew, const float* g, const float* bta, float* out, bf16_t* outb) {
    const int tid0 = tid_opaque(), lane = tid0 & 63, wave = tid0 >> 6;
    for (int row = blockIdx.x * 8 + wave; row < NTOK; row += gridDim.x * 8) {
        asm volatile("" ::: "memory");
        const int p0 = pos[row * 2], p1 = pos[row * 2 + 1];
        const float w0 = gatew[row * 2], w1 = gatew[row * 2 + 1];
        const float4* xr = (const float4*)(x + (size_t)row * D_MODEL);
        const v2u* y0 = (const v2u*)(Y + (size_t)p0 * D_MODEL);
        const v2u* y1 = (const v2u*)(Y + (size_t)p1 * D_MODEL);
        float4 v[4];
        float s = 0.f;
#pragma unroll
        for (int j = 0; j < 4; ++j) {
            const float4 a = xr[lane + 64 * j]; const v2u a0 = y0[lane + 64 * j], a1 = y1[lane + 64 * j];
            v[j] = make_float4(ALPHA * a.x + (w0 * bflo(a0.x) + w1 * bflo(a1.x)), ALPHA * a.y + (w0 * bfhi(a0.x) + w1 * bfhi(a1.x)),
                               ALPHA * a.z + (w0 * bflo(a0.y) + w1 * bflo(a1.y)), ALPHA * a.w + (w0 * bfhi(a0.y) + w1 * bfhi(a1.y)));
            s += (v[j].x + v[j].y) + (v[j].z + v[j].w);
        }
        const float mean = wave_sum(s) * (1.f / D_MODEL);
        float s2 = 0.f;
#pragma unroll
        for (int j = 0; j < 4; ++j) {
            v[j].x -= mean; v[j].y -= mean; v[j].z -= mean; v[j].w -= mean;
            s2 += (v[j].x * v[j].x + v[j].y * v[j].y) + (v[j].z * v[j].z + v[j].w * v[j].w);
        }
        const float rstd = 1.f / sqrtf(wave_sum(s2) * (1.f / D_MODEL) + LN_EPS);
        float4* orow = (float4*)(out + (size_t)row * D_MODEL);
        v2u* brow = (v2u*)(outb + (size_t)row * D_MODEL);
#pragma unroll
        for (int j = 0; j < 4; ++j) {
            const float4 gg = ((const float4*)g)[lane + 64 * j], bb = ((const float4*)bta)[lane + 64 * j];
            v[j] = make_float4(v[j].x * rstd * gg.x + bb.x, v[j].y * rstd * gg.y + bb.y, v[j].z * rstd * gg.z + bb.z, v[j].w * rstd * gg.w + bb.w);
            orow[lane + 64 * j] = v[j];
            v2u w; w.x = pk2(v[j].x, v[j].y); w.y = pk2(v[j].z, v[j].w); brow[lane + 64 * j] = w;
        }
    }
}
__device__ __forceinline__ void ph_convert_experts(LAS unsigned char* ldsl, const float* wg, const float* wu, const float* wd, bf16_t* W_GU, bf16_t* W_DN) {
    const int tid = tid_opaque(), lane = tid & 63, wave = __builtin_amdgcn_readfirstlane(tid >> 6);
    LAS float* scr = (LAS float*)(ldsl + wave * 16384);
    const int gw = blockIdx.x * NWAVES + wave, NGW = gridDim.x * NWAVES;
    for (int it = gw; it < 16 * 768; it += NGW) {
        const int e = it / 768, r = it % 768;
        if (r < 512) {
            const int bj = r >> 8, item = r & 255, n0 = 32 * (item % 16);
            const float* W = (bj ? wu : wg) + (size_t)e * D_MODEL * D_FF;
            p0_transpose_item(W, 1024, 512, W_GU + (size_t)e * 1024 * 1024, 256 * (n0 >> 7) + 128 * bj + (n0 & 127) - n0, scr, item, lane);
        } else {
            p0_transpose_item(wd + (size_t)e * D_FF * D_MODEL, 512, 1024, W_DN + (size_t)e * 1024 * 512, 0, scr, r - 512, lane);
        }
    }
}

struct Args {
    const void* in[27];
    float* out;
    unsigned char* ws;
};

__global__ void __launch_bounds__(NTHREADS, 2) fwd_megakernel(Args args) {
    extern __shared__ __attribute__((aligned(16))) unsigned char lds[];
    cg::grid_group grid = cg::this_grid();
#define GRID_BAR() grid.sync()
    const float* x_in = (const float*)args.in[0];
    const float* p_in = (const float*)args.in[1];
    const int* positions = (const int*)args.in[2];
    const float* w_in_ab = (const float*)args.in[3];
    const float* w_out_ab = (const float*)args.in[4];
    const float* conv_w = (const float*)args.in[5];
    const float* conv_b = (const float*)args.in[6];
    const float* lru_w_r = (const float*)args.in[7];
    const float* lru_b_r = (const float*)args.in[8];
    const float* lru_w_i = (const float*)args.in[9];
    const float* lru_b_i = (const float*)args.in[10];
    const float* lru_lambda = (const float*)args.in[11];
    const float* w_qkv_c = (const float*)args.in[12];
    const float* w_out_c = (const float*)args.in[13];
    const float* sinks_c = (const float*)args.in[14];
    const float* ln_mix_g = (const float*)args.in[15];
    const float* ln_mix_b = (const float*)args.in[16];
    const float* ln_ffn_g = (const float*)args.in[17];
    const float* ln_ffn_b = (const float*)args.in[18];
    const float* w_router = (const float*)args.in[19];
    const float* b_router = (const float*)args.in[20];
    const float* exp_w_gate = (const float*)args.in[21];
    const float* exp_w_up = (const float*)args.in[22];
    const float* exp_w_down = (const float*)args.in[23];
    const float* ple_w_proj = (const float*)args.in[24];
    const float* ple_w_gate = (const float*)args.in[25];
    const float* ple_b_gate = (const float*)args.in[26];
    float* out = args.out;
    unsigned char* ws = args.ws;
    bf16_t* W_IN = (bf16_t*)(ws + WS_W_IN); bf16_t* W_OUTAB = (bf16_t*)(ws + WS_W_OUTAB); bf16_t* W_QKV = (bf16_t*)(ws + WS_W_QKV); bf16_t* W_OUTC = (bf16_t*)(ws + WS_W_OUTC);
    bf16_t* W_PLEG = (bf16_t*)(ws + WS_W_PLEG); bf16_t* W_PLEP = (bf16_t*)(ws + WS_W_PLEP);
    bf16_t* PROJ = (bf16_t*)(ws + WS_PROJ); bf16_t* MIX = (bf16_t*)(ws + WS_MIX); bf16_t* XNA = (bf16_t*)(ws + WS_XNA); bf16_t* XNB = (bf16_t*)(ws + WS_XNB);
    bf16_t* PP = (bf16_t*)(ws + WS_PP); bf16_t* PB = (bf16_t*)(ws + WS_PB);
    int* EIDX = (int*)(ws + WS_EIDX); float* GATEW = (float*)(ws + WS_GATEW); int* LIST = (int*)(ws + WS_LIST); int* POS = (int*)(ws + WS_POS);
    unsigned* CTL = (unsigned*)(ws + WS_CTL);
    bf16_t* W_GU = (bf16_t*)(ws + WS_W_GU); bf16_t* W_DN = (bf16_t*)(ws + WS_W_DN); bf16_t* XS = (bf16_t*)(ws + WS_XS); bf16_t* HB = (bf16_t*)(ws + WS_H);
    float* HOUT = (float*)(ws + WS_PROJ);
    float* LRU_A = (float*)(ws + WS_XNA); float* LRU_U = (float*)(ws + WS_XNB);
    const int tid = threadIdx.x, lane = tid & 63, wave = __builtin_amdgcn_readfirstlane(tid >> 6);
    LAS unsigned char* ldsl = (LAS unsigned char*)lds;

    if (blockIdx.x == 0 && tid < 32) CTL[CW_CNT + tid] = 0u;
    ph_convert_experts(ldsl, lnd(exp_w_gate), lnd(exp_w_up), lnd(exp_w_down), lnd(W_GU), lnd(W_DN));
    {
        LAS float* scr = (LAS float*)(ldsl + wave * 16384);
        const int gw = blockIdx.x * NWAVES + wave, NGW = gridDim.x * NWAVES;
        constexpr int I_IN = 16 * 80, I_SQ = 16 * 32, I_QKV = 16 * 48, I_PP = 4 * 32;
        constexpr int NITEMS = I_IN + I_SQ + I_QKV + I_SQ + 2 * I_SQ + 2 * I_PP;
        for (int it = gw; it < NITEMS; it += NGW) {
            int r = it;
            if (r < I_IN) { p0_transpose_item(w_in_ab, 1024, 2560, W_IN, 0, scr, r, lane); continue; } r -= I_IN;
            if (r < I_SQ) { p0_transpose_item(w_out_ab, 1024, 1024, W_OUTAB, 0, scr, r, lane); continue; } r -= I_SQ;
            if (r < I_QKV) { p0_transpose_item(w_qkv_c, 1024, 1536, W_QKV, 0, scr, r, lane); continue; } r -= I_QKV;
            if (r < I_SQ) { p0_transpose_item(w_out_c, 1024, 1024, W_OUTC, 0, scr, r, lane); continue; } r -= I_SQ;
            if (r < I_SQ) { p0_transpose_item(ple_w_gate, 1024, 1024, W_PLEG, 0, scr, r, lane); continue; } r -= I_SQ;
            if (r < I_SQ) { p0_transpose_item(ple_w_gate + (size_t)1024 * 1024, 1024, 1024, W_PLEG + (size_t)1024 * 1024, 0, scr, r, lane); continue; } r -= I_SQ;
            if (r < I_PP) { p0_transpose_item(ple_w_proj, 256, 1024, W_PLEP, 0, scr, r, lane); continue; } r -= I_PP;
            p0_transpose_item(ple_w_proj + (size_t)256 * 1024, 256, 1024, W_PLEP + (size_t)1024 * 256, 0, scr, r, lane);
        }
        for (int m = gw; m < NTOK; m += NGW) row1024_to_bf16(x_in + (size_t)m * D_MODEL, XNA + (size_t)m * D_MODEL, lane);
        for (int m = gw; m < 2 * NTOK; m += NGW) {
            const f32x4 v = *((const f32x4*)(p_in + (size_t)m * PLE_DIM) + lane);
            v2u w; w.x = pk2(v[0], v[1]); w.y = pk2(v[2], v[3]);
            *((v2u*)(PB + (size_t)m * PLE_DIM) + lane) = w;
        }
    }
    GRID_BAR();

#pragma unroll
    for (int layer = 0; layer < 2; ++layer) {
        const float* xin = (layer == 0) ? x_in : out;
        if (layer == 0) {
            pg8::Gemm g{XNA, W_IN, NTOK, AB_IN, D_MODEL}; pg8::StaticOrder S; S.init(NTOK, AB_IN, (int)gridDim.x, (int)blockIdx.x);
            pg8::EpiBf16<0> E{PROJ, AB_IN, nullptr, 0, 0, 1.f};
            pg8::gemm_phase<pg8::EpiBf16<0>, pg8::StaticOrder, PG8_ALIGN, PG8_SP2>(ldsl, g, S, E);
        } else {
            pg8::Gemm g{XNA, W_QKV, NTOK, C_IN, D_MODEL}; pg8::StaticOrder S; S.init(NTOK, C_IN, (int)gridDim.x, (int)blockIdx.x);
            pg8::EpiBf16<0> E{PROJ, C_IN, nullptr, 0, 0, 1.f};
            pg8::gemm_phase<pg8::EpiBf16<0>, pg8::StaticOrder, PG8_ALIGN, PG8_SP2>(ldsl, g, S, E);
        }
        {
            pg8::Gemm g{PB + (size_t)layer * NTOK * PLE_DIM, W_PLEP + (size_t)layer * 1024 * 256, NTOK, D_MODEL, PLE_DIM}; pg8::StaticOrder S; S.init(NTOK, D_MODEL, (int)gridDim.x, (int)blockIdx.x);
            pg8::EpiBf16<0> E{PP, D_MODEL, nullptr, 0, 0, 1.f};
            pg8::gemm_phase<pg8::EpiBf16<0>, pg8::StaticOrder, PG8_ALIGN, PG8_SP2>(ldsl, g, S, E);
        }
        GRID_BAR();
        if (layer == 0) {
            ph_sb_attn(lds, lnd(PROJ), lnd(MIX));
            ph_lru_gates(lds, lnd(PROJ), lnd(conv_w), lnd(conv_b), lnd(lru_w_r), lnd(lru_b_r), lnd(lru_w_i), lnd(lru_b_i), lnd(lru_lambda), lnd(LRU_A), lnd(LRU_U));
            GRID_BAR();
            ph_lru_scan(lnd(LRU_A), lnd(LRU_U), lnd(PROJ), lnd(MIX));
        } else {
            ph_rope(lnd(PROJ), lnd(positions));
            GRID_BAR();
            ph_swa_attn(lds, lnd(PROJ), lnd(sinks_c), lnd(MIX));
        }
        GRID_BAR();
        {
            pg8::Gemm g{MIX, layer == 0 ? W_OUTAB : W_OUTC, NTOK, D_MODEL, D_MODEL}; pg8::StaticOrder S; S.init(NTOK, D_MODEL, (int)gridDim.x, (int)blockIdx.x);
            EpiF32 E{HOUT, D_MODEL};
            pg8::gemm_phase<EpiF32, pg8::StaticOrder, PG8_ALIGN, PG8_SP2>(ldsl, g, S, E);
        }
        GRID_BAR();
        ph_res_ln<false>(lnd(xin), lnd(HOUT), lnd(ln_mix_g + layer * D_MODEL), lnd(ln_mix_b + layer * D_MODEL), lnd(out), lnd(XNA), (const float*)nullptr, (const float*)nullptr, (int*)nullptr, (float*)nullptr);
        if (layer == 1) ph_convert_experts(ldsl, lnd(exp_w_gate + (size_t)N_EXP * D_MODEL * D_FF), lnd(exp_w_up + (size_t)N_EXP * D_MODEL * D_FF), lnd(exp_w_down + (size_t)N_EXP * D_FF * D_MODEL), lnd(W_GU), lnd(W_DN));
        GRID_BAR();
        ph_route(lds, lnd(out), lnd(w_router), lnd(b_router), lnd(GATEW), lnd(CTL + CW_CNT + 16 * layer), lnd(LIST));
        GRID_BAR();
        ph_permute(lds, lnd(CTL + CW_CNT + 16 * layer), lnd(LIST), lnd(XNA), lnd(XS), lnd(POS));
        GRID_BAR();
        {
            moe_offsets(lds, lnd(CTL + CW_CNT + 16 * layer));
            MoeOrder S{(const LAS int*)(ldsl + MISC_OFF + 2048), (int)gridDim.x, (int)blockIdx.x};
            pg8::Gemm g{XS, W_GU, 0, 0, D_MODEL};
            EpiGU E{HB};
            pg8::gemm_phase<EpiGU, MoeOrder, PG8_ALIGN, PG8_SP2>(ldsl, g, S, E);
        }
        GRID_BAR();
        {
            MoeOrder S{(const LAS int*)(ldsl + MISC_OFF + 2048), (int)gridDim.x, (int)blockIdx.x};
            pg8::Gemm g{HB, W_DN, 0, 0, D_FF};
            EpiBf16N E{XS, D_MODEL};
            pg8::gemm_phase<EpiBf16N, MoeOrder, PG8_ALIGN, PG8_SP2>(ldsl, g, S, E);
        }
        GRID_BAR();
        ph_combine_ln(lnd(out), lnd(XS), lnd(POS), lnd(GATEW), lnd(ln_ffn_g + layer * D_MODEL), lnd(ln_ffn_b + layer * D_MODEL), lnd(out), lnd(XNB));
        GRID_BAR();
        {
            pg8::Gemm g{XNB, W_PLEG + (size_t)layer * 1024 * 1024, NTOK, D_MODEL, D_MODEL}; pg8::StaticOrder S; S.init(NTOK, D_MODEL, (int)gridDim.x, (int)blockIdx.x);
            EpiPle E{out, PP, XNA, ple_b_gate + layer * D_MODEL};
            pg8::gemm_phase<EpiPle, pg8::StaticOrder, PG8_ALIGN, PG8_SP2>(ldsl, g, S, E);
        }
        if (layer == 0) GRID_BAR();
    }
}
}

extern "C" void kernel_launch(void* const* d_in, const int* in_sizes, int n_in, void* d_out, int out_size, void* d_ws, size_t ws_size,
                              hipStream_t stream) {
    static int grid_blocks = 0;
    if (grid_blocks == 0) {
        int dev = 0, cus = 0, per_cu = 0;
        (void)hipGetDevice(&dev);
        (void)hipDeviceGetAttribute(&cus, hipDeviceAttributeMultiprocessorCount, dev);
        if (hipFuncSetAttribute((const void*)fwd_megakernel, hipFuncAttributeMaxDynamicSharedMemorySize, LDS_BYTES) != hipSuccess)
            fprintf(stderr, "kernel_launch: hipFuncSetAttribute failed\n");
        if (hipOccupancyMaxActiveBlocksPerMultiprocessor(&per_cu, (const void*)fwd_megakernel, NTHREADS, LDS_BYTES) != hipSuccess || per_cu < 1) {
            fprintf(stderr, "kernel_launch: occupancy query gave %d\n", per_cu);
            per_cu = 1;
        }
        (void)hipGetLastError();
        grid_blocks = cus * 1;
        if (n_in != 27 || ws_size < WS_END) fprintf(stderr, "kernel_launch: unexpected n_in %d / ws %zu\n", n_in, ws_size);
    }
    Args a{};
    for (int i = 0; i < 27; ++i) a.in[i] = d_in[i];
    a.out = (float*)d_out;
    a.ws = (unsigned char*)d_ws;
    void* kargs[] = {&a};
    hipError_t e = hipLaunchCooperativeKernel((const void*)fwd_megakernel, dim3(grid_blocks), dim3(NTHREADS), kargs, LDS_BYTES, stream);
    if (e != hipSuccess) fprintf(stderr, "cooperative launch failed: %s (grid %d)\n", hipGetErrorString(e), grid_blocks);
}
```

```cpp
#include <hip/hip_runtime.h>
#include <hip/hip_cooperative_groups.h>
#include <cstdint>
#include <cstdio>
namespace cg = cooperative_groups;
namespace pg8 {
#define PG8_LAS __attribute__((address_space(3)))
typedef unsigned short bf16_t;
typedef short bf16x8 __attribute__((ext_vector_type(8)));
typedef float f32x4 __attribute__((ext_vector_type(4)));
typedef unsigned u32x4 __attribute__((ext_vector_type(4)));
constexpr int BM = 256, BK = 64, HALF = 128, HTB = HALF * BK * 2  , STAGE_BYTES = 8 * HTB, NXCD = 8, WGM = 8;

__host__ __device__ __forceinline__ int lds_byte(int r, int c) { const int st = (r >> 4) * 2 + (c >> 5), rr = r & 15, cc = c & 31, ob = rr * 64 + cc * 2; return st * 1024 + (ob ^ (((ob >> 9) & 1) << 5)); }
__host__ __device__ __forceinline__ void stage_rc(int b, int& R, int& C) { const int st = b / 1024, sb = b % 1024, swz = sb ^ (((sb >> 9) & 1) << 5); R = (st >> 1) * 16 + swz / 64; C = (st & 1) * 32 + (swz % 64) / 2; }
__host__ __device__ __forceinline__ int perm32(int rho) { const int n = rho >> 4, i = rho & 15; return 8 * (i >> 2) + 4 * n + (i & 3); }

struct Unit { int pm, pn; };
struct Gemm { const bf16_t* A; const bf16_t* Bt; int M, N, K; };

struct StaticOrder {
    int nM, nN, nwg, G, c;
    __host__ __device__ void init(int M, int N, int G_, int c_) { nM = M / BM; nN = N / BM; nwg = nM * nN; G = G_; c = c_; }
    __host__ __device__ bool next(int i, Unit& u) const {
        const long L = (long)i * G + c; if (L >= nwg) return false;
        int wgid = (int)L; { const int q = nwg / NXCD, r = nwg % NXCD, xcd = wgid % NXCD, off = wgid / NXCD; wgid = (xcd < r ? xcd * (q + 1) : r * (q + 1) + (xcd - r) * q) + off; }
        const int nig = WGM * nN, gid = wgid / nig, fm = gid * WGM, gsz = (nM - fm) < WGM ? (nM - fm) : WGM;
        u.pm = fm + ((wgid % nig) % gsz); u.pn = (wgid % nig) / gsz; return true;
    }
    __device__ __forceinline__ void a_ready(const Unit&) const {}
    __device__ __forceinline__ void done(const Unit&) const {}
};

__device__ __forceinline__ unsigned cvt_pk_bf16(float lo, float hi) { unsigned r; asm volatile("v_cvt_pk_bf16_f32 %0, %1, %2" : "=v"(r) : "v"(lo), "v"(hi)); return r; }
typedef float f32x2 __attribute__((ext_vector_type(2)));
__device__ __forceinline__ f32x2 gelu_pk(f32x2 v) {
    const f32x2 av = __builtin_elementwise_abs(v), d = av * 0.2316418882f + 1.0f;
    f32x2 t; t.x = __builtin_amdgcn_rcpf(d.x); t.y = __builtin_amdgcn_rcpf(d.y);
    f32x2 q = t * 0.5307027145f + (-0.7265760135f); q = q * t + 0.7107068705f; q = q * t + (-0.142248368f); q = q * t + 0.127414796f; q = q * t;
    const f32x2 s = (v * v) * (-0.72134752044f);
    f32x2 e; e.x = __builtin_amdgcn_exp2f(s.x); e.y = __builtin_amdgcn_exp2f(s.y);
    const f32x2 m = v * (q * e), r = v - m;
    f32x2 o; o.x = v.x < 0.f ? m.x : r.x; o.y = v.y < 0.f ? m.y : r.y; return o;
}

template <int ACT  > struct EpiBf16 {
    static constexpr bool PERM = true, AFTER_DRAIN = false; static_assert(ACT == 0 || ACT == 1, "EpiBf16: ACT is 0 (none) or 1 (gelu_pk)");
    bf16_t* O; int ldc; const float* bias; int split_cols; size_t split_stride; float scale0;
    __device__ __forceinline__ void operator()(const f32x4 (&acc)[2][2][4][2], const Unit& u, int wr, int wc, int fr, int fq) const {
        const int row0 = u.pm * BM + wr * 64 + fr; int colt = u.pn * BM; bf16_t* base = O;
        float sc = 1.f; if (split_cols) { const int t = colt / split_cols; base += (size_t)t * split_stride; colt -= t * split_cols; if (t == 0) sc = scale0; }
        const int col0 = colt + wc * 32 + 8 * fq, bcol0 = u.pn * BM + wc * 32 + 8 * fq;
        f32x4 bv[2][2];
#pragma unroll
        for (int bj = 0; bj < 2; ++bj)
#pragma unroll
            for (int n = 0; n < 2; ++n) bv[bj][n] = bias ? *(const f32x4*)(bias + bcol0 + bj * HALF + 4 * n) : (f32x4){0.f, 0.f, 0.f, 0.f};
#pragma unroll
        for (int ai = 0; ai < 2; ++ai)
#pragma unroll
            for (int m = 0; m < 4; ++m) { bf16_t* rowp = base + (size_t)(row0 + ai * HALF + m * 16) * ldc + col0;
#pragma unroll
                for (int bj = 0; bj < 2; ++bj) { f32x4 v0 = acc[ai][bj][m][0] + bv[bj][0], v1 = acc[ai][bj][m][1] + bv[bj][1];
                    if (ACT == 1) { f32x2 a = gelu_pk((f32x2){v0[0], v0[1]}), b = gelu_pk((f32x2){v0[2], v0[3]}), c = gelu_pk((f32x2){v1[0], v1[1]}), d = gelu_pk((f32x2){v1[2], v1[3]});
                        v0 = (f32x4){a.x, a.y, b.x, b.y}; v1 = (f32x4){c.x, c.y, d.x, d.y}; }
                    v0 = v0 * sc; v1 = v1 * sc; u32x4 w; w.x = cvt_pk_bf16(v0[0], v0[1]); w.y = cvt_pk_bf16(v0[2], v0[3]); w.z = cvt_pk_bf16(v1[0], v1[1]); w.w = cvt_pk_bf16(v1[2], v1[3]);
                    *(u32x4*)(rowp + bj * HALF) = w; } }
    }
};

struct PanelStats {
    unsigned* xbuf;
    unsigned* cnt;
    unsigned* tmo;
    int ntn; float eps;
    unsigned code;
    __device__ __forceinline__ bool run(const f32x4 (&v)[2][2][4][2], const Unit& u, int wr, int wc, int fr, int fq, PG8_LAS unsigned char* lds, int wid, int lane) const {
        typedef float f32x2v __attribute__((ext_vector_type(2)));
        PG8_LAS f32x2v* P = (PG8_LAS f32x2v*)lds;
        PG8_LAS f32x2v* S = (PG8_LAS f32x2v*)(lds + 8192);
        PG8_LAS unsigned* flag = (PG8_LAS unsigned*)(lds + 8192 + 2048);
#pragma unroll
        for (int ai = 0; ai < 2; ++ai)
#pragma unroll
            for (int m = 0; m < 4; ++m) {
                float s = 0.f;
#pragma unroll
                for (int bj = 0; bj < 2; ++bj)
#pragma unroll
                    for (int n = 0; n < 2; ++n) { const f32x4 x = v[ai][bj][m][n]; s += (x[0] + x[1]) + (x[2] + x[3]); }
                s += __shfl_xor(s, 16); s += __shfl_xor(s, 32);
                const float mw = s * (1.0f / 64.0f); float q = 0.f;
#pragma unroll
                for (int bj = 0; bj < 2; ++bj)
#pragma unroll
                    for (int n = 0; n < 2; ++n) { const f32x4 d = v[ai][bj][m][n] - mw; q += (d[0] * d[0] + d[1] * d[1]) + (d[2] * d[2] + d[3] * d[3]); }
                q += __shfl_xor(q, 16); q += __shfl_xor(q, 32);
                if (fq == 0) P[(ai * HALF + wr * 64 + m * 16 + fr) * 4 + wc] = (f32x2v){mw, q};
            }
        asm volatile("s_waitcnt lgkmcnt(0)" ::: "memory"); __builtin_amdgcn_s_barrier(); asm volatile("" ::: "memory");
#if defined(BROKEN_EXCHANGE_NO_WAIT)
#warning BROKEN CONTROL BUILD: the row-statistics exchange does not wait; results are wrong by design
        if (blockIdx.x >= 64) { const long long t0_ = clock64(); while (clock64() - t0_ < 60000) __builtin_amdgcn_s_sleep(8); }
#endif
        const int row = wid * 32 + (lane & 31);
        if (lane < 32) {
            const f32x2v a = P[row * 4 + 0], b = P[row * 4 + 1], c = P[row * 4 + 2], d = P[row * 4 + 3];
            const float mt = (a.x + b.x + c.x + d.x) * 0.25f;
            const float da = a.x - mt, db = b.x - mt, dc = c.x - mt, dd = d.x - mt;
            const float m2 = (a.y + b.y) + (c.y + d.y) + 64.0f * ((da * da + db * db) + (dc * dc + dd * dd));
            unsigned long long* slot = (unsigned long long*)xbuf + ((size_t)(u.pm * BM + row) * 4 + u.pn);
            __hip_atomic_store(slot, ((unsigned long long)__float_as_uint(m2) << 32) | __float_as_uint(mt), __ATOMIC_RELAXED, __HIP_MEMORY_SCOPE_AGENT);
        }
        asm volatile("s_waitcnt vmcnt(0)" ::: "memory");
        if (lane == 0) __hip_atomic_fetch_add(cnt + 64 * u.pm, 1u, __ATOMIC_RELAXED, __HIP_MEMORY_SCOPE_AGENT);
        if (wid == 0) {
            bool dead = false; const unsigned long long t0 = __builtin_amdgcn_s_memrealtime(); const unsigned want = 8u * (unsigned)ntn;
            for (;;) {
#if defined(BROKEN_EXCHANGE_NO_WAIT)
                break;
#endif
                if ((unsigned)__builtin_amdgcn_readfirstlane(__hip_atomic_load(cnt + 64 * u.pm, __ATOMIC_RELAXED, __HIP_MEMORY_SCOPE_AGENT)) >= want) break;
                if (__builtin_amdgcn_s_memrealtime() - t0 > 2000000ull) {
                    if (lane == 0) { unsigned expect = 0u; __hip_atomic_compare_exchange_strong(tmo + 1, &expect, code | (unsigned)(u.pm & 0xff), __ATOMIC_RELAXED, __ATOMIC_RELAXED, __HIP_MEMORY_SCOPE_AGENT);
                                     __hip_atomic_store(tmo, 1u, __ATOMIC_RELAXED, __HIP_MEMORY_SCOPE_AGENT); }
                    dead = true; break; }
                __builtin_amdgcn_s_sleep(2);
            }
            __builtin_amdgcn_fence(__ATOMIC_ACQUIRE, "agent");
            if (lane == 0) flag[0] = dead ? 1u : 0u;
        }
        asm volatile("s_waitcnt vmcnt(0) lgkmcnt(0)" ::: "memory"); __builtin_amdgcn_s_barrier(); asm volatile("" ::: "memory");
        const bool bad = flag[0] != 0u;
        if (lane < 32) {
            const unsigned long long* slot = (const unsigned long long*)xbuf + (size_t)(u.pm * BM + row) * 4; float mt[4], m2[4]; float ms = 0.f;
#pragma unroll
            for (int t = 0; t < 4; ++t) { if (t < ntn) { const unsigned long long w = __hip_atomic_load(slot + t, __ATOMIC_RELAXED, __HIP_MEMORY_SCOPE_AGENT); mt[t] = __uint_as_float((unsigned)w); m2[t] = __uint_as_float((unsigned)(w >> 32)); } else { mt[t] = 0.f; m2[t] = 0.f; } ms += mt[t]; }
            const float mean = ms / (float)ntn; float q = 0.f;
#pragma unroll
            for (int t = 0; t < 4; ++t) if (t < ntn) { const float dm = mt[t] - mean; q += m2[t] + 256.0f * dm * dm; }
            S[row] = (f32x2v){mean, 1.0f / sqrtf(q / (256.0f * (float)ntn) + eps)};
        }
        asm volatile("s_waitcnt lgkmcnt(0)" ::: "memory"); __builtin_amdgcn_s_barrier(); asm volatile("" ::: "memory");
        return bad;
    }
};
struct EpiLnRes {
    static constexpr bool PERM = false, AFTER_DRAIN = true;
    const float* base; float* out; int ldc; const float* bias; PanelStats st; unsigned poison;
    __device__ __forceinline__ void fused(f32x4 (&acc)[2][2][4][2], const Unit& u, int wr, int wc, int fr, int fq, PG8_LAS unsigned char* lds, int wid, int lane) const {
        typedef float f32x2v __attribute__((ext_vector_type(2)));
        const PG8_LAS f32x2v* S = (const PG8_LAS f32x2v*)(lds + 8192);
        const int col0 = u.pn * BM + wc * 32 + 4 * fq;
#pragma unroll
        for (int bj = 0; bj < 2; ++bj)
#pragma unroll
            for (int n = 0; n < 2; ++n) { const f32x4 bv = bias ? *(const f32x4*)(bias + col0 + bj * HALF + n * 16) : (f32x4){0.f, 0.f, 0.f, 0.f};
#pragma unroll
                for (int ai = 0; ai < 2; ++ai)
#pragma unroll
                    for (int m = 0; m < 4; ++m) acc[ai][bj][m][n] += bv; }
        f32x4 pre[4][2][2];
#pragma unroll
        for (int m = 0; m < 4; ++m) { const size_t off = (size_t)(u.pm * BM + wr * 64 + m * 16 + fr) * ldc + col0;
#pragma unroll
            for (int bj = 0; bj < 2; ++bj)
#pragma unroll
                for (int n = 0; n < 2; ++n) pre[m][bj][n] = *(const f32x4*)(base + off + bj * HALF + n * 16); }
        const bool bad = st.run(acc, u, wr, wc, fr, fq, lds, wid, lane) || poison != 0u;
        const float qnan = __builtin_nanf("");
#pragma unroll
        for (int ai = 0; ai < 2; ++ai)
#pragma unroll
            for (int m = 0; m < 4; ++m) { const int r = ai * HALF + wr * 64 + m * 16 + fr; const f32x2v sr = S[r]; const size_t off = (size_t)(u.pm * BM + r) * ldc + col0;
#pragma unroll
                for (int bj = 0; bj < 2; ++bj)
#pragma unroll
                    for (int n = 0; n < 2; ++n) { const f32x4 bs = ai == 0 ? pre[m][bj][n] : *(const f32x4*)(base + off + bj * HALF + n * 16); f32x4 o = bs + (acc[ai][bj][m][n] - sr.x) * sr.y;
                        if (bad) o = (f32x4){qnan, qnan, qnan, qnan}; *(f32x4*)(out + off + bj * HALF + n * 16) = o; }
                if (m & 1) asm volatile("" ::: "memory"); }
    }
};
struct EpiLnResLn {
    static constexpr bool PERM = false, AFTER_DRAIN = true;
    const float* base; float* out; bf16_t* xn; int ldc; const float* bias; PanelStats st1, st2; unsigned poison;
    __device__ __forceinline__ void fused(f32x4 (&acc)[2][2][4][2], const Unit& u, int wr, int wc, int fr, int fq, PG8_LAS unsigned char* lds, int wid, int lane) const {
        typedef float f32x2v __attribute__((ext_vector_type(2))); typedef unsigned u32x2v __attribute__((ext_vector_type(2)));
        const PG8_LAS f32x2v* S = (const PG8_LAS f32x2v*)(lds + 8192);
        const int col0 = u.pn * BM + wc * 32 + 4 * fq;
#pragma unroll
        for (int bj = 0; bj < 2; ++bj)
#pragma unroll
            for (int n = 0; n < 2; ++n) { const f32x4 bv = bias ? *(const f32x4*)(bias + col0 + bj * HALF + n * 16) : (f32x4){0.f, 0.f, 0.f, 0.f};
#pragma unroll
                for (int ai = 0; ai < 2; ++ai)
#pragma unroll
                    for (int m = 0; m < 4; ++m) acc[ai][bj][m][n] += bv; }
        bool bad = st1.run(acc, u, wr, wc, fr, fq, lds, wid, lane) || poison != 0u;
        const float qnan = __builtin_nanf("");
#pragma unroll
        for (int ai = 0; ai < 2; ++ai)
#pragma unroll
            for (int m = 0; m < 4; ++m) { const int r = ai * HALF + wr * 64 + m * 16 + fr; const f32x2v sr = S[r]; const size_t off = (size_t)(u.pm * BM + r) * ldc + col0;
#pragma unroll
                for (int bj = 0; bj < 2; ++bj)
#pragma unroll
                    for (int n = 0; n < 2; ++n) { const f32x4 bs = *(const f32x4*)(base + off + bj * HALF + n * 16); acc[ai][bj][m][n] = bs + (acc[ai][bj][m][n] - sr.x) * sr.y; }
                asm volatile("" : "+v"(acc[ai][0][m][0]), "+v"(acc[ai][0][m][1]), "+v"(acc[ai][1][m][0]), "+v"(acc[ai][1][m][1]));
                if (m & 1) asm volatile("" ::: "memory"); }
        const bool bad1 = bad;
        bad = st2.run(acc, u, wr, wc, fr, fq, lds, wid, lane) || bad;
#pragma unroll
        for (int ai = 0; ai < 2; ++ai)
#pragma unroll
            for (int m = 0; m < 4; ++m) { const int r = ai * HALF + wr * 64 + m * 16 + fr; const f32x2v sr = S[r]; const size_t off = (size_t)(u.pm * BM + r) * ldc + col0;
#pragma unroll
                for (int bj = 0; bj < 2; ++bj)
#pragma unroll
                    for (int n = 0; n < 2; ++n) { const f32x4 x1 = acc[ai][bj][m][n]; *(f32x4*)(out + off + bj * HALF + n * 16) = bad1 ? (f32x4){qnan, qnan, qnan, qnan} : x1;
                        const f32x4 o = (x1 - sr.x) * sr.y; u32x2v w; w.x = cvt_pk_bf16(o[0], o[1]); w.y = cvt_pk_bf16(o[2], o[3]);
                        if (bad) { w.x = 0x7fc07fc0u; w.y = 0x7fc07fc0u; } *(u32x2v*)(xn + off + bj * HALF + n * 16) = w; }
                asm volatile("" ::: "memory"); }
    }
};

template <class Epi, class Sched, bool ALIGN_EPI = false, bool SP2 = false>
__device__ __forceinline__ void gemm_phase(PG8_LAS unsigned char* lds, const Gemm g, const Sched& S, const Epi& E) {
    int tid_ = threadIdx.x; asm volatile("" : "+v"(tid_));
    const int tid = tid_, wid = __builtin_amdgcn_readfirstlane(tid >> 6), lane = tid & 63, wr = wid >> 2, wc = wid & 3, fr = lane & 15, fq = lane >> 4;
    const int K = g.K, nt = K / BK;
    unsigned voffA[2], voffB[2];
#pragma unroll
    for (int i = 0; i < 2; ++i) { int R, C; stage_rc(tid * 16 + i * 8192, R, C); const int Rb = Epi::PERM ? ((R & ~31) + perm32(R & 31)) : R;
        voffA[i] = (unsigned)(R * K + C) * 2u; voffB[i] = (unsigned)(Rb * K + C) * 2u; }
    const size_t kstep = (size_t)(BK * 2);
    const size_t hstep = (size_t)HALF * K * 2;
    const size_t tstep = 2 * hstep;
    const unsigned ldsw = (unsigned)wid * 1024u;
    const int aoff = lds_byte(wr * 64 + fr, fq * 8), boff = lds_byte(wc * 32 + fr, fq * 8);
#define PG8_SA(b, h) (((b) * 2 + (h)) * HTB)
#define PG8_SB(b, h) ((4 + (b) * 2 + (h)) * HTB)
#define PG8_STAGE(bufoff, gbase, voff) do { _Pragma("unroll") for (int _i = 0; _i < 2; ++_i) \
        __builtin_amdgcn_global_load_lds((const unsigned*)((const char*)(gbase) + (voff)[_i]), (PG8_LAS unsigned*)(lds + (bufoff) + ldsw + _i * 8192), 16, 0, 0); } while (0)
#define PG8_LDA(dst, b, h) do { _Pragma("unroll") for (int m = 0; m < 4; ++m) _Pragma("unroll") for (int k = 0; k < 2; ++k) dst[m][k] = *(const PG8_LAS bf16x8*)(lds + PG8_SA(b, h) + aoff + m * 2048 + k * 1024); } while (0)
#define PG8_LDB(dst, b, h) do { _Pragma("unroll") for (int n = 0; n < 2; ++n) _Pragma("unroll") for (int k = 0; k < 2; ++k) dst[n][k] = *(const PG8_LAS bf16x8*)(lds + PG8_SB(b, h) + boff + n * 2048 + k * 1024); } while (0)
#define PG8_MMA(ai, bj, At, Bt) do { __builtin_amdgcn_s_setprio(1); _Pragma("unroll") for (int m = 0; m < 4; ++m) _Pragma("unroll") for (int n = 0; n < 2; ++n) _Pragma("unroll") for (int k = 0; k < 2; ++k) \
        acc[ai][bj][m][n] = __builtin_amdgcn_mfma_f32_16x16x32_bf16(Bt[n][k], At[m][k], acc[ai][bj][m][n], 0, 0, 0); __builtin_amdgcn_s_setprio(0); } while (0)
#define PG8_WAIT_V(n) asm volatile("s_waitcnt vmcnt(" #n ")" ::: "memory")
#define PG8_WAIT_L(n) asm volatile("s_waitcnt lgkmcnt(" #n ")" ::: "memory")
#define PG8_BAR __builtin_amdgcn_s_barrier()
#define PG8_SCHED __builtin_amdgcn_sched_barrier(0)
    Unit cur, nxt; int ui = 0;
    if (!S.next(0, cur)) return;
    f32x4 acc[2][2][4][2];
#pragma unroll
    for (int a = 0; a < 2; ++a)
#pragma unroll
        for (int b = 0; b < 2; ++b)
#pragma unroll
            for (int m = 0; m < 4; ++m)
#pragma unroll
                for (int n = 0; n < 2; ++n) acc[a][b][m][n] = (f32x4){0.f, 0.f, 0.f, 0.f};
    bf16x8 At[4][2], B0[2][2], B1[2][2];
    const char* cA = (const char*)g.A + (size_t)cur.pm * tstep; const char* cB = (const char*)g.Bt + (size_t)cur.pn * tstep;
    S.a_ready(cur);
    if constexpr (SP2) {
        PG8_STAGE(PG8_SB(0, 0), cB, voffB); PG8_STAGE(PG8_SB(0, 1), cB + hstep, voffB); PG8_STAGE(PG8_SA(0, 0), cA, voffA); PG8_STAGE(PG8_SA(0, 1), cA + hstep, voffA);
        if (wr == 1) PG8_BAR;
        PG8_WAIT_V(2); PG8_BAR;
        PG8_STAGE(PG8_SB(1, 0), cB + kstep, voffB); PG8_STAGE(PG8_SA(1, 0), cA + kstep, voffA); PG8_STAGE(PG8_SB(1, 1), cB + hstep + kstep, voffB);
        PG8_WAIT_V(6); PG8_BAR;
    } else {
        PG8_STAGE(PG8_SB(0, 0), cB, voffB); PG8_STAGE(PG8_SA(0, 0), cA, voffA); PG8_STAGE(PG8_SB(0, 1), cB + hstep, voffB); PG8_STAGE(PG8_SA(0, 1), cA + hstep, voffA);
        if (wr == 1) PG8_BAR;
        PG8_WAIT_V(4); PG8_BAR;
        PG8_STAGE(PG8_SB(1, 0), cB + kstep, voffB); PG8_STAGE(PG8_SA(1, 0), cA + kstep, voffA); PG8_STAGE(PG8_SB(1, 1), cB + hstep + kstep, voffB);
        PG8_WAIT_V(6); PG8_BAR;
    }
    for (;;) {
        const bool has_next = S.next(ui + 1, nxt);
        const char* nA = has_next ? (const char*)g.A + (size_t)nxt.pm * tstep : cA; const char* nB = has_next ? (const char*)g.Bt + (size_t)nxt.pn * tstep : cB;
        for (int t = 0; t < nt; t += 2) {
            const bool last = (t == nt - 2);
            const char* a1 = cA + (size_t)(t + 1) * kstep;
            const char* a2 = last ? nA : cA + (size_t)(t + 2) * kstep; const char* b2 = last ? nB : cB + (size_t)(t + 2) * kstep;
            const char* a3 = a2 + kstep; const char* b3 = b2 + kstep;
            if (last && has_next) S.a_ready(nxt);
            if constexpr (SP2) {
            PG8_LDB(B0, 0, 0); PG8_LDB(B1, 0, 1); PG8_SCHED; PG8_LDA(At, 0, 0); PG8_STAGE(PG8_SA(1, 1), a1 + hstep, voffA);
            PG8_WAIT_V(8); PG8_WAIT_L(0); PG8_BAR; PG8_MMA(0, 0, At, B0); PG8_MMA(0, 1, At, B1); PG8_BAR; PG8_SCHED;
            PG8_LDA(At, 0, 1); PG8_STAGE(PG8_SB(0, 0), b2, voffB); PG8_STAGE(PG8_SB(0, 1), b2 + hstep, voffB); PG8_STAGE(PG8_SA(0, 0), a2, voffA);
            PG8_WAIT_V(8); PG8_WAIT_L(0); PG8_BAR; PG8_MMA(1, 0, At, B0); PG8_MMA(1, 1, At, B1); PG8_BAR; PG8_SCHED;
            PG8_LDB(B0, 1, 0); PG8_LDB(B1, 1, 1); PG8_SCHED; PG8_LDA(At, 1, 0); PG8_STAGE(PG8_SA(0, 1), a2 + hstep, voffA);
            PG8_WAIT_V(8); PG8_WAIT_L(0); PG8_BAR; PG8_MMA(0, 0, At, B0); PG8_MMA(0, 1, At, B1); PG8_BAR; PG8_SCHED;
            PG8_LDA(At, 1, 1); PG8_STAGE(PG8_SB(1, 0), b3, voffB); PG8_STAGE(PG8_SB(1, 1), b3 + hstep, voffB); PG8_STAGE(PG8_SA(1, 0), a3, voffA);
            PG8_WAIT_V(8); PG8_WAIT_L(0); PG8_BAR; PG8_MMA(1, 0, At, B0); PG8_MMA(1, 1, At, B1); PG8_BAR; PG8_SCHED;
            } else {
            PG8_LDB(B0, 0, 0); PG8_SCHED; PG8_LDA(At, 0, 0); PG8_STAGE(PG8_SA(1, 1), a1 + hstep, voffA);
            PG8_WAIT_L(8); PG8_BAR; PG8_WAIT_L(0); PG8_MMA(0, 0, At, B0); PG8_BAR; PG8_SCHED;
            PG8_LDB(B1, 0, 1); PG8_STAGE(PG8_SB(0, 0), b2, voffB);
            PG8_BAR; PG8_WAIT_L(0); PG8_MMA(0, 1, At, B1); PG8_BAR;
            PG8_LDA(At, 0, 1); PG8_STAGE(PG8_SA(0, 0), a2, voffA);
            PG8_BAR; PG8_WAIT_L(0); PG8_MMA(1, 0, At, B0); PG8_BAR; PG8_SCHED;
            PG8_STAGE(PG8_SB(0, 1), b2 + hstep, voffB);
            PG8_WAIT_V(6); PG8_BAR; PG8_MMA(1, 1, At, B1); PG8_BAR;
            PG8_LDB(B0, 1, 0); PG8_SCHED; PG8_LDA(At, 1, 0); PG8_STAGE(PG8_SA(0, 1), a2 + hstep, voffA);
            PG8_WAIT_L(8); PG8_BAR; PG8_WAIT_L(0); PG8_MMA(0, 0, At, B0); PG8_BAR; PG8_SCHED;
            PG8_LDB(B1, 1, 1); PG8_STAGE(PG8_SB(1, 0), b3, voffB);
            PG8_BAR; PG8_WAIT_L(0); PG8_MMA(0, 1, At, B1); PG8_BAR;
            PG8_LDA(At, 1, 1); PG8_STAGE(PG8_SA(1, 0), a3, voffA);
            PG8_BAR; PG8_WAIT_L(0); PG8_MMA(1, 0, At, B0); PG8_BAR; PG8_SCHED;
            PG8_STAGE(PG8_SB(1, 1), b3 + hstep, voffB);
            PG8_WAIT_V(6); PG8_BAR; PG8_MMA(1, 1, At, B1); PG8_BAR;
            }
        }
        if constexpr (ALIGN_EPI) { if (wr == 0) PG8_BAR; }
        if constexpr (!Epi::AFTER_DRAIN) { E(acc, cur, wr, wc, fr, fq); S.done(cur); }
        if (!has_next) break;
#pragma unroll
        for (int a = 0; a < 2; ++a)
#pragma unroll
            for (int b = 0; b < 2; ++b)
#pragma unroll
                for (int m = 0; m < 4; ++m)
#pragma unroll
                    for (int n = 0; n < 2; ++n) acc[a][b][m][n] = (f32x4){0.f, 0.f, 0.f, 0.f};
        cur = nxt; cA = nA; cB = nB; ++ui;
        if constexpr (ALIGN_EPI) { if (wr == 1) PG8_BAR; }
    }
    PG8_WAIT_V(0);
    if constexpr (!ALIGN_EPI) { if (wr == 0) PG8_BAR; }
    PG8_BAR;
    if constexpr (Epi::AFTER_DRAIN) { E.fused(acc, cur, wr, wc, fr, fq, lds, wid, lane); S.done(cur); }
#undef PG8_SA
#undef PG8_SB
#undef PG8_STAGE
#undef PG8_LDA
#undef PG8_LDB
#undef PG8_MMA
#undef PG8_WAIT_V
#undef PG8_WAIT_L
#undef PG8_BAR
#undef PG8_SCHED
}
}

#ifndef PG8_SP2
#define PG8_SP2 true
#endif
#ifndef PG8_ALIGN
#define PG8_ALIGN true
#endif

namespace {
constexpr int D_MODEL = 1024, BATCH = 2, SEQ = 8192, NTOK = BATCH * SEQ;
constexpr int AB_IN = 2560, C_IN = 1536;
constexpr int N_EXP = 16, D_FF = 512, PLE_DIM = 256;
constexpr float ALPHA = 1.4142135623730951f;
constexpr float LN_EPS = 1e-5f;
constexpr int NTHREADS = 512, NWAVES = 8;
constexpr int LDS_BYTES = 147456;
#define LAS __attribute__((address_space(3)))
#define GAS __attribute__((address_space(1)))
typedef unsigned short bf16_t;
typedef unsigned v4u __attribute__((ext_vector_type(4)));
typedef unsigned v2u __attribute__((ext_vector_type(2)));
typedef float f32x4 __attribute__((ext_vector_type(4)));

constexpr size_t MiB = 1u << 20;
constexpr size_t WS_CTL = 0;
constexpr size_t WS_W_IN = 1 * MiB, WS_W_OUTAB = 6 * MiB, WS_W_QKV = 8 * MiB, WS_W_OUTC = 11 * MiB, WS_W_PLEG = 13 * MiB, WS_W_PLEP = 17 * MiB;
constexpr size_t WS_W_GU = 18 * MiB, WS_W_DN = 50 * MiB;
constexpr size_t WS_PROJ = 66 * MiB;
constexpr size_t WS_MIX = 146 * MiB;
constexpr size_t WS_XNA = 182 * MiB, WS_XNB = 214 * MiB;
constexpr size_t WS_PP = 246 * MiB;
constexpr size_t WS_PB = 278 * MiB;
constexpr size_t WS_EIDX = 294 * MiB, WS_GATEW = 295 * MiB, WS_LIST = 296 * MiB, WS_POS = 297 * MiB;
constexpr size_t WS_LRUSUM = 298 * MiB, WS_LRUW = 299 * MiB;
constexpr size_t WS_ROPE = 300 * MiB;
constexpr size_t WS_END = 304 * MiB;
constexpr size_t WS_XS = WS_PROJ;
constexpr size_t WS_H = WS_MIX;
constexpr int MISC_OFF = 131072;
constexpr int CW_CNT = 64;

__device__ __forceinline__ float softplusf(float z) { return fmaxf(z, 0.f) + log1pf(expf(-fabsf(z))); }
__device__ __forceinline__ float sigmoidf_(float z) { return 1.f / (1.f + expf(-z)); }
__device__ __forceinline__ float wave_sum(float v) {
#pragma unroll
    for (int o = 1; o < 64; o <<= 1) v += __shfl_xor(v, o);
    return v;
}
__device__ __forceinline__ float gelu_tanh(float x) {
    const float c = 0.7978845608028654f;
    return 0.5f * x * (1.f + tanhf(c * (x + 0.044715f * x * x * x)));
}
__device__ __forceinline__ unsigned f2bf(float f) { unsigned u = __builtin_bit_cast(unsigned, f); return (u + 0x7fffu + ((u >> 16) & 1u)) >> 16; }
__device__ __forceinline__ unsigned pk2(float lo, float hi) { return f2bf(lo) | (f2bf(hi) << 16); }
__device__ __forceinline__ float bf2f(bf16_t v) { return __uint_as_float((unsigned)v << 16); }
__device__ __forceinline__ float bflo(unsigned w) { return __uint_as_float(w << 16); }
__device__ __forceinline__ float bfhi(unsigned w) { return __uint_as_float(w & 0xffff0000u); }
template <class T> __device__ __forceinline__ T* lnd(T* p) { asm volatile("" : "+s"(p)); return p; }
__device__ __forceinline__ int tid_opaque() { int t = threadIdx.x; asm volatile("" : "+v"(t)); return t; }

struct EpiF32 {
    static constexpr bool PERM = false, AFTER_DRAIN = false;
    float* O; int ldc;
    __device__ __forceinline__ void operator()(const pg8::f32x4 (&acc)[2][2][4][2], const pg8::Unit& u, int wr, int wc, int fr, int fq) const {
        const int row0 = u.pm * 256 + wr * 64 + fr, col0 = u.pn * 256 + wc * 32 + 4 * fq;
#pragma unroll
        for (int ai = 0; ai < 2; ++ai)
#pragma unroll
            for (int m = 0; m < 4; ++m) { float* rowp = O + (size_t)(row0 + ai * 128 + m * 16) * ldc + col0;
#pragma unroll
                for (int bj = 0; bj < 2; ++bj)
#pragma unroll
                    for (int n = 0; n < 2; ++n) *(pg8::f32x4*)(rowp + bj * 128 + n * 16) = acc[ai][bj][m][n]; }
    }
};
struct EpiPle {
    static constexpr bool PERM = false, AFTER_DRAIN = false;
    float* X; const bf16_t* PP; bf16_t* XB; const float* bias;
    __device__ __forceinline__ void operator()(const pg8::f32x4 (&acc)[2][2][4][2], const pg8::Unit& u, int wr, int wc, int fr, int fq) const {
        const int row0 = u.pm * 256 + wr * 64 + fr, col0 = u.pn * 256 + wc * 32 + 4 * fq;
        pg8::f32x4 bv[2][2];
#pragma unroll
        for (int bj = 0; bj < 2; ++bj)
#pragma unroll
            for (int n = 0; n < 2; ++n) bv[bj][n] = *(const pg8::f32x4*)(bias + col0 + bj * 128 + n * 16);
#pragma unroll
        for (int ai = 0; ai < 2; ++ai)
#pragma unroll
            for (int m = 0; m < 4; ++m) { const size_t off = (size_t)(row0 + ai * 128 + m * 16) * D_MODEL + col0;
#pragma unroll
                for (int bj = 0; bj < 2; ++bj)
#pragma unroll
                    for (int n = 0; n < 2; ++n) { const size_t o = off + bj * 128 + n * 16;
                        const pg8::f32x4 x2 = *(const pg8::f32x4*)(X + o); const v2u pw = *(const v2u*)(PP + o);
                        const pg8::f32x4 z = acc[ai][bj][m][n] + bv[bj][n];
                        pg8::f32x4 r;
                        r[0] = x2[0] + bflo(pw.x) * __builtin_amdgcn_rcpf(1.f + __expf(-z[0]));
                        r[1] = x2[1] + bfhi(pw.x) * __builtin_amdgcn_rcpf(1.f + __expf(-z[1]));
                        r[2] = x2[2] + bflo(pw.y) * __builtin_amdgcn_rcpf(1.f + __expf(-z[2]));
                        r[3] = x2[3] + bfhi(pw.y) * __builtin_amdgcn_rcpf(1.f + __expf(-z[3]));
                        *(pg8::f32x4*)(X + o) = r; v2u w; w.x = pk2(r[0], r[1]); w.y = pk2(r[2], r[3]); *(v2u*)(XB + o) = w; } }
    }
};

struct EpiGU {
    static constexpr bool PERM = true, AFTER_DRAIN = false;
    bf16_t* H;
    __device__ __forceinline__ void operator()(const pg8::f32x4 (&acc)[2][2][4][2], const pg8::Unit& u, int wr, int wc, int fr, int fq) const {
        const int row0 = u.pm * 256 + wr * 64 + fr, col0 = (u.pn & 3) * 128 + wc * 32 + 8 * fq;
#pragma unroll
        for (int ai = 0; ai < 2; ++ai)
#pragma unroll
            for (int m = 0; m < 4; ++m) { bf16_t* rowp = H + (size_t)(row0 + ai * 128 + m * 16) * D_FF + col0;
                float hv[8];
#pragma unroll
                for (int n = 0; n < 2; ++n)
#pragma unroll
                    for (int j = 0; j < 4; ++j) { const float g = acc[ai][0][m][n][j], up = acc[ai][1][m][n][j]; hv[n * 4 + j] = g * __builtin_amdgcn_rcpf(1.f + __expf(-g)) * up; }
                v4u w; w.x = pk2(hv[0], hv[1]); w.y = pk2(hv[2], hv[3]); w.z = pk2(hv[4], hv[5]); w.w = pk2(hv[6], hv[7]);
                *(v4u*)rowp = w; }
    }
};
struct EpiBf16N {
    static constexpr bool PERM = true, AFTER_DRAIN = false;
    bf16_t* O; int ldc;
    __device__ __forceinline__ void operator()(const pg8::f32x4 (&acc)[2][2][4][2], const pg8::Unit& u, int wr, int wc, int fr, int fq) const {
        const int row0 = u.pm * 256 + wr * 64 + fr, col0 = (u.pn & 3) * 256 + wc * 32 + 8 * fq;
#pragma unroll
        for (int ai = 0; ai < 2; ++ai)
#pragma unroll
            for (int m = 0; m < 4; ++m) { bf16_t* rowp = O + (size_t)(row0 + ai * 128 + m * 16) * ldc + col0;
#pragma unroll
                for (int bj = 0; bj < 2; ++bj) { const pg8::f32x4 v0 = acc[ai][bj][m][0], v1 = acc[ai][bj][m][1];
                    v4u w; w.x = pk2(v0[0], v0[1]); w.y = pk2(v0[2], v0[3]); w.z = pk2(v1[0], v1[1]); w.w = pk2(v1[2], v1[3]);
                    *(v4u*)(rowp + bj * 128) = w; } }
    }
};
struct MoeOrder {
    const LAS int* tile_off;
    int G, c;
    __device__ __forceinline__ bool next(int i, pg8::Unit& u) const {
        const int T = tile_off[16];
        const int L = i * G + c; if (L >= T * 4) return false;
        const int rt = L >> 2; int e = 0;
#pragma unroll
        for (int k = 1; k < 16; ++k) e += (rt >= tile_off[k]) ? 1 : 0;
        u.pm = rt; u.pn = __builtin_amdgcn_readfirstlane(e * 4 + (L & 3)); return true;
    }
    __device__ __forceinline__ void a_ready(const pg8::Unit&) const {}
    __device__ __forceinline__ void done(const pg8::Unit&) const {}
};

__device__ __forceinline__ void p0_transpose_item(const float* W, int K, int N, bf16_t* WT, int row_off, LAS float* scr, int item, int lane) {
    const int nblk = N / 32, kb = item / nblk, nb = item % nblk, k0 = 64 * kb, n0 = 32 * nb;
#pragma unroll 8
    for (int i = 0; i < 32; ++i) { const int kk = 2 * i + (lane >> 5); scr[kk * 33 + (lane & 31)] = W[(size_t)(k0 + kk) * N + n0 + (lane & 31)]; }
    asm volatile("s_waitcnt lgkmcnt(0)" ::: "memory");
    const int c = lane & 7;
#pragma unroll
    for (int j = 0; j < 4; ++j) { const int n = (lane >> 3) + 8 * j; const LAS float* s = scr + (8 * c) * 33 + n;
        v4u o; o.x = pk2(s[0 * 33], s[1 * 33]); o.y = pk2(s[2 * 33], s[3 * 33]); o.z = pk2(s[4 * 33], s[5 * 33]); o.w = pk2(s[6 * 33], s[7 * 33]);
        *(v4u*)(WT + (size_t)(row_off + n0 + n) * K + k0 + 8 * c) = o; }
    asm volatile("s_waitcnt lgkmcnt(0)" ::: "memory");
}
__device__ __forceinline__ void row1024_to_bf16(const float* xrow, bf16_t* orow, int lane) {
    const f32x4* xr = (const f32x4*)xrow + lane;
    v2u* o8 = (v2u*)orow + lane;
#pragma unroll
    for (int j = 0; j < 4; ++j) { const f32x4 v = xr[64 * j]; v2u w; w.x = pk2(v[0], v[1]); w.y = pk2(v[2], v[3]); o8[64 * j] = w; }
}

template <bool ROUTER>
__device__ __forceinline__ void ph_res_ln(const float* x, const float* h, const float* g, const float* bta, float* out, bf16_t* outb, const float* w_router,
                                          const float* b_router, int* eidx, float* gatew) {
    const int tid0 = tid_opaque(), lane = tid0 & 63, wave = tid0 >> 6;
    for (int row = blockIdx.x * 8 + wave; row < NTOK; row += gridDim.x * 8) {
        asm volatile("" ::: "memory");
        const float4* xr = (const float4*)(x + (size_t)row * D_MODEL);
        const float4* hr = (const float4*)(h + (size_t)row * D_MODEL);
        float4 v[4];
        float s = 0.f;
#pragma unroll
        for (int j = 0; j < 4; ++j) {
            const float4 a = xr[lane + 64 * j], c = hr[lane + 64 * j];
            v[j] = make_float4(ALPHA * a.x + c.x, ALPHA * a.y + c.y, ALPHA * a.z + c.z, ALPHA * a.w + c.w);
            s += (v[j].x + v[j].y) + (v[j].z + v[j].w);
        }
        const float mean = wave_sum(s) * (1.f / D_MODEL);
        float s2 = 0.f;
#pragma unroll
        for (int j = 0; j < 4; ++j) {
            v[j].x -= mean; v[j].y -= mean; v[j].z -= mean; v[j].w -= mean;
            s2 += (v[j].x * v[j].x + v[j].y * v[j].y) + (v[j].z * v[j].z + v[j].w * v[j].w);
        }
        const float rstd = 1.f / sqrtf(wave_sum(s2) * (1.f / D_MODEL) + LN_EPS);
        float4* orow = (float4*)(out + (size_t)row * D_MODEL);
        v2u* brow = (v2u*)(outb + (size_t)row * D_MODEL);
#pragma unroll
        for (int j = 0; j < 4; ++j) {
            const float4 gg = ((const float4*)g)[lane + 64 * j], bb = ((const float4*)bta)[lane + 64 * j];
            v[j] = make_float4(v[j].x * rstd * gg.x + bb.x, v[j].y * rstd * gg.y + bb.y, v[j].z * rstd * gg.z + bb.z, v[j].w * rstd * gg.w + bb.w);
            orow[lane + 64 * j] = v[j];
            v2u w; w.x = pk2(v[j].x, v[j].y); w.y = pk2(v[j].z, v[j].w); brow[lane + 64 * j] = w;
        }
        if (ROUTER) {
            float lg[16];
#pragma unroll
            for (int e = 0; e < 16; ++e) lg[e] = 0.f;
#pragma unroll
            for (int j = 0; j < 4; ++j) {
                const float xv[4] = {v[j].x, v[j].y, v[j].z, v[j].w};
#pragma unroll
                for (int k = 0; k < 4; ++k) {
                    const int d = 4 * (lane + 64 * j) + k;
                    const float4* wr = (const float4*)(w_router + d * 16);
#pragma unroll
                    for (int q4 = 0; q4 < 4; ++q4) {
                        const float4 w = wr[q4];
                        lg[q4 * 4 + 0] += xv[k] * w.x; lg[q4 * 4 + 1] += xv[k] * w.y; lg[q4 * 4 + 2] += xv[k] * w.z; lg[q4 * 4 + 3] += xv[k] * w.w;
                    }
                }
            }
#pragma unroll
            for (int e = 0; e < 16; ++e) lg[e] = wave_sum(lg[e]) + b_router[e];
            if (lane == 0) {
                float mx = lg[0];
#pragma unroll
                for (int e = 1; e < 16; ++e) mx = fmaxf(mx, lg[e]);
                float p[16], sum = 0.f;
#pragma unroll
                for (int e = 0; e < 16; ++e) { p[e] = expf(lg[e] - mx); sum += p[e]; }
                const float inv = 1.f / sum;
#pragma unroll
                for (int e = 0; e < 16; ++e) p[e] *= inv;
                int gsel = 0; float gbest = -1.f;
#pragma unroll
                for (int gq = 0; gq < 4; ++gq) {
                    float m1 = -1.f, m2 = -1.f;
#pragma unroll
                    for (int k = 0; k < 4; ++k) { const float pv = p[gq * 4 + k]; if (pv > m1) { m2 = m1; m1 = pv; } else if (pv > m2) { m2 = pv; } }
                    const float sc = m1 + m2;
                    if (sc > gbest) { gbest = sc; gsel = gq; }
                }
                float m1 = -1.f, m2 = -1.f; int i1 = 0, i2 = 0;
#pragma unroll
                for (int gq = 0; gq < 4; ++gq) {
                    if (gq == gsel) {
#pragma unroll
                        for (int k = 0; k < 4; ++k) { const float pv = p[gq * 4 + k]; if (pv > m1) { m2 = m1; i2 = i1; m1 = pv; i1 = k; } else if (pv > m2) { m2 = pv; i2 = k; } }
                    }
                }
                const float wsum = m1 + m2;
                eidx[row * 2 + 0] = gsel * 4 + i1; eidx[row * 2 + 1] = gsel * 4 + i2;
                gatew[row * 2 + 0] = m1 / wsum; gatew[row * 2 + 1] = m2 / wsum;
            }
        }
    }
}
__device__ __forceinline__ void ph_moe_naive(unsigned char* lds, const float* x, const int* eidx, const float* gatew, const float* wg, const float* wu, const float* wd, float* m) {
    float* xs = (float*)(lds + 65536);
    float* hs = (float*)(lds + 65536 + 4096);
    const int tid = tid_opaque();
    for (int tok = blockIdx.x; tok < NTOK; tok += gridDim.x) {
        __syncthreads();
        xs[tid] = x[(size_t)tok * D_MODEL + tid]; xs[tid + 512] = x[(size_t)tok * D_MODEL + tid + 512];
        float o0 = 0.f, o1 = 0.f;
        for (int kk = 0; kk < 2; ++kk) {
            const int e = eidx[tok * 2 + kk];
            const float gw = gatew[tok * 2 + kk];
            const float* wge = wg + (size_t)e * D_MODEL * D_FF;
            const float* wue = wu + (size_t)e * D_MODEL * D_FF;
            const float* wde = wd + (size_t)e * D_FF * D_MODEL;
            __syncthreads();
            float g0 = 0.f, u0 = 0.f;
#pragma unroll 4
            for (int d = 0; d < 1024; ++d) {
                const float xv = xs[d];
                g0 += xv * wge[(size_t)d * D_FF + tid];
                u0 += xv * wue[(size_t)d * D_FF + tid];
            }
            hs[tid] = g0 * sigmoidf_(g0) * u0 * gw;
            __syncthreads();
#pragma unroll 4
            for (int f = 0; f < 512; ++f) {
                const float hv = hs[f];
                o0 += hv * wde[(size_t)f * D_MODEL + tid];
                o1 += hv * wde[(size_t)f * D_MODEL + tid + 512];
            }
        }
        m[(size_t)tok * D_MODEL + tid] = o0; m[(size_t)tok * D_MODEL + tid + 512] = o1;
    }
}
__device__ __forceinline__ void ph_route(unsigned char* lds, const float* x1, const float* w_router, const float* b_router, float* gatew, unsigned* cnt, int* list) {
    const int tid = tid_opaque(), lane = tid & 63, wave = tid >> 6;
    int* s_e = (int*)(lds + MISC_OFF);
    int* s_rank = s_e + 128;
    int* s_cnt = s_rank + 128;
    int* s_base = s_cnt + 16;
    for (int base = blockIdx.x * 64; base < NTOK; base += gridDim.x * 64) {
        __syncthreads();
        if (tid < 16) s_cnt[tid] = 0;
        __syncthreads();
#pragma unroll 1
        for (int rr = 0; rr < 8; rr += 4) {
            asm volatile("" ::: "memory");
            const int row0 = base + wave * 8 + rr;
            float lg[4][16];
#pragma unroll
            for (int r = 0; r < 4; ++r)
#pragma unroll
                for (int e = 0; e < 16; ++e) lg[r][e] = 0.f;
#pragma unroll 1
            for (int j = 0; j < 4; ++j) {
                asm volatile("" ::: "memory");
                f32x4 xv[4];
#pragma unroll
                for (int r = 0; r < 4; ++r) xv[r] = *((const f32x4*)(x1 + (size_t)(row0 + r) * D_MODEL) + lane + 64 * j);
#pragma unroll
                for (int k = 0; k < 4; ++k) {
                    const int d = 4 * (lane + 64 * j) + k;
                    const f32x4* wr = (const f32x4*)(w_router + d * 16);
#pragma unroll
                    for (int q4 = 0; q4 < 4; ++q4) {
                        const f32x4 w = wr[q4];
#pragma unroll
                        for (int r = 0; r < 4; ++r) { lg[r][q4 * 4 + 0] += xv[r][k] * w[0]; lg[r][q4 * 4 + 1] += xv[r][k] * w[1]; lg[r][q4 * 4 + 2] += xv[r][k] * w[2]; lg[r][q4 * 4 + 3] += xv[r][k] * w[3]; }
                    }
                }
            }
#pragma unroll
            for (int r = 0; r < 4; ++r) {
#pragma unroll
                for (int e = 0; e < 16; ++e) lg[r][e] = wave_sum(lg[r][e]) + b_router[e];
                float mx = lg[r][0];
#pragma unroll
                for (int e = 1; e < 16; ++e) mx = fmaxf(mx, lg[r][e]);
                float p[16], sum = 0.f;
#pragma unroll
                for (int e = 0; e < 16; ++e) { p[e] = expf(lg[r][e] - mx); sum += p[e]; }
                const float inv = 1.f / sum;
#pragma unroll
                for (int e = 0; e < 16; ++e) p[e] *= inv;
                int gsel = 0; float gbest = -1.f;
#pragma unroll
                for (int gq = 0; gq < 4; ++gq) {
                    float m1 = -1.f, m2 = -1.f;
#pragma unroll
                    for (int k = 0; k < 4; ++k) { const float pv = p[gq * 4 + k]; if (pv > m1) { m2 = m1; m1 = pv; } else if (pv > m2) { m2 = pv; } }
                    const float sc = m1 + m2;
                    if (sc > gbest) { gbest = sc; gsel = gq; }
                }
                float m1 = -1.f, m2 = -1.f; int i1 = 0, i2 = 0;
#pragma unroll
                for (int gq = 0; gq < 4; ++gq) {
                    if (gq == gsel) {
#pragma unroll
                        for (int k = 0; k < 4; ++k) { const float pv = p[gq * 4 + k]; if (pv > m1) { m2 = m1; i2 = i1; m1 = pv; i1 = k; } else if (pv > m2) { m2 = pv; i2 = k; } }
                    }
                }
                if (lane == 0) {
                    const int row = row0 + r, tl = row - base, e1 = gsel * 4 + i1, e2 = gsel * 4 + i2;
                    const float wsum = m1 + m2;
                    gatew[row * 2 + 0] = m1 / wsum; gatew[row * 2 + 1] = m2 / wsum;
                    s_e[tl * 2 + 0] = e1; s_e[tl * 2 + 1] = e2;
                    s_rank[tl * 2 + 0] = atomicAdd(&s_cnt[e1], 1);
                    s_rank[tl * 2 + 1] = atomicAdd(&s_cnt[e2], 1);
                }
            }
        }
        __syncthreads();
        if (tid < 16) s_base[tid] = (int)__hip_atomic_fetch_add(cnt + tid, (unsigned)s_cnt[tid], __ATOMIC_RELAXED, __HIP_MEMORY_SCOPE_AGENT);
        __syncthreads();
        if (tid < 128) { const int e = s_e[tid]; list[e * NTOK + s_base[e] + s_rank[tid]] = (base + (tid >> 1)) * 2 + (tid & 1); }
    }
}
__device__ __forceinline__ void moe_offsets(unsigned char* lds, const unsigned* cnt) {
    int* t_off = (int*)(lds + MISC_OFF + 2048);
    __syncthreads();
    if (threadIdx.x == 0) {
        int acc = 0;
        for (int e = 0; e < 16; ++e) { const int c = (int)__hip_atomic_load(cnt + e, __ATOMIC_RELAXED, __HIP_MEMORY_SCOPE_AGENT); t_off[e] = acc; t_off[32 + e] = c; acc += (c + 255) >> 8; }
        t_off[16] = acc;
    }
    __syncthreads();
}
__device__ __forceinline__ void ph_permute(unsigned char* lds, const unsigned* cnt, const int* list, const bf16_t* x1b, bf16_t* xs, int* pos) {
    moe_offsets(lds, cnt);
    const int* t_off = (const int*)(lds + MISC_OFF + 2048);
    const int tid = tid_opaque(), lane = tid & 63, wave = tid >> 6;
    const int R = t_off[16] * 256;
    for (int r = blockIdx.x * NWAVES + wave; r < R; r += gridDim.x * NWAVES) {
        const int rt = r >> 8; int e = 0;
#pragma unroll
        for (int k = 1; k < 16; ++k) e += (rt >= t_off[k]) ? 1 : 0;
        const int i = r - t_off[e] * 256;
        if (i < t_off[32 + e]) {
            const int ent = list[e * NTOK + i], tok = ent >> 1;
            const v4u* src = (const v4u*)(x1b + (size_t)tok * D_MODEL);
            v4u* dst = (v4u*)(xs + (size_t)r * D_MODEL);
            dst[lane] = src[lane]; dst[lane + 64] = src[lane + 64];
            if (lane == 0) pos[ent] = r;
        }
    }
}
__device__ __forceinline__ void ph_combine_ln(const float* x, const bf16_t* Y, const int* pos, const float* gatew, const float* g, const float* bta, float* out, bf16_t* outb) {
    const int tid0 = tid_opaque(), lane = tid0 & 63, wave = tid0 >> 6;
    for (int row = blockIdx.x * 8 + wave; row < NTOK; row += gridDim.x * 8) {
        asm volatile("" ::: "memory");
        const int p0 = pos[row * 2], p1 = pos[row * 2 + 1];
        const float w0 = gatew[row * 2], w1 = gatew[row * 2 + 1];
        const float4* xr = (const float4*)(x + (size_t)row * D_MODEL);
        const v2u* y0 = (const v2u*)(Y + (size_t)p0 * D_MODEL);
        const v2u* y1 = (const v2u*)(Y + (size_t)p1 * D_MODEL);
        float4 v[4];
        float s = 0.f;
#pragma unroll
        for (int j = 0; j < 4; ++j) {
            const float4 a = xr[lane + 64 * j]; const v2u a0 = y0[lane + 64 * j], a1 = y1[lane + 64 * j];
            v[j] = make_float4(ALPHA * a.x + (w0 * bflo(a0.x) + w1 * bflo(a1.x)), ALPHA * a.y + (w0 * bfhi(a0.x) + w1 * bfhi(a1.x)),
                               ALPHA * a.z + (w0 * bflo(a0.y) + w1 * bflo(a1.y)), ALPHA * a.w + (w0 * bfhi(a0.y) + w1 * bfhi(a1.y)));
            s += (v[j].x + v[j].y) + (v[j].z + v[j].w);
        }
        const float mean = wave_sum(s) * (1.f / D_MODEL);
        float s2 = 0.f;
#pragma unroll
        for (int j = 0; j < 4; ++j) {
            v[j].x -= mean; v[j].y -= mean; v[j].z -= mean; v[j].w -= mean;
            s2 += (v[j].x * v[j].x + v[j].y * v[j].y) + (v[j].z * v[j].z + v[j].w * v[j].w);
        }
        const float rstd = 1.f / sqrtf(wave_sum(s2) * (1.f / D_MODEL) + LN_EPS);
        float4* orow = (float4*)(out + (size_t)row * D_MODEL);
        v2u* brow = (v2u*)(outb + (size_t)row * D_MODEL);
#pragma unroll
        for (int j = 0; j < 4; ++j) {
            const float4 gg = ((const float4*)g)[lane + 64 * j], bb = ((const float4*)bta)[lane + 64 * j];
            v[j] = make_float4(v[j].x * rstd * gg.x + bb.x, v[j].y * rstd * gg.y + bb.y, v[j].z * rstd * gg.z + bb.z, v[j].w * rstd * gg.w + bb.w);
            orow[lane + 64 * j] = v[j];
            v2u w; w.x = pk2(v[j].x, v[j].y); w.y = pk2(v[j].z, v[j].w); brow[lane + 64 * j] = w;
        }
    }
}
__device__ __forceinline__ void ph_convert_experts(LAS unsigned char* ldsl, const float* wg, const float* wu, const float* wd, bf16_t* W_GU, bf16_t* W_DN) {
    const int tid = tid_opaque(), lane = tid & 63, wave = __builtin_amdgcn_readfirstlane(tid >> 6);
    LAS float* scr = (LAS float*)(ldsl + wave * 16384);
    const int gw = blockIdx.x * NWAVES + wave, NGW = gridDim.x * NWAVES;
    for (int it = gw; it < 16 * 768; it += NGW) {
        const int e = it / 768, r = it % 768;
        if (r < 512) {
            const int bj = r >> 8, item = r & 255, n0 = 32 * (item % 16);
            const float* W = (bj ? wu : wg) + (size_t)e * D_MODEL * D_FF;
            p0_transpose_item(W, 1024, 512, W_GU + (size_t)e * 1024 * 1024, 256 * (n0 >> 7) + 128 * bj + (n0 & 127) - n0, scr, item, lane);
        } else {
            p0_transpose_item(wd + (size_t)e * D_FF * D_MODEL, 512, 1024, W_DN + (size_t)e * 1024 * 512, 0, scr, r - 512, lane);
        }
    }
}


typedef short bf16x8 __attribute__((ext_vector_type(8)));
#define MFMA16(a, b, c) __builtin_amdgcn_mfma_f32_16x16x32_bf16((a), (b), (c), 0, 0, 0)
#define WAVE_LDS_FENCE() asm volatile("s_waitcnt lgkmcnt(0)" ::: "memory")

constexpr int SB_KS_OFF = 0, SB_VT_OFF = 9216, SB_Z_OFF = 18432, SB_W_OFF = SB_Z_OFF + 8 * 8704, SB_FLAG_OFF = SB_W_OFF + 8 * 4608;
constexpr float SB_THR = 104.0f;
__device__ __forceinline__ void ph_sb_attn2(unsigned char* lds, const bf16_t* proj, bf16_t* mix) {
    const int tid = tid_opaque(), lane = tid & 63, wave = __builtin_amdgcn_readfirstlane(tid >> 6), fr = lane & 15, fq = lane >> 4;
    bf16_t* Ks = (bf16_t*)(lds + SB_KS_OFF);
    bf16_t* Vt = (bf16_t*)(lds + SB_VT_OFF);
    float* Zs = (float*)(lds + SB_Z_OFF + wave * 8704);
    bf16_t* Ws = (bf16_t*)(lds + SB_W_OFF + wave * 4608);
    volatile int* flags = (volatile int*)(lds + SB_FLAG_OFF);
    const int qs = lane >> 1, hs = lane & 1;
    for (int unit = blockIdx.x; unit < BATCH * 8 * (SEQ / 256); unit += gridDim.x) {
        const int bh = unit & 15, qc = unit >> 4, b = bh >> 3, h = bh & 7, q0 = qc * 256;
        const size_t rowbase = (size_t)b * SEQ;
        bf16x8 qf[2][2];
#pragma unroll
        for (int mt = 0; mt < 2; ++mt)
#pragma unroll
            for (int ks = 0; ks < 2; ++ks) {
                const v4u raw = *(const v4u*)(proj + (rowbase + q0 + 32 * wave + mt * 16 + fr) * AB_IN + h * 64 + ks * 32 + fq * 8);
                v4u sc;
                sc.x = pk2(bflo(raw.x) * 0.125f, bfhi(raw.x) * 0.125f); sc.y = pk2(bflo(raw.y) * 0.125f, bfhi(raw.y) * 0.125f);
                sc.z = pk2(bflo(raw.z) * 0.125f, bfhi(raw.z) * 0.125f); sc.w = pk2(bflo(raw.w) * 0.125f, bfhi(raw.w) * 0.125f);
                qf[mt][ks] = __builtin_bit_cast(bf16x8, sc);
            }
        f32x4 o[2][4];
#pragma unroll
        for (int mt = 0; mt < 2; ++mt)
#pragma unroll
            for (int nt = 0; nt < 4; ++nt) o[mt][nt] = (f32x4){0.f, 0.f, 0.f, 0.f};
        float carry = 0.f;
        const int t_row = q0 + 32 * wave + qs, tmax_w = q0 + 32 * wave + 31;
        bool wave_done = false;
        for (int kt = (q0 >> 6) + 3; kt >= 0; --kt) {
            {
                const int r = tid >> 3, c = tid & 7;
                const bf16_t* rp = proj + (rowbase + kt * 64 + r) * AB_IN + h * 64 + c * 8;
                const v4u kv = *(const v4u*)(rp + 512); const v4u vv = *(const v4u*)(rp + 1024);
                *(v4u*)(Ks + r * 72 + c * 8) = kv;
                bf16_t* vp = Vt + (c * 8) * 72 + r;
                vp[0 * 72] = (bf16_t)(vv.x & 0xffffu); vp[1 * 72] = (bf16_t)(vv.x >> 16); vp[2 * 72] = (bf16_t)(vv.y & 0xffffu); vp[3 * 72] = (bf16_t)(vv.y >> 16);
                vp[4 * 72] = (bf16_t)(vv.z & 0xffffu); vp[5 * 72] = (bf16_t)(vv.z >> 16); vp[6 * 72] = (bf16_t)(vv.w & 0xffffu); vp[7 * 72] = (bf16_t)(vv.w >> 16);
            }
            __syncthreads();
            if (!wave_done && kt * 64 < tmax_w) {
#pragma unroll
                for (int nt = 0; nt < 4; ++nt) {
                    const bf16x8 b0 = *(const bf16x8*)(Ks + (nt * 16 + fr) * 72 + fq * 8), b1 = *(const bf16x8*)(Ks + (nt * 16 + fr) * 72 + 32 + fq * 8);
#pragma unroll
                    for (int mt = 0; mt < 2; ++mt) {
                        f32x4 z4 = MFMA16(qf[mt][0], b0, ((f32x4){0.f, 0.f, 0.f, 0.f}));
                        z4 = MFMA16(qf[mt][1], b1, z4);
#pragma unroll
                        for (int rg = 0; rg < 4; ++rg) Zs[(mt * 16 + fq * 4 + rg) * 68 + nt * 16 + fr] = z4[rg];
                    }
                }
                WAVE_LDS_FENCE();
                float zz[32];
#pragma unroll
                for (int k4 = 0; k4 < 8; ++k4) { const f32x4 v = *(const f32x4*)(Zs + qs * 68 + hs * 32 + k4 * 4); zz[k4 * 4 + 0] = v[0]; zz[k4 * 4 + 1] = v[1]; zz[k4 * 4 + 2] = v[2]; zz[k4 * 4 + 3] = v[3]; }
                const int s0 = kt * 64 + hs * 32;
                float run = 0.f;
                float lw[32];
#pragma unroll
                for (int i = 31; i >= 0; --i) {
                    const float z = zz[i];
                    const float sp = fmaxf(z, 0.f) + __logf(1.f + __expf(-fabsf(z)));
                    const bool valid = (s0 + i) < t_row;
                    lw[i] = valid ? (z - sp - run) : -INFINITY;
                    run += valid ? sp : 0.f;
                }
                const float other = __shfl_xor(run, 1);
                const float base = carry + (hs == 0 ? other : 0.f);
                carry += run + other;
                unsigned pw[16];
#pragma unroll
                for (int i = 0; i < 32; i += 2) pw[i >> 1] = pk2(__expf(lw[i] - base), __expf(lw[i + 1] - base));
#pragma unroll
                for (int k4 = 0; k4 < 4; ++k4) { v4u w4; w4.x = pw[k4 * 4]; w4.y = pw[k4 * 4 + 1]; w4.z = pw[k4 * 4 + 2]; w4.w = pw[k4 * 4 + 3]; *(v4u*)(Ws + qs * 72 + hs * 32 + k4 * 8) = w4; }
                WAVE_LDS_FENCE();
#pragma unroll
                for (int ks = 0; ks < 2; ++ks) {
                    const bf16x8 a0 = *(const bf16x8*)(Ws + fr * 72 + ks * 32 + fq * 8), a1 = *(const bf16x8*)(Ws + (16 + fr) * 72 + ks * 32 + fq * 8);
#pragma unroll
                    for (int nt = 0; nt < 4; ++nt) {
                        const bf16x8 bv = *(const bf16x8*)(Vt + (nt * 16 + fr) * 72 + ks * 32 + fq * 8);
                        o[0][nt] = MFMA16(a0, bv, o[0][nt]); o[1][nt] = MFMA16(a1, bv, o[1][nt]);
                    }
                }
                wave_done = __all(carry > SB_THR) != 0;
            }
            if (lane == 0) flags[wave] = wave_done ? 1 : 0;
            __syncthreads();
            int nd = 0;
#pragma unroll
            for (int w8 = 0; w8 < 8; ++w8) nd += flags[w8];
            if (nd == 8) break;
        }
        WAVE_LDS_FENCE();
#pragma unroll
        for (int mt = 0; mt < 2; ++mt)
#pragma unroll
            for (int nt = 0; nt < 4; ++nt)
#pragma unroll
                for (int rg = 0; rg < 4; ++rg) Ws[(mt * 16 + fq * 4 + rg) * 72 + nt * 16 + fr] = (bf16_t)f2bf(o[mt][nt][rg]);
        WAVE_LDS_FENCE();
#pragma unroll
        for (int i = 0; i < 4; ++i) { const int id = i * 64 + lane, row = id >> 3, c = id & 7;
            *(v4u*)(mix + (rowbase + q0 + 32 * wave + row) * D_MODEL + h * 64 + c * 8) = *(const v4u*)(Ws + row * 72 + c * 8); }
        __syncthreads();
    }
}

constexpr int LRU_SLOT = 17408;
template <bool FINAL>
__device__ __forceinline__ void ph_lru(unsigned char* lds, const bf16_t* proj, const float* conv_w, const float* conv_b, const bf16_t* wt, const float* b_r, const float* b_i,
                                       const float* lam, float2* sum, bf16_t* mix) {
    const int tid = tid_opaque(), lane = tid & 63, wave = __builtin_amdgcn_readfirstlane(tid >> 6), fr = lane & 15, fq = lane >> 4;
    bf16_t* XC = (bf16_t*)(lds + wave * LRU_SLOT);
    float* AUa = (float*)(lds + wave * LRU_SLOT + 9216);
    float* AUu = AUa + 1024;
    const int ch = wave * 64 + lane;
    const float cw0 = conv_w[ch], cw1 = conv_w[512 + ch], cw2 = conv_w[1024 + ch], cw3 = conv_w[1536 + ch], cb = conv_b[ch];
    bf16x8 wr[4][2], wi[4][2];
    float br[4], bi[4], spl[4];
#pragma unroll
    for (int nt = 0; nt < 4; ++nt) {
#pragma unroll
        for (int ks = 0; ks < 2; ++ks) {
            wr[nt][ks] = *(const bf16x8*)(wt + ((size_t)(0 * 8 + wave) * 64 + nt * 16 + fr) * 64 + ks * 32 + fq * 8);
            wi[nt][ks] = *(const bf16x8*)(wt + ((size_t)(1 * 8 + wave) * 64 + nt * 16 + fr) * 64 + ks * 32 + fq * 8);
        }
        const int cd = wave * 64 + nt * 16 + fr;
        br[nt] = b_r[cd]; bi[nt] = b_i[cd];
        const float nl = -lam[cd]; spl[nt] = fmaxf(nl, 0.f) + log1pf(expf(-fabsf(nl)));
    }
    for (int unit = blockIdx.x; unit < BATCH * (SEQ / 64); unit += gridDim.x) {
        const int b = unit >> 7, chunk = unit & 127;
        const size_t tokbase = (size_t)b * SEQ + chunk * 64;
        {
            float xm3 = 0.f, xm2 = 0.f, xm1 = 0.f;
            if (chunk > 0) { xm3 = bf2f(proj[(tokbase - 3) * AB_IN + 1536 + ch]); xm2 = bf2f(proj[(tokbase - 2) * AB_IN + 1536 + ch]); xm1 = bf2f(proj[(tokbase - 1) * AB_IN + 1536 + ch]); }
#pragma unroll 8
            for (int i = 0; i < 64; ++i) {
                const float x = bf2f(proj[(tokbase + i) * AB_IN + 1536 + ch]);
                const float y = cb + cw0 * xm3 + cw1 * xm2 + cw2 * xm1 + cw3 * x;
                XC[i * 72 + lane] = (bf16_t)f2bf(y);
                xm3 = xm2; xm2 = xm1; xm1 = x;
            }
        }
        float hst = 0.f, ap = 1.f;
        if (FINAL) {
            for (int j = 0; j < chunk; ++j) { const float2 sj = sum[(size_t)(b * 128 + j) * 512 + ch]; hst = sj.x * hst + sj.y; }
        }
        WAVE_LDS_FENCE();
#pragma unroll 1
        for (int mt = 0; mt < 4; ++mt) {
            const bf16x8 a0 = *(const bf16x8*)(XC + (mt * 16 + fr) * 72 + fq * 8), a1 = *(const bf16x8*)(XC + (mt * 16 + fr) * 72 + 32 + fq * 8);
#pragma unroll
            for (int nt = 0; nt < 4; ++nt) {
                f32x4 cr = MFMA16(a0, wr[nt][0], ((f32x4){0.f, 0.f, 0.f, 0.f})); cr = MFMA16(a1, wr[nt][1], cr);
                f32x4 ci = MFMA16(a0, wi[nt][0], ((f32x4){0.f, 0.f, 0.f, 0.f})); ci = MFMA16(a1, wi[nt][1], ci);
#pragma unroll
                for (int rg = 0; rg < 4; ++rg) {
                    const int tokl = fq * 4 + rg, d = nt * 16 + fr;
                    const float r = 1.f / (1.f + __expf(-(cr[rg] + br[nt]))), ig = 1.f / (1.f + __expf(-(ci[rg] + bi[nt])));
                    const float la = -8.0f * r * spl[nt];
                    const float xv = bf2f(XC[(mt * 16 + tokl) * 72 + d]);
                    AUa[tokl * 64 + d] = __expf(la);
                    AUu[tokl * 64 + d] = sqrtf(-expm1f(2.0f * la)) * (ig * xv);
                }
            }
            WAVE_LDS_FENCE();
#pragma unroll
            for (int tl = 0; tl < 16; ++tl) {
                const float a = AUa[tl * 64 + lane], u = AUu[tl * 64 + lane];
                hst = a * hst + u; ap *= a;
                if (FINAL) {
                    const size_t tok = tokbase + mt * 16 + tl;
                    const float g = bf2f(proj[tok * AB_IN + 2048 + ch]);
                    mix[tok * D_MODEL + 512 + ch] = (bf16_t)f2bf(gelu_tanh(g) * hst);
                }
            }
            WAVE_LDS_FENCE();
        }
        if (!FINAL) sum[(size_t)(b * 128 + chunk) * 512 + ch] = make_float2(ap, hst);
    }
}

constexpr int SWA_SC_OFF = SB_FLAG_OFF + 64;
__device__ __forceinline__ void ph_swa2(unsigned char* lds, const bf16_t* proj, const float2* rope, const float* sinks, bf16_t* mix) {
    const int tid = tid_opaque(), lane = tid & 63, wave = __builtin_amdgcn_readfirstlane(tid >> 6), fr = lane & 15, fq = lane >> 4;
    bf16_t* Ks = (bf16_t*)(lds + SB_KS_OFF);
    bf16_t* Vt = (bf16_t*)(lds + SB_VT_OFF);
    float* Zs = (float*)(lds + SB_Z_OFF + wave * 8704);
    bf16_t* Ws = (bf16_t*)(lds + SB_W_OFF + wave * 4608);
    float* SC = (float*)(lds + SWA_SC_OFF + wave * 256);
    float* LS = SC + 32;
    const int qs = lane >> 1, hs = lane & 1, g = wave >> 1, qh = wave & 1;
    for (int unit = blockIdx.x; unit < BATCH * 4 * (SEQ / 64); unit += gridDim.x) {
        const int bk = unit & 7, qb = unit >> 3, b = bk >> 2, kv = bk & 3, hq = kv * 4 + g, t0 = qb * 64;
        const size_t rowbase = (size_t)b * SEQ;
        bf16x8 qf[2][2];
#pragma unroll
        for (int mt = 0; mt < 2; ++mt) {
            const size_t tok = rowbase + t0 + 32 * qh + mt * 16 + fr;
            const v4u r0 = *(const v4u*)(proj + tok * C_IN + hq * 64 + fq * 8), r1 = *(const v4u*)(proj + tok * C_IN + hq * 64 + 32 + fq * 8);
            const unsigned w0[4] = {r0.x, r0.y, r0.z, r0.w}, w1[4] = {r1.x, r1.y, r1.z, r1.w};
            unsigned o0[4], o1[4];
#pragma unroll
            for (int j2 = 0; j2 < 4; ++j2) {
                const float4 cs = *(const float4*)(rope + tok * 32 + fq * 8 + j2 * 2);
                const float a0 = bflo(w0[j2]), a1 = bfhi(w0[j2]), c0 = bflo(w1[j2]), c1 = bfhi(w1[j2]);
                o0[j2] = pk2((a0 * cs.x - c0 * cs.y) * 0.125f, (a1 * cs.z - c1 * cs.w) * 0.125f);
                o1[j2] = pk2((c0 * cs.x + a0 * cs.y) * 0.125f, (c1 * cs.z + a1 * cs.w) * 0.125f);
            }
            v4u p0; p0.x = o0[0]; p0.y = o0[1]; p0.z = o0[2]; p0.w = o0[3];
            v4u p1; p1.x = o1[0]; p1.y = o1[1]; p1.z = o1[2]; p1.w = o1[3];
            qf[mt][0] = __builtin_bit_cast(bf16x8, p0); qf[mt][1] = __builtin_bit_cast(bf16x8, p1);
        }
        f32x4 o[2][4];
#pragma unroll
        for (int mt = 0; mt < 2; ++mt)
#pragma unroll
            for (int nt = 0; nt < 4; ++nt) o[mt][nt] = (f32x4){0.f, 0.f, 0.f, 0.f};
        float mrun = sinks[hq], lrun = 1.f;
        const int t_row = t0 + 32 * qh + qs;
        for (int kt = qb - 2; kt <= qb; ++kt) {
            if (kt < 0) continue;
            __syncthreads();
            {
                const int r = tid >> 3, c = tid & 7;
                const size_t tok = rowbase + kt * 64 + r;
                if (c < 4) {
                    const v4u r0 = *(const v4u*)(proj + tok * C_IN + 1024 + kv * 64 + c * 8), r1 = *(const v4u*)(proj + tok * C_IN + 1024 + kv * 64 + 32 + c * 8);
                    const unsigned w0[4] = {r0.x, r0.y, r0.z, r0.w}, w1[4] = {r1.x, r1.y, r1.z, r1.w};
                    unsigned o0[4], o1[4];
#pragma unroll
                    for (int j2 = 0; j2 < 4; ++j2) {
                        const float4 cs = *(const float4*)(rope + tok * 32 + c * 8 + j2 * 2);
                        const float a0 = bflo(w0[j2]), a1 = bfhi(w0[j2]), c0 = bflo(w1[j2]), c1 = bfhi(w1[j2]);
                        o0[j2] = pk2(a0 * cs.x - c0 * cs.y, a1 * cs.z - c1 * cs.w);
                        o1[j2] = pk2(c0 * cs.x + a0 * cs.y, c1 * cs.z + a1 * cs.w);
                    }
                    v4u p0; p0.x = o0[0]; p0.y = o0[1]; p0.z = o0[2]; p0.w = o0[3];
                    v4u p1; p1.x = o1[0]; p1.y = o1[1]; p1.z = o1[2]; p1.w = o1[3];
                    *(v4u*)(Ks + r * 72 + c * 8) = p0; *(v4u*)(Ks + r * 72 + 32 + c * 8) = p1;
                } else {
                    const int cc = c - 4;
                    const v4u v0 = *(const v4u*)(proj + tok * C_IN + 1280 + kv * 64 + cc * 16), v1 = *(const v4u*)(proj + tok * C_IN + 1280 + kv * 64 + cc * 16 + 8);
                    bf16_t* vp = Vt + (cc * 16) * 72 + r;
                    vp[0 * 72] = (bf16_t)(v0.x & 0xffffu); vp[1 * 72] = (bf16_t)(v0.x >> 16); vp[2 * 72] = (bf16_t)(v0.y & 0xffffu); vp[3 * 72] = (bf16_t)(v0.y >> 16);
                    vp[4 * 72] = (bf16_t)(v0.z & 0xffffu); vp[5 * 72] = (bf16_t)(v0.z >> 16); vp[6 * 72] = (bf16_t)(v0.w & 0xffffu); vp[7 * 72] = (bf16_t)(v0.w >> 16);
                    vp[8 * 72] = (bf16_t)(v1.x & 0xffffu); vp[9 * 72] = (bf16_t)(v1.x >> 16); vp[10 * 72] = (bf16_t)(v1.y & 0xffffu); vp[11 * 72] = (bf16_t)(v1.y >> 16);
                    vp[12 * 72] = (bf16_t)(v1.z & 0xffffu); vp[13 * 72] = (bf16_t)(v1.z >> 16); vp[14 * 72] = (bf16_t)(v1.w & 0xffffu); vp[15 * 72] = (bf16_t)(v1.w >> 16);
                }
            }
            __syncthreads();
#pragma unroll
            for (int nt = 0; nt < 4; ++nt) {
                const bf16x8 b0 = *(const bf16x8*)(Ks + (nt * 16 + fr) * 72 + fq * 8), b1 = *(const bf16x8*)(Ks + (nt * 16 + fr) * 72 + 32 + fq * 8);
#pragma unroll
                for (int mt = 0; mt < 2; ++mt) {
                    f32x4 z4 = MFMA16(qf[mt][0], b0, ((f32x4){0.f, 0.f, 0.f, 0.f}));
                    z4 = MFMA16(qf[mt][1], b1, z4);
#pragma unroll
                    for (int rg = 0; rg < 4; ++rg) Zs[(mt * 16 + fq * 4 + rg) * 68 + nt * 16 + fr] = z4[rg];
                }
            }
            WAVE_LDS_FENCE();
            float zz[32];
#pragma unroll
            for (int k4 = 0; k4 < 8; ++k4) { const f32x4 v = *(const f32x4*)(Zs + qs * 68 + hs * 32 + k4 * 4); zz[k4 * 4 + 0] = v[0]; zz[k4 * 4 + 1] = v[1]; zz[k4 * 4 + 2] = v[2]; zz[k4 * 4 + 3] = v[3]; }
            const int s0 = kt * 64 + hs * 32;
            float tmx = -INFINITY;
#pragma unroll
            for (int i = 0; i < 32; ++i) { const int s = s0 + i; const bool valid = (s <= t_row) && (t_row - s < 128); zz[i] = valid ? zz[i] : -INFINITY; tmx = fmaxf(tmx, zz[i]); }
            tmx = fmaxf(tmx, __shfl_xor(tmx, 1));
            const float mnew = fmaxf(mrun, tmx);
            const float scl = __expf(mrun - mnew);
            float psum = 0.f;
            unsigned pw[16];
#pragma unroll
            for (int i = 0; i < 32; i += 2) { const float p0 = __expf(zz[i] - mnew), p1 = __expf(zz[i + 1] - mnew); psum += p0 + p1; pw[i >> 1] = pk2(p0, p1); }
            psum += __shfl_xor(psum, 1);
            lrun = lrun * scl + psum; mrun = mnew;
#pragma unroll
            for (int k4 = 0; k4 < 4; ++k4) { v4u w4; w4.x = pw[k4 * 4]; w4.y = pw[k4 * 4 + 1]; w4.z = pw[k4 * 4 + 2]; w4.w = pw[k4 * 4 + 3]; *(v4u*)(Ws + qs * 72 + hs * 32 + k4 * 8) = w4; }
            if (hs == 0) SC[qs] = scl;
            WAVE_LDS_FENCE();
#pragma unroll
            for (int mt = 0; mt < 2; ++mt) {
                const f32x4 sc4 = *(const f32x4*)(SC + mt * 16 + fq * 4);
#pragma unroll
                for (int nt = 0; nt < 4; ++nt) { o[mt][nt][0] *= sc4[0]; o[mt][nt][1] *= sc4[1]; o[mt][nt][2] *= sc4[2]; o[mt][nt][3] *= sc4[3]; }
            }
#pragma unroll
            for (int ks = 0; ks < 2; ++ks) {
                const bf16x8 a0 = *(const bf16x8*)(Ws + fr * 72 + ks * 32 + fq * 8), a1 = *(const bf16x8*)(Ws + (16 + fr) * 72 + ks * 32 + fq * 8);
#pragma unroll
                for (int nt = 0; nt < 4; ++nt) {
                    const bf16x8 bv = *(const bf16x8*)(Vt + (nt * 16 + fr) * 72 + ks * 32 + fq * 8);
                    o[0][nt] = MFMA16(a0, bv, o[0][nt]); o[1][nt] = MFMA16(a1, bv, o[1][nt]);
                }
            }
            WAVE_LDS_FENCE();
        }
        if (hs == 0) LS[qs] = 1.f / lrun;
        WAVE_LDS_FENCE();
#pragma unroll
        for (int mt = 0; mt < 2; ++mt) {
            const f32x4 li = *(const f32x4*)(LS + mt * 16 + fq * 4);
#pragma unroll
            for (int nt = 0; nt < 4; ++nt)
#pragma unroll
                for (int rg = 0; rg < 4; ++rg) Ws[(mt * 16 + fq * 4 + rg) * 72 + nt * 16 + fr] = (bf16_t)f2bf(o[mt][nt][rg] * li[rg]);
        }
        WAVE_LDS_FENCE();
#pragma unroll
        for (int i = 0; i < 4; ++i) { const int id = i * 64 + lane, row = id >> 3, c = id & 7;
            *(v4u*)(mix + (rowbase + t0 + 32 * qh + row) * D_MODEL + hq * 64 + c * 8) = *(const v4u*)(Ws + row * 72 + c * 8); }
    }
    __syncthreads();
}

struct Args {
    const void* in[27];
    float* out;
    unsigned char* ws;
};

__global__ void __launch_bounds__(NTHREADS, 2) fwd_megakernel(Args args) {
    extern __shared__ __attribute__((aligned(16))) unsigned char lds[];
    cg::grid_group grid = cg::this_grid();
#define GRID_BAR() grid.sync()
    const float* x_in = (const float*)args.in[0];
    const float* p_in = (const float*)args.in[1];
    const int* positions = (const int*)args.in[2];
    const float* w_in_ab = (const float*)args.in[3];
    const float* w_out_ab = (const float*)args.in[4];
    const float* conv_w = (const float*)args.in[5];
    const float* conv_b = (const float*)args.in[6];
    const float* lru_w_r = (const float*)args.in[7];
    const float* lru_b_r = (const float*)args.in[8];
    const float* lru_w_i = (const float*)args.in[9];
    const float* lru_b_i = (const float*)args.in[10];
    const float* lru_lambda = (const float*)args.in[11];
    const float* w_qkv_c = (const float*)args.in[12];
    const float* w_out_c = (const float*)args.in[13];
    const float* sinks_c = (const float*)args.in[14];
    const float* ln_mix_g = (const float*)args.in[15];
    const float* ln_mix_b = (const float*)args.in[16];
    const float* ln_ffn_g = (const float*)args.in[17];
    const float* ln_ffn_b = (const float*)args.in[18];
    const float* w_router = (const float*)args.in[19];
    const float* b_router = (const float*)args.in[20];
    const float* exp_w_gate = (const float*)args.in[21];
    const float* exp_w_up = (const float*)args.in[22];
    const float* exp_w_down = (const float*)args.in[23];
    const float* ple_w_proj = (const float*)args.in[24];
    const float* ple_w_gate = (const float*)args.in[25];
    const float* ple_b_gate = (const float*)args.in[26];
    float* out = args.out;
    unsigned char* ws = args.ws;
    bf16_t* W_IN = (bf16_t*)(ws + WS_W_IN); bf16_t* W_OUTAB = (bf16_t*)(ws + WS_W_OUTAB); bf16_t* W_QKV = (bf16_t*)(ws + WS_W_QKV); bf16_t* W_OUTC = (bf16_t*)(ws + WS_W_OUTC);
    bf16_t* W_PLEG = (bf16_t*)(ws + WS_W_PLEG); bf16_t* W_PLEP = (bf16_t*)(ws + WS_W_PLEP);
    bf16_t* PROJ = (bf16_t*)(ws + WS_PROJ); bf16_t* MIX = (bf16_t*)(ws + WS_MIX); bf16_t* XNA = (bf16_t*)(ws + WS_XNA); bf16_t* XNB = (bf16_t*)(ws + WS_XNB);
    bf16_t* PP = (bf16_t*)(ws + WS_PP); bf16_t* PB = (bf16_t*)(ws + WS_PB);
    int* EIDX = (int*)(ws + WS_EIDX); float* GATEW = (float*)(ws + WS_GATEW); int* LIST = (int*)(ws + WS_LIST); int* POS = (int*)(ws + WS_POS);
    unsigned* CTL = (unsigned*)(ws + WS_CTL);
    float2* ROPE = (float2*)(ws + WS_ROPE);
    float2* LRUSUM = (float2*)(ws + WS_LRUSUM); bf16_t* LRUW = (bf16_t*)(ws + WS_LRUW);
    bf16_t* W_GU = (bf16_t*)(ws + WS_W_GU); bf16_t* W_DN = (bf16_t*)(ws + WS_W_DN); bf16_t* XS = (bf16_t*)(ws + WS_XS); bf16_t* HB = (bf16_t*)(ws + WS_H);
    float* HOUT = (float*)(ws + WS_PROJ);
    const int tid = threadIdx.x, lane = tid & 63, wave = __builtin_amdgcn_readfirstlane(tid >> 6);
    LAS unsigned char* ldsl = (LAS unsigned char*)lds;

    if (blockIdx.x == 0 && tid < 32) CTL[CW_CNT + tid] = 0u;
    ph_convert_experts(ldsl, lnd(exp_w_gate), lnd(exp_w_up), lnd(exp_w_down), lnd(W_GU), lnd(W_DN));
    {
        LAS float* scr = (LAS float*)(ldsl + wave * 16384);
        const int gw = blockIdx.x * NWAVES + wave, NGW = gridDim.x * NWAVES;
        constexpr int I_IN = 16 * 80, I_SQ = 16 * 32, I_QKV = 16 * 48, I_PP = 4 * 32;
        constexpr int NITEMS = I_IN + I_SQ + I_QKV + I_SQ + 2 * I_SQ + 2 * I_PP + 32;
        for (int it = gw; it < NITEMS; it += NGW) {
            int r = it;
            if (r < I_IN) { p0_transpose_item(w_in_ab, 1024, 2560, W_IN, 0, scr, r, lane); continue; } r -= I_IN;
            if (r < I_SQ) { p0_transpose_item(w_out_ab, 1024, 1024, W_OUTAB, 0, scr, r, lane); continue; } r -= I_SQ;
            if (r < I_QKV) { p0_transpose_item(w_qkv_c, 1024, 1536, W_QKV, 0, scr, r, lane); continue; } r -= I_QKV;
            if (r < I_SQ) { p0_transpose_item(w_out_c, 1024, 1024, W_OUTC, 0, scr, r, lane); continue; } r -= I_SQ;
            if (r < I_SQ) { p0_transpose_item(ple_w_gate, 1024, 1024, W_PLEG, 0, scr, r, lane); continue; } r -= I_SQ;
            if (r < I_SQ) { p0_transpose_item(ple_w_gate + (size_t)1024 * 1024, 1024, 1024, W_PLEG + (size_t)1024 * 1024, 0, scr, r, lane); continue; } r -= I_SQ;
            if (r < I_PP) { p0_transpose_item(ple_w_proj, 256, 1024, W_PLEP, 0, scr, r, lane); continue; } r -= I_PP;
            if (r < I_PP) { p0_transpose_item(ple_w_proj + (size_t)256 * 1024, 256, 1024, W_PLEP + (size_t)1024 * 256, 0, scr, r, lane); continue; } r -= I_PP;
            {
                const int mtx = r >> 1; const float* src = (mtx < 8 ? lru_w_r + mtx * 4096 : lru_w_i + (mtx - 8) * 4096);
                p0_transpose_item(src, 64, 64, LRUW + (size_t)mtx * 4096, 0, scr, r & 1, lane);
            }
        }
        for (int idx = blockIdx.x * NTHREADS + tid; idx < NTOK * 32; idx += gridDim.x * NTHREADS) {
            const int i = idx & 31, tok = idx >> 5;
            const float ang = (float)positions[tok] * powf(10000.0f, -(float)i / 32.0f);
            ROPE[idx] = make_float2(cosf(ang), sinf(ang));
        }
        for (int m = gw; m < NTOK; m += NGW) row1024_to_bf16(x_in + (size_t)m * D_MODEL, XNA + (size_t)m * D_MODEL, lane);
        for (int m = gw; m < 2 * NTOK; m += NGW) {
            const f32x4 v = *((const f32x4*)(p_in + (size_t)m * PLE_DIM) + lane);
            v2u w; w.x = pk2(v[0], v[1]); w.y = pk2(v[2], v[3]);
            *((v2u*)(PB + (size_t)m * PLE_DIM) + lane) = w;
        }
    }
    GRID_BAR();

#pragma unroll
    for (int layer = 0; layer < 2; ++layer) {
        const float* xin = (layer == 0) ? x_in : out;
        if (layer == 0) {
            pg8::Gemm g{XNA, W_IN, NTOK, AB_IN, D_MODEL}; pg8::StaticOrder S; S.init(NTOK, AB_IN, (int)gridDim.x, (int)blockIdx.x);
            pg8::EpiBf16<0> E{PROJ, AB_IN, nullptr, 0, 0, 1.f};
            pg8::gemm_phase<pg8::EpiBf16<0>, pg8::StaticOrder, PG8_ALIGN, PG8_SP2>(ldsl, g, S, E);
        } else {
            pg8::Gemm g{XNA, W_QKV, NTOK, C_IN, D_MODEL}; pg8::StaticOrder S; S.init(NTOK, C_IN, (int)gridDim.x, (int)blockIdx.x);
            pg8::EpiBf16<0> E{PROJ, C_IN, nullptr, 0, 0, 1.f};
            pg8::gemm_phase<pg8::EpiBf16<0>, pg8::StaticOrder, PG8_ALIGN, PG8_SP2>(ldsl, g, S, E);
        }
        {
            pg8::Gemm g{PB + (size_t)layer * NTOK * PLE_DIM, W_PLEP + (size_t)layer * 1024 * 256, NTOK, D_MODEL, PLE_DIM}; pg8::StaticOrder S; S.init(NTOK, D_MODEL, (int)gridDim.x, (int)blockIdx.x);
            pg8::EpiBf16<0> E{PP, D_MODEL, nullptr, 0, 0, 1.f};
            pg8::gemm_phase<pg8::EpiBf16<0>, pg8::StaticOrder, PG8_ALIGN, PG8_SP2>(ldsl, g, S, E);
        }
        GRID_BAR();
        if (layer == 0) {
            ph_lru<false>(lds, lnd(PROJ), lnd(conv_w), lnd(conv_b), lnd(LRUW), lnd(lru_b_r), lnd(lru_b_i), lnd(lru_lambda), lnd(LRUSUM), lnd(MIX));
            GRID_BAR();
            ph_sb_attn2(lds, lnd(PROJ), lnd(MIX));
            ph_lru<true>(lds, lnd(PROJ), lnd(conv_w), lnd(conv_b), lnd(LRUW), lnd(lru_b_r), lnd(lru_b_i), lnd(lru_lambda), lnd(LRUSUM), lnd(MIX));
        } else {
            ph_swa2(lds, lnd(PROJ), lnd(ROPE), lnd(sinks_c), lnd(MIX));
        }
        GRID_BAR();
        {
            pg8::Gemm g{MIX, layer == 0 ? W_OUTAB : W_OUTC, NTOK, D_MODEL, D_MODEL}; pg8::StaticOrder S; S.init(NTOK, D_MODEL, (int)gridDim.x, (int)blockIdx.x);
            EpiF32 E{HOUT, D_MODEL};
            pg8::gemm_phase<EpiF32, pg8::StaticOrder, PG8_ALIGN, PG8_SP2>(ldsl, g, S, E);
        }
        GRID_BAR();
        ph_res_ln<false>(lnd(xin), lnd(HOUT), lnd(ln_mix_g + layer * D_MODEL), lnd(ln_mix_b + layer * D_MODEL), lnd(out), lnd(XNA), (const float*)nullptr, (const float*)nullptr, (int*)nullptr, (float*)nullptr);
        if (layer == 1) ph_convert_experts(ldsl, lnd(exp_w_gate + (size_t)N_EXP * D_MODEL * D_FF), lnd(exp_w_up + (size_t)N_EXP * D_MODEL * D_FF), lnd(exp_w_down + (size_t)N_EXP * D_FF * D_MODEL), lnd(W_GU), lnd(W_DN));
        GRID_BAR();
        ph_route(lds, lnd(out), lnd(w_router), lnd(b_router), lnd(GATEW), lnd(CTL + CW_CNT + 16 * layer), lnd(LIST));
        GRID_BAR();
        ph_permute(lds, lnd(CTL + CW_CNT + 16 * layer), lnd(LIST), lnd(XNA), lnd(XS), lnd(POS));
        GRID_BAR();
        {
            moe_offsets(lds, lnd(CTL + CW_CNT + 16 * layer));
            MoeOrder S{(const LAS int*)(ldsl + MISC_OFF + 2048), (int)gridDim.x, (int)blockIdx.x};
            pg8::Gemm g{XS, W_GU, 0, 0, D_MODEL};
            EpiGU E{HB};
            pg8::gemm_phase<EpiGU, MoeOrder, PG8_ALIGN, PG8_SP2>(ldsl, g, S, E);
        }
        GRID_BAR();
        {
            MoeOrder S{(const LAS int*)(ldsl + MISC_OFF + 2048), (int)gridDim.x, (int)blockIdx.x};
            pg8::Gemm g{HB, W_DN, 0, 0, D_FF};
            EpiBf16N E{XS, D_MODEL};
            pg8::gemm_phase<EpiBf16N, MoeOrder, PG8_ALIGN, PG8_SP2>(ldsl, g, S, E);
        }
        GRID_BAR();
        ph_combine_ln(lnd(out), lnd(XS), lnd(POS), lnd(GATEW), lnd(ln_ffn_g + layer * D_MODEL), lnd(ln_ffn_b + layer * D_MODEL), lnd(out), lnd(XNB));
        GRID_BAR();
        {
            pg8::Gemm g{XNB, W_PLEG + (size_t)layer * 1024 * 1024, NTOK, D_MODEL, D_MODEL}; pg8::StaticOrder S; S.init(NTOK, D_MODEL, (int)gridDim.x, (int)blockIdx.x);
            EpiPle E{out, PP, XNA, ple_b_gate + layer * D_MODEL};
            pg8::gemm_phase<EpiPle, pg8::StaticOrder, PG8_ALIGN, PG8_SP2>(ldsl, g, S, E);
        }
        if (layer == 0) GRID_BAR();
    }
}
}

extern "C" void kernel_launch(void* const* d_in, const int* in_sizes, int n_in, void* d_out, int out_size, void* d_ws, size_t ws_size,
                              hipStream_t stream) {
    static int grid_blocks = 0;
    if (grid_blocks == 0) {
        int dev = 0, cus = 0, per_cu = 0;
        (void)hipGetDevice(&dev);
        (void)hipDeviceGetAttribute(&cus, hipDeviceAttributeMultiprocessorCount, dev);
        if (hipFuncSetAttribute((const void*)fwd_megakernel, hipFuncAttributeMaxDynamicSharedMemorySize, LDS_BYTES) != hipSuccess)
            fprintf(stderr, "kernel_launch: hipFuncSetAttribute failed\n");
        if (hipOccupancyMaxActiveBlocksPerMultiprocessor(&per_cu, (const void*)fwd_megakernel, NTHREADS, LDS_BYTES) != hipSuccess || per_cu < 1) {
            fprintf(stderr, "kernel_launch: occupancy query gave %d\n", per_cu);
            per_cu = 1;
        }
        (void)hipGetLastError();
        grid_blocks = cus * 1;
        if (n_in != 27 || ws_size < WS_END) fprintf(stderr, "kernel_launch: unexpected n_in %d / ws %zu\n", n_in, ws_size);
    }
    Args a{};
    for (int i = 0; i < 27; ++i) a.in[i] = d_in[i];
    a.out = (float*)d_out;
    a.ws = (unsigned char*)d_ws;
    void* kargs[] = {&a};
    hipError_t e = hipLaunchCooperativeKernel((const void*)fwd_megakernel, dim3(grid_blocks), dim3(NTHREADS), kargs, LDS_BYTES, stream);
    if (e != hipSuccess) fprintf(stderr, "cooperative launch failed: %s (grid %d)\n", hipGetErrorString(e), grid_blocks);
}
```

```cpp
#include <hip/hip_runtime.h>
#include <hip/hip_cooperative_groups.h>
#include <cstdint>
#include <cstdio>
namespace cg = cooperative_groups;
namespace pg8 {
#define PG8_LAS __attribute__((address_space(3)))
typedef unsigned short bf16_t;
typedef short bf16x8 __attribute__((ext_vector_type(8)));
typedef float f32x4 __attribute__((ext_vector_type(4)));
typedef unsigned u32x4 __attribute__((ext_vector_type(4)));
constexpr int BM = 256, BK = 64, HALF = 128, HTB = HALF * BK * 2  , STAGE_BYTES = 8 * HTB, NXCD = 8, WGM = 8;

__host__ __device__ __forceinline__ int lds_byte(int r, int c) { const int st = (r >> 4) * 2 + (c >> 5), rr = r & 15, cc = c & 31, ob = rr * 64 + cc * 2; return st * 1024 + (ob ^ (((ob >> 9) & 1) << 5)); }
__host__ __device__ __forceinline__ void stage_rc(int b, int& R, int& C) { const int st = b / 1024, sb = b % 1024, swz = sb ^ (((sb >> 9) & 1) << 5); R = (st >> 1) * 16 + swz / 64; C = (st & 1) * 32 + (swz % 64) / 2; }
__host__ __device__ __forceinline__ int perm32(int rho) { const int n = rho >> 4, i = rho & 15; return 8 * (i >> 2) + 4 * n + (i & 3); }

struct Unit { int pm, pn; };
struct Gemm { const bf16_t* A; const bf16_t* Bt; int M, N, K; };

struct StaticOrder {
    int nM, nN, nwg, G, c;
    __host__ __device__ void init(int M, int N, int G_, int c_) { nM = M / BM; nN = N / BM; nwg = nM * nN; G = G_; c = c_; }
    __host__ __device__ bool next(int i, Unit& u) const {
        const long L = (long)i * G + c; if (L >= nwg) return false;
        int wgid = (int)L; { const int q = nwg / NXCD, r = nwg % NXCD, xcd = wgid % NXCD, off = wgid / NXCD; wgid = (xcd < r ? xcd * (q + 1) : r * (q + 1) + (xcd - r) * q) + off; }
        const int nig = WGM * nN, gid = wgid / nig, fm = gid * WGM, gsz = (nM - fm) < WGM ? (nM - fm) : WGM;
        u.pm = fm + ((wgid % nig) % gsz); u.pn = (wgid % nig) / gsz; return true;
    }
    __device__ __forceinline__ void a_ready(const Unit&) const {}
    __device__ __forceinline__ void done(const Unit&) const {}
};

__device__ __forceinline__ unsigned cvt_pk_bf16(float lo, float hi) { unsigned r; asm volatile("v_cvt_pk_bf16_f32 %0, %1, %2" : "=v"(r) : "v"(lo), "v"(hi)); return r; }
typedef float f32x2 __attribute__((ext_vector_type(2)));
__device__ __forceinline__ f32x2 gelu_pk(f32x2 v) {
    const f32x2 av = __builtin_elementwise_abs(v), d = av * 0.2316418882f + 1.0f;
    f32x2 t; t.x = __builtin_amdgcn_rcpf(d.x); t.y = __builtin_amdgcn_rcpf(d.y);
    f32x2 q = t * 0.5307027145f + (-0.7265760135f); q = q * t + 0.7107068705f; q = q * t + (-0.142248368f); q = q * t + 0.127414796f; q = q * t;
    const f32x2 s = (v * v) * (-0.72134752044f);
    f32x2 e; e.x = __builtin_amdgcn_exp2f(s.x); e.y = __builtin_amdgcn_exp2f(s.y);
    const f32x2 m = v * (q * e), r = v - m;
    f32x2 o; o.x = v.x < 0.f ? m.x : r.x; o.y = v.y < 0.f ? m.y : r.y; return o;
}

template <int ACT  > struct EpiBf16 {
    static constexpr bool PERM = true, AFTER_DRAIN = false; static_assert(ACT == 0 || ACT == 1, "EpiBf16: ACT is 0 (none) or 1 (gelu_pk)");
    bf16_t* O; int ldc; const float* bias; int split_cols; size_t split_stride; float scale0;
    __device__ __forceinline__ void operator()(const f32x4 (&acc)[2][2][4][2], const Unit& u, int wr, int wc, int fr, int fq) const {
        const int row0 = u.pm * BM + wr * 64 + fr; int colt = u.pn * BM; bf16_t* base = O;
        float sc = 1.f; if (split_cols) { const int t = colt / split_cols; base += (size_t)t * split_stride; colt -= t * split_cols; if (t == 0) sc = scale0; }
        const int col0 = colt + wc * 32 + 8 * fq, bcol0 = u.pn * BM + wc * 32 + 8 * fq;
        f32x4 bv[2][2];
#pragma unroll
        for (int bj = 0; bj < 2; ++bj)
#pragma unroll
            for (int n = 0; n < 2; ++n) bv[bj][n] = bias ? *(const f32x4*)(bias + bcol0 + bj * HALF + 4 * n) : (f32x4){0.f, 0.f, 0.f, 0.f};
#pragma unroll
        for (int ai = 0; ai < 2; ++ai)
#pragma unroll
            for (int m = 0; m < 4; ++m) { bf16_t* rowp = base + (size_t)(row0 + ai * HALF + m * 16) * ldc + col0;
#pragma unroll
                for (int bj = 0; bj < 2; ++bj) { f32x4 v0 = acc[ai][bj][m][0] + bv[bj][0], v1 = acc[ai][bj][m][1] + bv[bj][1];
                    if (ACT == 1) { f32x2 a = gelu_pk((f32x2){v0[0], v0[1]}), b = gelu_pk((f32x2){v0[2], v0[3]}), c = gelu_pk((f32x2){v1[0], v1[1]}), d = gelu_pk((f32x2){v1[2], v1[3]});
                        v0 = (f32x4){a.x, a.y, b.x, b.y}; v1 = (f32x4){c.x, c.y, d.x, d.y}; }
                    v0 = v0 * sc; v1 = v1 * sc; u32x4 w; w.x = cvt_pk_bf16(v0[0], v0[1]); w.y = cvt_pk_bf16(v0[2], v0[3]); w.z = cvt_pk_bf16(v1[0], v1[1]); w.w = cvt_pk_bf16(v1[2], v1[3]);
                    *(u32x4*)(rowp + bj * HALF) = w; } }
    }
};

struct PanelStats {
    unsigned* xbuf;
    unsigned* cnt;
    unsigned* tmo;
    int ntn; float eps;
    unsigned code;
    __device__ __forceinline__ bool run(const f32x4 (&v)[2][2][4][2], const Unit& u, int wr, int wc, int fr, int fq, PG8_LAS unsigned char* lds, int wid, int lane) const {
        typedef float f32x2v __attribute__((ext_vector_type(2)));
        PG8_LAS f32x2v* P = (PG8_LAS f32x2v*)lds;
        PG8_LAS f32x2v* S = (PG8_LAS f32x2v*)(lds + 8192);
        PG8_LAS unsigned* flag = (PG8_LAS unsigned*)(lds + 8192 + 2048);
#pragma unroll
        for (int ai = 0; ai < 2; ++ai)
#pragma unroll
            for (int m = 0; m < 4; ++m) {
                float s = 0.f;
#pragma unroll
                for (int bj = 0; bj < 2; ++bj)
#pragma unroll
                    for (int n = 0; n < 2; ++n) { const f32x4 x = v[ai][bj][m][n]; s += (x[0] + x[1]) + (x[2] + x[3]); }
                s += __shfl_xor(s, 16); s += __shfl_xor(s, 32);
                const float mw = s * (1.0f / 64.0f); float q = 0.f;
#pragma unroll
                for (int bj = 0; bj < 2; ++bj)
#pragma unroll
                    for (int n = 0; n < 2; ++n) { const f32x4 d = v[ai][bj][m][n] - mw; q += (d[0] * d[0] + d[1] * d[1]) + (d[2] * d[2] + d[3] * d[3]); }
                q += __shfl_xor(q, 16); q += __shfl_xor(q, 32);
                if (fq == 0) P[(ai * HALF + wr * 64 + m * 16 + fr) * 4 + wc] = (f32x2v){mw, q};
            }
        asm volatile("s_waitcnt lgkmcnt(0)" ::: "memory"); __builtin_amdgcn_s_barrier(); asm volatile("" ::: "memory");
#if defined(BROKEN_EXCHANGE_NO_WAIT)
#warning BROKEN CONTROL BUILD: the row-statistics exchange does not wait; results are wrong by design
        if (blockIdx.x >= 64) { const long long t0_ = clock64(); while (clock64() - t0_ < 60000) __builtin_amdgcn_s_sleep(8); }
#endif
        const int row = wid * 32 + (lane & 31);
        if (lane < 32) {
            const f32x2v a = P[row * 4 + 0], b = P[row * 4 + 1], c = P[row * 4 + 2], d = P[row * 4 + 3];
            const float mt = (a.x + b.x + c.x + d.x) * 0.25f;
            const float da = a.x - mt, db = b.x - mt, dc = c.x - mt, dd = d.x - mt;
            const float m2 = (a.y + b.y) + (c.y + d.y) + 64.0f * ((da * da + db * db) + (dc * dc + dd * dd));
            unsigned long long* slot = (unsigned long long*)xbuf + ((size_t)(u.pm * BM + row) * 4 + u.pn);
            __hip_atomic_store(slot, ((unsigned long long)__float_as_uint(m2) << 32) | __float_as_uint(mt), __ATOMIC_RELAXED, __HIP_MEMORY_SCOPE_AGENT);
        }
        asm volatile("s_waitcnt vmcnt(0)" ::: "memory");
        if (lane == 0) __hip_atomic_fetch_add(cnt + 64 * u.pm, 1u, __ATOMIC_RELAXED, __HIP_MEMORY_SCOPE_AGENT);
        if (wid == 0) {
            bool dead = false; const unsigned long long t0 = __builtin_amdgcn_s_memrealtime(); const unsigned want = 8u * (unsigned)ntn;
            for (;;) {
#if defined(BROKEN_EXCHANGE_NO_WAIT)
                break;
#endif
                if ((unsigned)__builtin_amdgcn_readfirstlane(__hip_atomic_load(cnt + 64 * u.pm, __ATOMIC_RELAXED, __HIP_MEMORY_SCOPE_AGENT)) >= want) break;
                if (__builtin_amdgcn_s_memrealtime() - t0 > 2000000ull) {
                    if (lane == 0) { unsigned expect = 0u; __hip_atomic_compare_exchange_strong(tmo + 1, &expect, code | (unsigned)(u.pm & 0xff), __ATOMIC_RELAXED, __ATOMIC_RELAXED, __HIP_MEMORY_SCOPE_AGENT);
                                     __hip_atomic_store(tmo, 1u, __ATOMIC_RELAXED, __HIP_MEMORY_SCOPE_AGENT); }
                    dead = true; break; }
                __builtin_amdgcn_s_sleep(2);
            }
            __builtin_amdgcn_fence(__ATOMIC_ACQUIRE, "agent");
            if (lane == 0) flag[0] = dead ? 1u : 0u;
        }
        asm volatile("s_waitcnt vmcnt(0) lgkmcnt(0)" ::: "memory"); __builtin_amdgcn_s_barrier(); asm volatile("" ::: "memory");
        const bool bad = flag[0] != 0u;
        if (lane < 32) {
            const unsigned long long* slot = (const unsigned long long*)xbuf + (size_t)(u.pm * BM + row) * 4; float mt[4], m2[4]; float ms = 0.f;
#pragma unroll
            for (int t = 0; t < 4; ++t) { if (t < ntn) { const unsigned long long w = __hip_atomic_load(slot + t, __ATOMIC_RELAXED, __HIP_MEMORY_SCOPE_AGENT); mt[t] = __uint_as_float((unsigned)w); m2[t] = __uint_as_float((unsigned)(w >> 32)); } else { mt[t] = 0.f; m2[t] = 0.f; } ms += mt[t]; }
            const float mean = ms / (float)ntn; float q = 0.f;
#pragma unroll
            for (int t = 0; t < 4; ++t) if (t < ntn) { const float dm = mt[t] - mean; q += m2[t] + 256.0f * dm * dm; }
            S[row] = (f32x2v){mean, 1.0f / sqrtf(q / (256.0f * (float)ntn) + eps)};
        }
        asm volatile("s_waitcnt lgkmcnt(0)" ::: "memory"); __builtin_amdgcn_s_barrier(); asm volatile("" ::: "memory");
        return bad;
    }
};
struct EpiLnRes {
    static constexpr bool PERM = false, AFTER_DRAIN = true;
    const float* base; float* out; int ldc; const float* bias; PanelStats st; unsigned poison;
    __device__ __forceinline__ void fused(f32x4 (&acc)[2][2][4][2], const Unit& u, int wr, int wc, int fr, int fq, PG8_LAS unsigned char* lds, int wid, int lane) const {
        typedef float f32x2v __attribute__((ext_vector_type(2)));
        const PG8_LAS f32x2v* S = (const PG8_LAS f32x2v*)(lds + 8192);
        const int col0 = u.pn * BM + wc * 32 + 4 * fq;
#pragma unroll
        for (int bj = 0; bj < 2; ++bj)
#pragma unroll
            for (int n = 0; n < 2; ++n) { const f32x4 bv = bias ? *(const f32x4*)(bias + col0 + bj * HALF + n * 16) : (f32x4){0.f, 0.f, 0.f, 0.f};
#pragma unroll
                for (int ai = 0; ai < 2; ++ai)
#pragma unroll
                    for (int m = 0; m < 4; ++m) acc[ai][bj][m][n] += bv; }
        f32x4 pre[4][2][2];
#pragma unroll
        for (int m = 0; m < 4; ++m) { const size_t off = (size_t)(u.pm * BM + wr * 64 + m * 16 + fr) * ldc + col0;
#pragma unroll
            for (int bj = 0; bj < 2; ++bj)
#pragma unroll
                for (int n = 0; n < 2; ++n) pre[m][bj][n] = *(const f32x4*)(base + off + bj * HALF + n * 16); }
        const bool bad = st.run(acc, u, wr, wc, fr, fq, lds, wid, lane) || poison != 0u;
        const float qnan = __builtin_nanf("");
#pragma unroll
        for (int ai = 0; ai < 2; ++ai)
#pragma unroll
            for (int m = 0; m < 4; ++m) { const int r = ai * HALF + wr * 64 + m * 16 + fr; const f32x2v sr = S[r]; const size_t off = (size_t)(u.pm * BM + r) * ldc + col0;
#pragma unroll
                for (int bj = 0; bj < 2; ++bj)
#pragma unroll
                    for (int n = 0; n < 2; ++n) { const f32x4 bs = ai == 0 ? pre[m][bj][n] : *(const f32x4*)(base + off + bj * HALF + n * 16); f32x4 o = bs + (acc[ai][bj][m][n] - sr.x) * sr.y;
                        if (bad) o = (f32x4){qnan, qnan, qnan, qnan}; *(f32x4*)(out + off + bj * HALF + n * 16) = o; }
                if (m & 1) asm volatile("" ::: "memory"); }
    }
};
struct EpiLnResLn {
    static constexpr bool PERM = false, AFTER_DRAIN = true;
    const float* base; float* out; bf16_t* xn; int ldc; const float* bias; PanelStats st1, st2; unsigned poison;
    __device__ __forceinline__ void fused(f32x4 (&acc)[2][2][4][2], const Unit& u, int wr, int wc, int fr, int fq, PG8_LAS unsigned char* lds, int wid, int lane) const {
        typedef float f32x2v __attribute__((ext_vector_type(2))); typedef unsigned u32x2v __attribute__((ext_vector_type(2)));
        const PG8_LAS f32x2v* S = (const PG8_LAS f32x2v*)(lds + 8192);
        const int col0 = u.pn * BM + wc * 32 + 4 * fq;
#pragma unroll
        for (int bj = 0; bj < 2; ++bj)
#pragma unroll
            for (int n = 0; n < 2; ++n) { const f32x4 bv = bias ? *(const f32x4*)(bias + col0 + bj * HALF + n * 16) : (f32x4){0.f, 0.f, 0.f, 0.f};
#pragma unroll
                for (int ai = 0; ai < 2; ++ai)
#pragma unroll
                    for (int m = 0; m < 4; ++m) acc[ai][bj][m][n] += bv; }
        bool bad = st1.run(acc, u, wr, wc, fr, fq, lds, wid, lane) || poison != 0u;
        const float qnan = __builtin_nanf("");
#pragma unroll
        for (int ai = 0; ai < 2; ++ai)
#pragma unroll
            for (int m = 0; m < 4; ++m) { const int r = ai * HALF + wr * 64 + m * 16 + fr; const f32x2v sr = S[r]; const size_t off = (size_t)(u.pm * BM + r) * ldc + col0;
#pragma unroll
                for (int bj = 0; bj < 2; ++bj)
#pragma unroll
                    for (int n = 0; n < 2; ++n) { const f32x4 bs = *(const f32x4*)(base + off + bj * HALF + n * 16); acc[ai][bj][m][n] = bs + (acc[ai][bj][m][n] - sr.x) * sr.y; }
                asm volatile("" : "+v"(acc[ai][0][m][0]), "+v"(acc[ai][0][m][1]), "+v"(acc[ai][1][m][0]), "+v"(acc[ai][1][m][1]));
                if (m & 1) asm volatile("" ::: "memory"); }
        const bool bad1 = bad;
        bad = st2.run(acc, u, wr, wc, fr, fq, lds, wid, lane) || bad;
#pragma unroll
        for (int ai = 0; ai < 2; ++ai)
#pragma unroll
            for (int m = 0; m < 4; ++m) { const int r = ai * HALF + wr * 64 + m * 16 + fr; const f32x2v sr = S[r]; const size_t off = (size_t)(u.pm * BM + r) * ldc + col0;
#pragma unroll
                for (int bj = 0; bj < 2; ++bj)
#pragma unroll
                    for (int n = 0; n < 2; ++n) { const f32x4 x1 = acc[ai][bj][m][n]; *(f32x4*)(out + off + bj * HALF + n * 16) = bad1 ? (f32x4){qnan, qnan, qnan, qnan} : x1;
                        const f32x4 o = (x1 - sr.x) * sr.y; u32x2v w; w.x = cvt_pk_bf16(o[0], o[1]); w.y = cvt_pk_bf16(o[2], o[3]);
                        if (bad) { w.x = 0x7fc07fc0u; w.y = 0x7fc07fc0u; } *(u32x2v*)(xn + off + bj * HALF + n * 16) = w; }
                asm volatile("" ::: "memory"); }
    }
};

template <class Epi, class Sched, bool ALIGN_EPI = false, bool SP2 = false>
__device__ __forceinline__ void gemm_phase(PG8_LAS unsigned char* lds, const Gemm g, const Sched& S, const Epi& E) {
    int tid_ = threadIdx.x; asm volatile("" : "+v"(tid_));
    const int tid = tid_, wid = __builtin_amdgcn_readfirstlane(tid >> 6), lane = tid & 63, wr = wid >> 2, wc = wid & 3, fr = lane & 15, fq = lane >> 4;
    const int K = g.K, nt = K / BK;
    unsigned voffA[2], voffB[2];
#pragma unroll
    for (int i = 0; i < 2; ++i) { int R, C; stage_rc(tid * 16 + i * 8192, R, C); const int Rb = Epi::PERM ? ((R & ~31) + perm32(R & 31)) : R;
        voffA[i] = (unsigned)(R * K + C) * 2u; voffB[i] = (unsigned)(Rb * K + C) * 2u; }
    const size_t kstep = (size_t)(BK * 2);
    const size_t hstep = (size_t)HALF * K * 2;
    const size_t tstep = 2 * hstep;
    const unsigned ldsw = (unsigned)wid * 1024u;
    const int aoff = lds_byte(wr * 64 + fr, fq * 8), boff = lds_byte(wc * 32 + fr, fq * 8);
#define PG8_SA(b, h) (((b) * 2 + (h)) * HTB)
#define PG8_SB(b, h) ((4 + (b) * 2 + (h)) * HTB)
#define PG8_STAGE(bufoff, gbase, voff) do { _Pragma("unroll") for (int _i = 0; _i < 2; ++_i) \
        __builtin_amdgcn_global_load_lds((const unsigned*)((const char*)(gbase) + (voff)[_i]), (PG8_LAS unsigned*)(lds + (bufoff) + ldsw + _i * 8192), 16, 0, 0); } while (0)
#define PG8_LDA(dst, b, h) do { _Pragma("unroll") for (int m = 0; m < 4; ++m) _Pragma("unroll") for (int k = 0; k < 2; ++k) dst[m][k] = *(const PG8_LAS bf16x8*)(lds + PG8_SA(b, h) + aoff + m * 2048 + k * 1024); } while (0)
#define PG8_LDB(dst, b, h) do { _Pragma("unroll") for (int n = 0; n < 2; ++n) _Pragma("unroll") for (int k = 0; k < 2; ++k) dst[n][k] = *(const PG8_LAS bf16x8*)(lds + PG8_SB(b, h) + boff + n * 2048 + k * 1024); } while (0)
#define PG8_MMA(ai, bj, At, Bt) do { __builtin_amdgcn_s_setprio(1); _Pragma("unroll") for (int m = 0; m < 4; ++m) _Pragma("unroll") for (int n = 0; n < 2; ++n) _Pragma("unroll") for (int k = 0; k < 2; ++k) \
        acc[ai][bj][m][n] = __builtin_amdgcn_mfma_f32_16x16x32_bf16(Bt[n][k], At[m][k], acc[ai][bj][m][n], 0, 0, 0); __builtin_amdgcn_s_setprio(0); } while (0)
#define PG8_WAIT_V(n) asm volatile("s_waitcnt vmcnt(" #n ")" ::: "memory")
#define PG8_WAIT_L(n) asm volatile("s_waitcnt lgkmcnt(" #n ")" ::: "memory")
#define PG8_BAR __builtin_amdgcn_s_barrier()
#define PG8_SCHED __builtin_amdgcn_sched_barrier(0)
    Unit cur, nxt; int ui = 0;
    if (!S.next(0, cur)) return;
    f32x4 acc[2][2][4][2];
#pragma unroll
    for (int a = 0; a < 2; ++a)
#pragma unroll
        for (int b = 0; b < 2; ++b)
#pragma unroll
            for (int m = 0; m < 4; ++m)
#pragma unroll
                for (int n = 0; n < 2; ++n) acc[a][b][m][n] = (f32x4){0.f, 0.f, 0.f, 0.f};
    bf16x8 At[4][2], B0[2][2], B1[2][2];
    const char* cA = (const char*)g.A + (size_t)cur.pm * tstep; const char* cB = (const char*)g.Bt + (size_t)cur.pn * tstep;
    S.a_ready(cur);
    if constexpr (SP2) {
        PG8_STAGE(PG8_SB(0, 0), cB, voffB); PG8_STAGE(PG8_SB(0, 1), cB + hstep, voffB); PG8_STAGE(PG8_SA(0, 0), cA, voffA); PG8_STAGE(PG8_SA(0, 1), cA + hstep, voffA);
        if (wr == 1) PG8_BAR;
        PG8_WAIT_V(2); PG8_BAR;
        PG8_STAGE(PG8_SB(1, 0), cB + kstep, voffB); PG8_STAGE(PG8_SA(1, 0), cA + kstep, voffA); PG8_STAGE(PG8_SB(1, 1), cB + hstep + kstep, voffB);
        PG8_WAIT_V(6); PG8_BAR;
    } else {
        PG8_STAGE(PG8_SB(0, 0), cB, voffB); PG8_STAGE(PG8_SA(0, 0), cA, voffA); PG8_STAGE(PG8_SB(0, 1), cB + hstep, voffB); PG8_STAGE(PG8_SA(0, 1), cA + hstep, voffA);
        if (wr == 1) PG8_BAR;
        PG8_WAIT_V(4); PG8_BAR;
        PG8_STAGE(PG8_SB(1, 0), cB + kstep, voffB); PG8_STAGE(PG8_SA(1, 0), cA + kstep, voffA); PG8_STAGE(PG8_SB(1, 1), cB + hstep + kstep, voffB);
        PG8_WAIT_V(6); PG8_BAR;
    }
    for (;;) {
        const bool has_next = S.next(ui + 1, nxt);
        const char* nA = has_next ? (const char*)g.A + (size_t)nxt.pm * tstep : cA; const char* nB = has_next ? (const char*)g.Bt + (size_t)nxt.pn * tstep : cB;
        for (int t = 0; t < nt; t += 2) {
            const bool last = (t == nt - 2);
            const char* a1 = cA + (size_t)(t + 1) * kstep;
            const char* a2 = last ? nA : cA + (size_t)(t + 2) * kstep; const char* b2 = last ? nB : cB + (size_t)(t + 2) * kstep;
            const char* a3 = a2 + kstep; const char* b3 = b2 + kstep;
            if (last && has_next) S.a_ready(nxt);
            if constexpr (SP2) {
            PG8_LDB(B0, 0, 0); PG8_LDB(B1, 0, 1); PG8_SCHED; PG8_LDA(At, 0, 0); PG8_STAGE(PG8_SA(1, 1), a1 + hstep, voffA);
            PG8_WAIT_V(8); PG8_WAIT_L(0); PG8_BAR; PG8_MMA(0, 0, At, B0); PG8_MMA(0, 1, At, B1); PG8_BAR; PG8_SCHED;
            PG8_LDA(At, 0, 1); PG8_STAGE(PG8_SB(0, 0), b2, voffB); PG8_STAGE(PG8_SB(0, 1), b2 + hstep, voffB); PG8_STAGE(PG8_SA(0, 0), a2, voffA);
            PG8_WAIT_V(8); PG8_WAIT_L(0); PG8_BAR; PG8_MMA(1, 0, At, B0); PG8_MMA(1, 1, At, B1); PG8_BAR; PG8_SCHED;
            PG8_LDB(B0, 1, 0); PG8_LDB(B1, 1, 1); PG8_SCHED; PG8_LDA(At, 1, 0); PG8_STAGE(PG8_SA(0, 1), a2 + hstep, voffA);
            PG8_WAIT_V(8); PG8_WAIT_L(0); PG8_BAR; PG8_MMA(0, 0, At, B0); PG8_MMA(0, 1, At, B1); PG8_BAR; PG8_SCHED;
            PG8_LDA(At, 1, 1); PG8_STAGE(PG8_SB(1, 0), b3, voffB); PG8_STAGE(PG8_SB(1, 1), b3 + hstep, voffB); PG8_STAGE(PG8_SA(1, 0), a3, voffA);
            PG8_WAIT_V(8); PG8_WAIT_L(0); PG8_BAR; PG8_MMA(1, 0, At, B0); PG8_MMA(1, 1, At, B1); PG8_BAR; PG8_SCHED;
            } else {
            PG8_LDB(B0, 0, 0); PG8_SCHED; PG8_LDA(At, 0, 0); PG8_STAGE(PG8_SA(1, 1), a1 + hstep, voffA);
            PG8_WAIT_L(8); PG8_BAR; PG8_WAIT_L(0); PG8_MMA(0, 0, At, B0); PG8_BAR; PG8_SCHED;
            PG8_LDB(B1, 0, 1); PG8_STAGE(PG8_SB(0, 0), b2, voffB);
            PG8_BAR; PG8_WAIT_L(0); PG8_MMA(0, 1, At, B1); PG8_BAR;
            PG8_LDA(At, 0, 1); PG8_STAGE(PG8_SA(0, 0), a2, voffA);
            PG8_BAR; PG8_WAIT_L(0); PG8_MMA(1, 0, At, B0); PG8_BAR; PG8_SCHED;
            PG8_STAGE(PG8_SB(0, 1), b2 + hstep, voffB);
            PG8_WAIT_V(6); PG8_BAR; PG8_MMA(1, 1, At, B1); PG8_BAR;
            PG8_LDB(B0, 1, 0); PG8_SCHED; PG8_LDA(At, 1, 0); PG8_STAGE(PG8_SA(0, 1), a2 + hstep, voffA);
            PG8_WAIT_L(8); PG8_BAR; PG8_WAIT_L(0); PG8_MMA(0, 0, At, B0); PG8_BAR; PG8_SCHED;
            PG8_LDB(B1, 1, 1); PG8_STAGE(PG8_SB(1, 0), b3, voffB);
            PG8_BAR; PG8_WAIT_L(0); PG8_MMA(0, 1, At, B1); PG8_BAR;
            PG8_LDA(At, 1, 1); PG8_STAGE(PG8_SA(1, 0), a3, voffA);
            PG8_BAR; PG8_WAIT_L(0); PG8_MMA(1, 0, At, B0); PG8_BAR; PG8_SCHED;
            PG8_STAGE(PG8_SB(1, 1), b3 + hstep, voffB);
            PG8_WAIT_V(6); PG8_BAR; PG8_MMA(1, 1, At, B1); PG8_BAR;
            }
        }
        if constexpr (ALIGN_EPI) { if (wr == 0) PG8_BAR; }
        if constexpr (!Epi::AFTER_DRAIN) { E(acc, cur, wr, wc, fr, fq); S.done(cur); }
        if (!has_next) break;
#pragma unroll
        for (int a = 0; a < 2; ++a)
#pragma unroll
            for (int b = 0; b < 2; ++b)
#pragma unroll
                for (int m = 0; m < 4; ++m)
#pragma unroll
                    for (int n = 0; n < 2; ++n) acc[a][b][m][n] = (f32x4){0.f, 0.f, 0.f, 0.f};
        cur = nxt; cA = nA; cB = nB; ++ui;
        if constexpr (ALIGN_EPI) { if (wr == 1) PG8_BAR; }
    }
    PG8_WAIT_V(0);
    if constexpr (!ALIGN_EPI) { if (wr == 0) PG8_BAR; }
    PG8_BAR;
    if constexpr (Epi::AFTER_DRAIN) { E.fused(acc, cur, wr, wc, fr, fq, lds, wid, lane); S.done(cur); }
#undef PG8_SA
#undef PG8_SB
#undef PG8_STAGE
#undef PG8_LDA
#undef PG8_LDB
#undef PG8_MMA
#undef PG8_WAIT_V
#undef PG8_WAIT_L
#undef PG8_BAR
#undef PG8_SCHED
}
}

#ifndef PG8_SP2
#define PG8_SP2 true
#endif
#ifndef PG8_ALIGN
#define PG8_ALIGN true
#endif

namespace {
constexpr int D_MODEL = 1024, BATCH = 2, SEQ = 8192, NTOK = BATCH * SEQ;
constexpr int AB_IN = 2560, C_IN = 1536;
constexpr int N_EXP = 16, D_FF = 512, PLE_DIM = 256;
constexpr float ALPHA = 1.4142135623730951f;
constexpr float LN_EPS = 1e-5f;
constexpr int NTHREADS = 512, NWAVES = 8;
constexpr int LDS_BYTES = 147456;
#define LAS __attribute__((address_space(3)))
#define GAS __attribute__((address_space(1)))
typedef unsigned short bf16_t;
typedef unsigned v4u __attribute__((ext_vector_type(4)));
typedef unsigned v2u __attribute__((ext_vector_type(2)));
typedef float f32x4 __attribute__((ext_vector_type(4)));

constexpr size_t MiB = 1u << 20;
constexpr size_t WS_CTL = 0;
constexpr size_t WS_W_IN = 1 * MiB, WS_W_OUTAB = 6 * MiB, WS_W_QKV = 8 * MiB, WS_W_OUTC = 11 * MiB, WS_W_PLEG = 13 * MiB, WS_W_PLEP = 17 * MiB;
constexpr size_t WS_W_GU = 18 * MiB, WS_W_DN = 50 * MiB;
constexpr size_t WS_PROJ = 66 * MiB;
constexpr size_t WS_MIX = 146 * MiB;
constexpr size_t WS_XNA = 182 * MiB, WS_XNB = 214 * MiB;
constexpr size_t WS_PP = 246 * MiB;
constexpr size_t WS_PB = 278 * MiB;
constexpr size_t WS_EIDX = 294 * MiB, WS_GATEW = 295 * MiB, WS_LIST = 296 * MiB, WS_POS = 297 * MiB;
constexpr size_t WS_LRUSUM = 298 * MiB, WS_LRUW = 299 * MiB;
constexpr size_t WS_ROPE = 300 * MiB;
constexpr size_t WS_END = 304 * MiB;
constexpr size_t WS_XS = WS_PROJ;
constexpr size_t WS_H = WS_MIX;
constexpr int MISC_OFF = 131072;
constexpr int CW_CNT = 64;

__device__ __forceinline__ float softplusf(float z) { return fmaxf(z, 0.f) + log1pf(expf(-fabsf(z))); }
__device__ __forceinline__ float sigmoidf_(float z) { return 1.f / (1.f + expf(-z)); }
__device__ __forceinline__ float wave_sum(float v) {
#pragma unroll
    for (int o = 1; o < 64; o <<= 1) v += __shfl_xor(v, o);
    return v;
}
__device__ __forceinline__ float gelu_tanh(float x) {
    const float c = 0.7978845608028654f;
    return 0.5f * x * (1.f + tanhf(c * (x + 0.044715f * x * x * x)));
}
__device__ __forceinline__ unsigned f2bf(float f) { unsigned u = __builtin_bit_cast(unsigned, f); return (u + 0x7fffu + ((u >> 16) & 1u)) >> 16; }
__device__ __forceinline__ unsigned pk2(float lo, float hi) { return f2bf(lo) | (f2bf(hi) << 16); }
__device__ __forceinline__ float bf2f(bf16_t v) { return __uint_as_float((unsigned)v << 16); }
__device__ __forceinline__ float bflo(unsigned w) { return __uint_as_float(w << 16); }
__device__ __forceinline__ float bfhi(unsigned w) { return __uint_as_float(w & 0xffff0000u); }
template <class T> __device__ __forceinline__ T* lnd(T* p) { asm volatile("" : "+s"(p)); return p; }
__device__ __forceinline__ int tid_opaque() { int t = threadIdx.x; asm volatile("" : "+v"(t)); return t; }
#define XB_TMO      128
#define XB_XCNT(j)  (256  + 64 * (j))
#define XB_XSUB(j)  (1280 + 64 * (j))
#define XB_XGEN(j)  (2304 + 64 * (j))
#define XB_TOP      3328
#define XB_TOPGEN   3392
#define XCD_BAR_WORDS 3456
#define XB_SPIN_CAP (1u << 18)

__device__ __forceinline__ unsigned xb_ld(unsigned* p)              { return __hip_atomic_load(p, __ATOMIC_RELAXED, __HIP_MEMORY_SCOPE_AGENT); }
__device__ __forceinline__ unsigned xb_add(unsigned* p, unsigned v) { return __hip_atomic_fetch_add(p, v, __ATOMIC_RELAXED, __HIP_MEMORY_SCOPE_AGENT); }
__device__ __forceinline__ unsigned xb_xcc_id() { return (unsigned)__builtin_amdgcn_s_getreg((3 << 11) | 20) & 0xFu; }
#define XB_SPIN(cond, bar) do { unsigned _sp = 0; while (cond) { __builtin_amdgcn_s_sleep(1); \
    if ((++_sp & 255u) == 0u) { if (xb_ld(&(bar)[XB_TMO])) break; if (_sp > XB_SPIN_CAP) { atomicAdd(&(bar)[XB_TMO], 1u); break; } } } } while (0)

struct XcdBarrier {
    unsigned* bar; unsigned x;
    volatile LAS unsigned* st;
};

__device__ __forceinline__ XcdBarrier xcd_barrier_post(unsigned* bar, volatile LAS unsigned* st) {
    XcdBarrier b; b.bar = bar; b.x = xb_xcc_id(); b.st = st;
    if (threadIdx.x == 0) (void)xb_add(&bar[XB_XCNT(b.x)], 1u);
    return b;
}
__device__ __forceinline__ void xcd_barrier_complete(unsigned* bar, unsigned x, unsigned& nloc, unsigned& nx) {
    const unsigned G = gridDim.x * gridDim.y * gridDim.z;
    unsigned sum, cnt, mine, sp = 0u;
    for (;;) {
        sum = 0u; cnt = 0u; mine = 0u;
#pragma unroll
        for (unsigned j = 0; j < 16; ++j) { const unsigned c = xb_ld(&bar[XB_XCNT(j)]); sum += c; cnt += (c > 0u) ? 1u : 0u; mine = (j == x) ? c : mine; }
        if (sum == G) break;
        __builtin_amdgcn_s_sleep(1);
        if ((++sp & 255u) == 0u) { if (xb_ld(&bar[XB_TMO])) break; if (sp > XB_SPIN_CAP) { atomicAdd(&bar[XB_TMO], 1u); break; } }
    }
    nloc = mine > 0u ? mine : 1u; nx = cnt > 0u ? cnt : 1u;
}

__device__ __forceinline__ void xcd_barrier(const XcdBarrier& b) {
    asm volatile("s_waitcnt vmcnt(0)" ::: "memory");
    __syncthreads();
    if (threadIdx.x == 0) {
        unsigned* bar = b.bar;
        __builtin_amdgcn_s_waitcnt(0);
        unsigned nloc = b.st[0], nx = b.st[1];
        if (nloc == 0u) { xcd_barrier_complete(bar, b.x, nloc, nx); b.st[0] = nloc; b.st[1] = nx; }
        const unsigned old = xb_add(&bar[XB_XSUB(b.x)], 1u);
        const unsigned gen = old / nloc;
        if (old + 1u == (gen + 1u) * nloc) {
            __builtin_amdgcn_fence(__ATOMIC_RELEASE, "agent");
            asm volatile("s_waitcnt vmcnt(0)" ::: "memory");
            const unsigned og = xb_add(&bar[XB_TOP], 1u);
            const unsigned tg = og / nx;
            if (og + 1u == (tg + 1u) * nx) xb_add(&bar[XB_TOPGEN], 1u);
            else XB_SPIN(xb_ld(&bar[XB_TOPGEN]) == tg, bar);
            __builtin_amdgcn_fence(__ATOMIC_ACQUIRE, "agent");
            xb_add(&bar[XB_XGEN(b.x)], 1u);
            asm volatile("s_waitcnt vmcnt(0)" ::: "memory");
        } else {
            XB_SPIN(xb_ld(&bar[XB_XGEN(b.x)]) == gen, bar);
            __builtin_amdgcn_fence(__ATOMIC_ACQUIRE, "agent");
            asm volatile("s_waitcnt vmcnt(0)" ::: "memory");
        }
    }
    __syncthreads();
}

constexpr int CW_BAR = 4096;
constexpr int CTL_ZERO_BYTES = 32768;
constexpr int BARST_OFF = LDS_BYTES - 64;

struct EpiF32 {
    static constexpr bool PERM = false, AFTER_DRAIN = false;
    float* O; int ldc;
    __device__ __forceinline__ void operator()(const pg8::f32x4 (&acc)[2][2][4][2], const pg8::Unit& u, int wr, int wc, int fr, int fq) const {
        const int row0 = u.pm * 256 + wr * 64 + fr, col0 = u.pn * 256 + wc * 32 + 4 * fq;
#pragma unroll
        for (int ai = 0; ai < 2; ++ai)
#pragma unroll
            for (int m = 0; m < 4; ++m) { float* rowp = O + (size_t)(row0 + ai * 128 + m * 16) * ldc + col0;
#pragma unroll
                for (int bj = 0; bj < 2; ++bj)
#pragma unroll
                    for (int n = 0; n < 2; ++n) *(pg8::f32x4*)(rowp + bj * 128 + n * 16) = acc[ai][bj][m][n]; }
    }
};
struct EpiPle {
    static constexpr bool PERM = false, AFTER_DRAIN = false;
    float* X; const bf16_t* PP; bf16_t* XB; const float* bias;
    __device__ __forceinline__ void operator()(const pg8::f32x4 (&acc)[2][2][4][2], const pg8::Unit& u, int wr, int wc, int fr, int fq) const {
        const int row0 = u.pm * 256 + wr * 64 + fr, col0 = u.pn * 256 + wc * 32 + 4 * fq;
        pg8::f32x4 bv[2][2];
#pragma unroll
        for (int bj = 0; bj < 2; ++bj)
#pragma unroll
            for (int n = 0; n < 2; ++n) bv[bj][n] = *(const pg8::f32x4*)(bias + col0 + bj * 128 + n * 16);
#pragma unroll
        for (int ai = 0; ai < 2; ++ai)
#pragma unroll
            for (int m = 0; m < 4; ++m) { const size_t off = (size_t)(row0 + ai * 128 + m * 16) * D_MODEL + col0;
#pragma unroll
                for (int bj = 0; bj < 2; ++bj)
#pragma unroll
                    for (int n = 0; n < 2; ++n) { const size_t o = off + bj * 128 + n * 16;
                        const pg8::f32x4 x2 = *(const pg8::f32x4*)(X + o); const v2u pw = *(const v2u*)(PP + o);
                        const pg8::f32x4 z = acc[ai][bj][m][n] + bv[bj][n];
                        pg8::f32x4 r;
                        r[0] = x2[0] + bflo(pw.x) * __builtin_amdgcn_rcpf(1.f + __expf(-z[0]));
                        r[1] = x2[1] + bfhi(pw.x) * __builtin_amdgcn_rcpf(1.f + __expf(-z[1]));
                        r[2] = x2[2] + bflo(pw.y) * __builtin_amdgcn_rcpf(1.f + __expf(-z[2]));
                        r[3] = x2[3] + bfhi(pw.y) * __builtin_amdgcn_rcpf(1.f + __expf(-z[3]));
                        *(pg8::f32x4*)(X + o) = r; v2u w; w.x = pk2(r[0], r[1]); w.y = pk2(r[2], r[3]); *(v2u*)(XB + o) = w; } }
    }
};

struct EpiGU {
    static constexpr bool PERM = true, AFTER_DRAIN = false;
    bf16_t* H;
    __device__ __forceinline__ void operator()(const pg8::f32x4 (&acc)[2][2][4][2], const pg8::Unit& u, int wr, int wc, int fr, int fq) const {
        const int row0 = u.pm * 256 + wr * 64 + fr, col0 = (u.pn & 3) * 128 + wc * 32 + 8 * fq;
#pragma unroll
        for (int ai = 0; ai < 2; ++ai)
#pragma unroll
            for (int m = 0; m < 4; ++m) { bf16_t* rowp = H + (size_t)(row0 + ai * 128 + m * 16) * D_FF + col0;
                float hv[8];
#pragma unroll
                for (int n = 0; n < 2; ++n)
#pragma unroll
                    for (int j = 0; j < 4; ++j) { const float g = acc[ai][0][m][n][j], up = acc[ai][1][m][n][j]; hv[n * 4 + j] = g * __builtin_amdgcn_rcpf(1.f + __expf(-g)) * up; }
                v4u w; w.x = pk2(hv[0], hv[1]); w.y = pk2(hv[2], hv[3]); w.z = pk2(hv[4], hv[5]); w.w = pk2(hv[6], hv[7]);
                *(v4u*)rowp = w; }
    }
};
struct EpiBf16N {
    static constexpr bool PERM = true, AFTER_DRAIN = false;
    bf16_t* O; int ldc;
    __device__ __forceinline__ void operator()(const pg8::f32x4 (&acc)[2][2][4][2], const pg8::Unit& u, int wr, int wc, int fr, int fq) const {
        const int row0 = u.pm * 256 + wr * 64 + fr, col0 = (u.pn & 3) * 256 + wc * 32 + 8 * fq;
#pragma unroll
        for (int ai = 0; ai < 2; ++ai)
#pragma unroll
            for (int m = 0; m < 4; ++m) { bf16_t* rowp = O + (size_t)(row0 + ai * 128 + m * 16) * ldc + col0;
#pragma unroll
                for (int bj = 0; bj < 2; ++bj) { const pg8::f32x4 v0 = acc[ai][bj][m][0], v1 = acc[ai][bj][m][1];
                    v4u w; w.x = pk2(v0[0], v0[1]); w.y = pk2(v0[2], v0[3]); w.z = pk2(v1[0], v1[1]); w.w = pk2(v1[2], v1[3]);
                    *(v4u*)(rowp + bj * 128) = w; } }
    }
};
struct MoeOrder {
    const LAS int* tile_off;
    int G, c;
    __device__ __forceinline__ bool next(int i, pg8::Unit& u) const {
        const int T = tile_off[16];
        const int L = i * G + c; if (L >= T * 4) return false;
        const int rt = L >> 2; int e = 0;
#pragma unroll
        for (int k = 1; k < 16; ++k) e += (rt >= tile_off[k]) ? 1 : 0;
        u.pm = rt; u.pn = __builtin_amdgcn_readfirstlane(e * 4 + (L & 3)); return true;
    }
    __device__ __forceinline__ void a_ready(const pg8::Unit&) const {}
    __device__ __forceinline__ void done(const pg8::Unit&) const {}
};

__device__ __forceinline__ void p0_transpose_item(const float* W, int K, int N, bf16_t* WT, int row_off, LAS float* scr, int item, int lane) {
    const int nblk = N / 32, kb = item / nblk, nb = item % nblk, k0 = 64 * kb, n0 = 32 * nb;
#pragma unroll 8
    for (int i = 0; i < 32; ++i) { const int kk = 2 * i + (lane >> 5); scr[kk * 33 + (lane & 31)] = W[(size_t)(k0 + kk) * N + n0 + (lane & 31)]; }
    asm volatile("s_waitcnt lgkmcnt(0)" ::: "memory");
    const int c = lane & 7;
#pragma unroll
    for (int j = 0; j < 4; ++j) { const int n = (lane >> 3) + 8 * j; const LAS float* s = scr + (8 * c) * 33 + n;
        v4u o; o.x = pk2(s[0 * 33], s[1 * 33]); o.y = pk2(s[2 * 33], s[3 * 33]); o.z = pk2(s[4 * 33], s[5 * 33]); o.w = pk2(s[6 * 33], s[7 * 33]);
        *(v4u*)(WT + (size_t)(row_off + n0 + n) * K + k0 + 8 * c) = o; }
    asm volatile("s_waitcnt lgkmcnt(0)" ::: "memory");
}
__device__ __forceinline__ void row1024_to_bf16(const float* xrow, bf16_t* orow, int lane) {
    const f32x4* xr = (const f32x4*)xrow + lane;
    v2u* o8 = (v2u*)orow + lane;
#pragma unroll
    for (int j = 0; j < 4; ++j) { const f32x4 v = xr[64 * j]; v2u w; w.x = pk2(v[0], v[1]); w.y = pk2(v[2], v[3]); o8[64 * j] = w; }
}

template <bool ROUTER>
__device__ __forceinline__ void ph_res_ln(const float* x, const float* h, const float* g, const float* bta, float* out, bf16_t* outb, const float* w_router,
                                          const float* b_router, int* eidx, float* gatew) {
    const int tid0 = tid_opaque(), lane = tid0 & 63, wave = tid0 >> 6;
    for (int row = blockIdx.x * 8 + wave; row < NTOK; row += gridDim.x * 8) {
        asm volatile("" ::: "memory");
        const float4* xr = (const float4*)(x + (size_t)row * D_MODEL);
        const float4* hr = (const float4*)(h + (size_t)row * D_MODEL);
        float4 v[4];
        float s = 0.f;
#pragma unroll
        for (int j = 0; j < 4; ++j) {
            const float4 a = xr[lane + 64 * j], c = hr[lane + 64 * j];
            v[j] = make_float4(ALPHA * a.x + c.x, ALPHA * a.y + c.y, ALPHA * a.z + c.z, ALPHA * a.w + c.w);
            s += (v[j].x + v[j].y) + (v[j].z + v[j].w);
        }
        const float mean = wave_sum(s) * (1.f / D_MODEL);
        float s2 = 0.f;
#pragma unroll
        for (int j = 0; j < 4; ++j) {
            v[j].x -= mean; v[j].y -= mean; v[j].z -= mean; v[j].w -= mean;
            s2 += (v[j].x * v[j].x + v[j].y * v[j].y) + (v[j].z * v[j].z + v[j].w * v[j].w);
        }
        const float rstd = 1.f / sqrtf(wave_sum(s2) * (1.f / D_MODEL) + LN_EPS);
        float4* orow = (float4*)(out + (size_t)row * D_MODEL);
        v2u* brow = (v2u*)(outb + (size_t)row * D_MODEL);
#pragma unroll
        for (int j = 0; j < 4; ++j) {
            const float4 gg = ((const float4*)g)[lane + 64 * j], bb = ((const float4*)bta)[lane + 64 * j];
            v[j] = make_float4(v[j].x * rstd * gg.x + bb.x, v[j].y * rstd * gg.y + bb.y, v[j].z * rstd * gg.z + bb.z, v[j].w * rstd * gg.w + bb.w);
            orow[lane + 64 * j] = v[j];
            v2u w; w.x = pk2(v[j].x, v[j].y); w.y = pk2(v[j].z, v[j].w); brow[lane + 64 * j] = w;
        }
        if (ROUTER) {
            float lg[16];
#pragma unroll
            for (int e = 0; e < 16; ++e) lg[e] = 0.f;
#pragma unroll
            for (int j = 0; j < 4; ++j) {
                const float xv[4] = {v[j].x, v[j].y, v[j].z, v[j].w};
#pragma unroll
                for (int k = 0; k < 4; ++k) {
                    const int d = 4 * (lane + 64 * j) + k;
                    const float4* wr = (const float4*)(w_router + d * 16);
#pragma unroll
                    for (int q4 = 0; q4 < 4; ++q4) {
                        const float4 w = wr[q4];
                        lg[q4 * 4 + 0] += xv[k] * w.x; lg[q4 * 4 + 1] += xv[k] * w.y; lg[q4 * 4 + 2] += xv[k] * w.z; lg[q4 * 4 + 3] += xv[k] * w.w;
                    }
                }
            }
#pragma unroll
            for (int e = 0; e < 16; ++e) lg[e] = wave_sum(lg[e]) + b_router[e];
            if (lane == 0) {
                float mx = lg[0];
#pragma unroll
                for (int e = 1; e < 16; ++e) mx = fmaxf(mx, lg[e]);
                float p[16], sum = 0.f;
#pragma unroll
                for (int e = 0; e < 16; ++e) { p[e] = expf(lg[e] - mx); sum += p[e]; }
                const float inv = 1.f / sum;
#pragma unroll
                for (int e = 0; e < 16; ++e) p[e] *= inv;
                int gsel = 0; float gbest = -1.f;
#pragma unroll
                for (int gq = 0; gq < 4; ++gq) {
                    float m1 = -1.f, m2 = -1.f;
#pragma unroll
                    for (int k = 0; k < 4; ++k) { const float pv = p[gq * 4 + k]; if (pv > m1) { m2 = m1; m1 = pv; } else if (pv > m2) { m2 = pv; } }
                    const float sc = m1 + m2;
                    if (sc > gbest) { gbest = sc; gsel = gq; }
                }
                float m1 = -1.f, m2 = -1.f; int i1 = 0, i2 = 0;
#pragma unroll
                for (int gq = 0; gq < 4; ++gq) {
                    if (gq == gsel) {
#pragma unroll
                        for (int k = 0; k < 4; ++k) { const float pv = p[gq * 4 + k]; if (pv > m1) { m2 = m1; i2 = i1; m1 = pv; i1 = k; } else if (pv > m2) { m2 = pv; i2 = k; } }
                    }
                }
                const float wsum = m1 + m2;
                eidx[row * 2 + 0] = gsel * 4 + i1; eidx[row * 2 + 1] = gsel * 4 + i2;
                gatew[row * 2 + 0] = m1 / wsum; gatew[row * 2 + 1] = m2 / wsum;
            }
        }
    }
}
__device__ __forceinline__ void ph_moe_naive(unsigned char* lds, const float* x, const int* eidx, const float* gatew, const float* wg, const float* wu, const float* wd, float* m) {
    float* xs = (float*)(lds + 65536);
    float* hs = (float*)(lds + 65536 + 4096);
    const int tid = tid_opaque();
    for (int tok = blockIdx.x; tok < NTOK; tok += gridDim.x) {
        __syncthreads();
        xs[tid] = x[(size_t)tok * D_MODEL + tid]; xs[tid + 512] = x[(size_t)tok * D_MODEL + tid + 512];
        float o0 = 0.f, o1 = 0.f;
        for (int kk = 0; kk < 2; ++kk) {
            const int e = eidx[tok * 2 + kk];
            const float gw = gatew[tok * 2 + kk];
            const float* wge = wg + (size_t)e * D_MODEL * D_FF;
            const float* wue = wu + (size_t)e * D_MODEL * D_FF;
            const float* wde = wd + (size_t)e * D_FF * D_MODEL;
            __syncthreads();
            float g0 = 0.f, u0 = 0.f;
#pragma unroll 4
            for (int d = 0; d < 1024; ++d) {
                const float xv = xs[d];
                g0 += xv * wge[(size_t)d * D_FF + tid];
                u0 += xv * wue[(size_t)d * D_FF + tid];
            }
            hs[tid] = g0 * sigmoidf_(g0) * u0 * gw;
            __syncthreads();
#pragma unroll 4
            for (int f = 0; f < 512; ++f) {
                const float hv = hs[f];
                o0 += hv * wde[(size_t)f * D_MODEL + tid];
                o1 += hv * wde[(size_t)f * D_MODEL + tid + 512];
            }
        }
        m[(size_t)tok * D_MODEL + tid] = o0; m[(size_t)tok * D_MODEL + tid + 512] = o1;
    }
}
__device__ __forceinline__ void ph_route(unsigned char* lds, const float* x1, const float* w_router, const float* b_router, float* gatew, unsigned* cnt, int* list) {
    const int tid = tid_opaque(), lane = tid & 63, wave = tid >> 6;
    int* s_e = (int*)(lds + MISC_OFF);
    int* s_rank = s_e + 128;
    int* s_cnt = s_rank + 128;
    int* s_base = s_cnt + 16;
    for (int base = blockIdx.x * 64; base < NTOK; base += gridDim.x * 64) {
        __syncthreads();
        if (tid < 16) s_cnt[tid] = 0;
        __syncthreads();
#pragma unroll 1
        for (int rr = 0; rr < 8; rr += 4) {
            asm volatile("" ::: "memory");
            const int row0 = base + wave * 8 + rr;
            float lg[4][16];
#pragma unroll
            for (int r = 0; r < 4; ++r)
#pragma unroll
                for (int e = 0; e < 16; ++e) lg[r][e] = 0.f;
#pragma unroll 1
            for (int j = 0; j < 4; ++j) {
                asm volatile("" ::: "memory");
                f32x4 xv[4];
#pragma unroll
                for (int r = 0; r < 4; ++r) xv[r] = *((const f32x4*)(x1 + (size_t)(row0 + r) * D_MODEL) + lane + 64 * j);
#pragma unroll
                for (int k = 0; k < 4; ++k) {
                    const int d = 4 * (lane + 64 * j) + k;
                    const f32x4* wr = (const f32x4*)(w_router + d * 16);
#pragma unroll
                    for (int q4 = 0; q4 < 4; ++q4) {
                        const f32x4 w = wr[q4];
#pragma unroll
                        for (int r = 0; r < 4; ++r) { lg[r][q4 * 4 + 0] += xv[r][k] * w[0]; lg[r][q4 * 4 + 1] += xv[r][k] * w[1]; lg[r][q4 * 4 + 2] += xv[r][k] * w[2]; lg[r][q4 * 4 + 3] += xv[r][k] * w[3]; }
                    }
                }
            }
#pragma unroll
            for (int r = 0; r < 4; ++r) {
#pragma unroll
                for (int e = 0; e < 16; ++e) lg[r][e] = wave_sum(lg[r][e]) + b_router[e];
                float mx = lg[r][0];
#pragma unroll
                for (int e = 1; e < 16; ++e) mx = fmaxf(mx, lg[r][e]);
                float p[16], sum = 0.f;
#pragma unroll
                for (int e = 0; e < 16; ++e) { p[e] = expf(lg[r][e] - mx); sum += p[e]; }
                const float inv = 1.f / sum;
#pragma unroll
                for (int e = 0; e < 16; ++e) p[e] *= inv;
                int gsel = 0; float gbest = -1.f;
#pragma unroll
                for (int gq = 0; gq < 4; ++gq) {
                    float m1 = -1.f, m2 = -1.f;
#pragma unroll
                    for (int k = 0; k < 4; ++k) { const float pv = p[gq * 4 + k]; if (pv > m1) { m2 = m1; m1 = pv; } else if (pv > m2) { m2 = pv; } }
                    const float sc = m1 + m2;
                    if (sc > gbest) { gbest = sc; gsel = gq; }
                }
                float m1 = -1.f, m2 = -1.f; int i1 = 0, i2 = 0;
#pragma unroll
                for (int gq = 0; gq < 4; ++gq) {
                    if (gq == gsel) {
#pragma unroll
                        for (int k = 0; k < 4; ++k) { const float pv = p[gq * 4 + k]; if (pv > m1) { m2 = m1; i2 = i1; m1 = pv; i1 = k; } else if (pv > m2) { m2 = pv; i2 = k; } }
                    }
                }
                if (lane == 0) {
                    const int row = row0 + r, tl = row - base, e1 = gsel * 4 + i1, e2 = gsel * 4 + i2;
                    const float wsum = m1 + m2;
                    gatew[row * 2 + 0] = m1 / wsum; gatew[row * 2 + 1] = m2 / wsum;
                    s_e[tl * 2 + 0] = e1; s_e[tl * 2 + 1] = e2;
                    s_rank[tl * 2 + 0] = atomicAdd(&s_cnt[e1], 1);
                    s_rank[tl * 2 + 1] = atomicAdd(&s_cnt[e2], 1);
                }
            }
        }
        __syncthreads();
        if (tid < 16) s_base[tid] = (int)__hip_atomic_fetch_add(cnt + tid, (unsigned)s_cnt[tid], __ATOMIC_RELAXED, __HIP_MEMORY_SCOPE_AGENT);
        __syncthreads();
        if (tid < 128) { const int e = s_e[tid]; list[e * NTOK + s_base[e] + s_rank[tid]] = (base + (tid >> 1)) * 2 + (tid & 1); }
    }
}
__device__ __forceinline__ void moe_offsets(unsigned char* lds, const unsigned* cnt) {
    int* t_off = (int*)(lds + MISC_OFF + 2048);
    __syncthreads();
    if (threadIdx.x == 0) {
        int acc = 0;
        for (int e = 0; e < 16; ++e) { const int c = (int)__hip_atomic_load(cnt + e, __ATOMIC_RELAXED, __HIP_MEMORY_SCOPE_AGENT); t_off[e] = acc; t_off[32 + e] = c; acc += (c + 255) >> 8; }
        t_off[16] = acc;
    }
    __syncthreads();
}
__device__ __forceinline__ void ph_permute(unsigned char* lds, const unsigned* cnt, const int* list, const bf16_t* x1b, bf16_t* xs, int* pos) {
    moe_offsets(lds, cnt);
    const int* t_off = (const int*)(lds + MISC_OFF + 2048);
    const int tid = tid_opaque(), lane = tid & 63, wave = tid >> 6;
    const int R = t_off[16] * 256;
    for (int r = blockIdx.x * NWAVES + wave; r < R; r += gridDim.x * NWAVES) {
        const int rt = r >> 8; int e = 0;
#pragma unroll
        for (int k = 1; k < 16; ++k) e += (rt >= t_off[k]) ? 1 : 0;
        const int i = r - t_off[e] * 256;
        if (i < t_off[32 + e]) {
            const int ent = list[e * NTOK + i], tok = ent >> 1;
            const v4u* src = (const v4u*)(x1b + (size_t)tok * D_MODEL);
            v4u* dst = (v4u*)(xs + (size_t)r * D_MODEL);
            dst[lane] = src[lane]; dst[lane + 64] = src[lane + 64];
            if (lane == 0) pos[ent] = r;
        }
    }
}
__device__ __forceinline__ void ph_combine_ln(const float* x, const bf16_t* Y, const int* pos, const float* gatew, const float* g, const float* bta, float* out, bf16_t* outb) {
    const int tid0 = tid_opaque(), lane = tid0 & 63, wave = tid0 >> 6;
    for (int row = blockIdx.x * 8 + wave; row < NTOK; row += gridDim.x * 8) {
        asm volatile("" ::: "memory");
        const int p0 = pos[row * 2], p1 = pos[row * 2 + 1];
        const float w0 = gatew[row * 2], w1 = gatew[row * 2 + 1];
        const float4* xr = (const float4*)(x + (size_t)row * D_MODEL);
        const v2u* y0 = (const v2u*)(Y + (size_t)p0 * D_MODEL);
        const v2u* y1 = (const v2u*)(Y + (size_t)p1 * D_MODEL);
        float4 v[4];
        float s = 0.f;
#pragma unroll
        for (int j = 0; j < 4; ++j) {
            const float4 a = xr[lane + 64 * j]; const v2u a0 = y0[lane + 64 * j], a1 = y1[lane + 64 * j];
            v[j] = make_float4(ALPHA * a.x + (w0 * bflo(a0.x) + w1 * bflo(a1.x)), ALPHA * a.y + (w0 * bfhi(a0.x) + w1 * bfhi(a1.x)),
                               ALPHA * a.z + (w0 * bflo(a0.y) + w1 * bflo(a1.y)), ALPHA * a.w + (w0 * bfhi(a0.y) + w1 * bfhi(a1.y)));
            s += (v[j].x + v[j].y) + (v[j].z + v[j].w);
        }
        const float mean = wave_sum(s) * (1.f / D_MODEL);
        float s2 = 0.f;
#pragma unroll
        for (int j = 0; j < 4; ++j) {
            v[j].x -= mean; v[j].y -= mean; v[j].z -= mean; v[j].w -= mean;
            s2 += (v[j].x * v[j].x + v[j].y * v[j].y) + (v[j].z * v[j].z + v[j].w * v[j].w);
        }
        const float rstd = 1.f / sqrtf(wave_sum(s2) * (1.f / D_MODEL) + LN_EPS);
        float4* orow = (float4*)(out + (size_t)row * D_MODEL);
        v2u* brow = (v2u*)(outb + (size_t)row * D_MODEL);
#pragma unroll
        for (int j = 0; j < 4; ++j) {
            const float4 gg = ((const float4*)g)[lane + 64 * j], bb = ((const float4*)bta)[lane + 64 * j];
            v[j] = make_float4(v[j].x * rstd * gg.x + bb.x, v[j].y * rstd * gg.y + bb.y, v[j].z * rstd * gg.z + bb.z, v[j].w * rstd * gg.w + bb.w);
            orow[lane + 64 * j] = v[j];
            v2u w; w.x = pk2(v[j].x, v[j].y); w.y = pk2(v[j].z, v[j].w); brow[lane + 64 * j] = w;
        }
    }
}
__device__ __forceinline__ void ph_convert_experts(LAS unsigned char* ldsl, const float* wg, const float* wu, const float* wd, bf16_t* W_GU, bf16_t* W_DN) {
    const int tid = tid_opaque(), lane = tid & 63, wave = __builtin_amdgcn_readfirstlane(tid >> 6);
    LAS float* scr = (LAS float*)(ldsl + wave * 16384);
    const int gw = blockIdx.x * NWAVES + wave, NGW = gridDim.x * NWAVES;
    for (int it = gw; it < 16 * 768; it += NGW) {
        const int e = it / 768, r = it % 768;
        if (r < 512) {
            const int bj = r >> 8, item = r & 255, n0 = 32 * (item % 16);
            const float* W = (bj ? wu : wg) + (size_t)e * D_MODEL * D_FF;
            p0_transpose_item(W, 1024, 512, W_GU + (size_t)e * 1024 * 1024, 256 * (n0 >> 7) + 128 * bj + (n0 & 127) - n0, scr, item, lane);
        } else {
            p0_transpose_item(wd + (size_t)e * D_FF * D_MODEL, 512, 1024, W_DN + (size_t)e * 1024 * 512, 0, scr, r - 512, lane);
        }
    }
}


typedef short bf16x8 __attribute__((ext_vector_type(8)));
#define MFMA16(a, b, c) __builtin_amdgcn_mfma_f32_16x16x32_bf16((a), (b), (c), 0, 0, 0)
#define WAVE_LDS_FENCE() asm volatile("s_waitcnt lgkmcnt(0)" ::: "memory")

constexpr int SB_KS_OFF = 0, SB_VT_OFF = 9216, SB_Z_OFF = 18432, SB_W_OFF = SB_Z_OFF + 8 * 8704, SB_FLAG_OFF = SB_W_OFF + 8 * 4608;
constexpr float SB_THR = 104.0f;
__device__ __forceinline__ void ph_sb_attn2(unsigned char* lds, const bf16_t* proj, bf16_t* mix) {
    const int tid = tid_opaque(), lane = tid & 63, wave = __builtin_amdgcn_readfirstlane(tid >> 6), fr = lane & 15, fq = lane >> 4;
    bf16_t* Ks = (bf16_t*)(lds + SB_KS_OFF);
    bf16_t* Vt = (bf16_t*)(lds + SB_VT_OFF);
    float* Zs = (float*)(lds + SB_Z_OFF + wave * 8704);
    bf16_t* Ws = (bf16_t*)(lds + SB_W_OFF + wave * 4608);
    volatile int* flags = (volatile int*)(lds + SB_FLAG_OFF);
    const int qs = lane >> 1, hs = lane & 1;
    for (int unit = blockIdx.x; unit < BATCH * 8 * (SEQ / 256); unit += gridDim.x) {
        const int bh = unit & 15, qc = unit >> 4, b = bh >> 3, h = bh & 7, q0 = qc * 256;
        const size_t rowbase = (size_t)b * SEQ;
        bf16x8 qf[2][2];
#pragma unroll
        for (int mt = 0; mt < 2; ++mt)
#pragma unroll
            for (int ks = 0; ks < 2; ++ks) {
                const v4u raw = *(const v4u*)(proj + (rowbase + q0 + 32 * wave + mt * 16 + fr) * AB_IN + h * 64 + ks * 32 + fq * 8);
                v4u sc;
                sc.x = pk2(bflo(raw.x) * 0.125f, bfhi(raw.x) * 0.125f); sc.y = pk2(bflo(raw.y) * 0.125f, bfhi(raw.y) * 0.125f);
                sc.z = pk2(bflo(raw.z) * 0.125f, bfhi(raw.z) * 0.125f); sc.w = pk2(bflo(raw.w) * 0.125f, bfhi(raw.w) * 0.125f);
                qf[mt][ks] = __builtin_bit_cast(bf16x8, sc);
            }
        f32x4 o[2][4];
#pragma unroll
        for (int mt = 0; mt < 2; ++mt)
#pragma unroll
            for (int nt = 0; nt < 4; ++nt) o[mt][nt] = (f32x4){0.f, 0.f, 0.f, 0.f};
        float carry = 0.f;
        const int t_row = q0 + 32 * wave + qs, tmax_w = q0 + 32 * wave + 31;
        bool wave_done = false;
        for (int kt = (q0 >> 6) + 3; kt >= 0; --kt) {
            {
                const int r = tid >> 3, c = tid & 7;
                const bf16_t* rp = proj + (rowbase + kt * 64 + r) * AB_IN + h * 64 + c * 8;
                const v4u kv = *(const v4u*)(rp + 512); const v4u vv = *(const v4u*)(rp + 1024);
                *(v4u*)(Ks + r * 72 + c * 8) = kv;
                bf16_t* vp = Vt + (c * 8) * 72 + r;
                vp[0 * 72] = (bf16_t)(vv.x & 0xffffu); vp[1 * 72] = (bf16_t)(vv.x >> 16); vp[2 * 72] = (bf16_t)(vv.y & 0xffffu); vp[3 * 72] = (bf16_t)(vv.y >> 16);
                vp[4 * 72] = (bf16_t)(vv.z & 0xffffu); vp[5 * 72] = (bf16_t)(vv.z >> 16); vp[6 * 72] = (bf16_t)(vv.w & 0xffffu); vp[7 * 72] = (bf16_t)(vv.w >> 16);
            }
            __syncthreads();
            if (!wave_done && kt * 64 < tmax_w) {
#pragma unroll
                for (int nt = 0; nt < 4; ++nt) {
                    const bf16x8 b0 = *(const bf16x8*)(Ks + (nt * 16 + fr) * 72 + fq * 8), b1 = *(const bf16x8*)(Ks + (nt * 16 + fr) * 72 + 32 + fq * 8);
#pragma unroll
                    for (int mt = 0; mt < 2; ++mt) {
                        f32x4 z4 = MFMA16(qf[mt][0], b0, ((f32x4){0.f, 0.f, 0.f, 0.f}));
                        z4 = MFMA16(qf[mt][1], b1, z4);
#pragma unroll
                        for (int rg = 0; rg < 4; ++rg) Zs[(mt * 16 + fq * 4 + rg) * 68 + nt * 16 + fr] = z4[rg];
                    }
                }
                WAVE_LDS_FENCE();
                float zz[32];
#pragma unroll
                for (int k4 = 0; k4 < 8; ++k4) { const f32x4 v = *(const f32x4*)(Zs + qs * 68 + hs * 32 + k4 * 4); zz[k4 * 4 + 0] = v[0]; zz[k4 * 4 + 1] = v[1]; zz[k4 * 4 + 2] = v[2]; zz[k4 * 4 + 3] = v[3]; }
                const int s0 = kt * 64 + hs * 32;
                float run = 0.f;
                float lw[32];
#pragma unroll
                for (int i = 31; i >= 0; --i) {
                    const float z = zz[i];
                    const float sp = fmaxf(z, 0.f) + __logf(1.f + __expf(-fabsf(z)));
                    const bool valid = (s0 + i) < t_row;
                    lw[i] = valid ? (z - sp - run) : -INFINITY;
                    run += valid ? sp : 0.f;
                }
                const float other = __shfl_xor(run, 1);
                const float base = carry + (hs == 0 ? other : 0.f);
                carry += run + other;
                unsigned pw[16];
#pragma unroll
                for (int i = 0; i < 32; i += 2) pw[i >> 1] = pk2(__expf(lw[i] - base), __expf(lw[i + 1] - base));
#pragma unroll
                for (int k4 = 0; k4 < 4; ++k4) { v4u w4; w4.x = pw[k4 * 4]; w4.y = pw[k4 * 4 + 1]; w4.z = pw[k4 * 4 + 2]; w4.w = pw[k4 * 4 + 3]; *(v4u*)(Ws + qs * 72 + hs * 32 + k4 * 8) = w4; }
                WAVE_LDS_FENCE();
#pragma unroll
                for (int ks = 0; ks < 2; ++ks) {
                    const bf16x8 a0 = *(const bf16x8*)(Ws + fr * 72 + ks * 32 + fq * 8), a1 = *(const bf16x8*)(Ws + (16 + fr) * 72 + ks * 32 + fq * 8);
#pragma unroll
                    for (int nt = 0; nt < 4; ++nt) {
                        const bf16x8 bv = *(const bf16x8*)(Vt + (nt * 16 + fr) * 72 + ks * 32 + fq * 8);
                        o[0][nt] = MFMA16(a0, bv, o[0][nt]); o[1][nt] = MFMA16(a1, bv, o[1][nt]);
                    }
                }
                wave_done = __all(carry > SB_THR) != 0;
            }
            if (lane == 0) flags[wave] = wave_done ? 1 : 0;
            __syncthreads();
            int nd = 0;
#pragma unroll
            for (int w8 = 0; w8 < 8; ++w8) nd += flags[w8];
            if (nd == 8) break;
        }
        WAVE_LDS_FENCE();
#pragma unroll
        for (int mt = 0; mt < 2; ++mt)
#pragma unroll
            for (int nt = 0; nt < 4; ++nt)
#pragma unroll
                for (int rg = 0; rg < 4; ++rg) Ws[(mt * 16 + fq * 4 + rg) * 72 + nt * 16 + fr] = (bf16_t)f2bf(o[mt][nt][rg]);
        WAVE_LDS_FENCE();
#pragma unroll
        for (int i = 0; i < 4; ++i) { const int id = i * 64 + lane, row = id >> 3, c = id & 7;
            *(v4u*)(mix + (rowbase + q0 + 32 * wave + row) * D_MODEL + h * 64 + c * 8) = *(const v4u*)(Ws + row * 72 + c * 8); }
        __syncthreads();
    }
}

constexpr int LRU_SLOT = 17408;
template <bool FINAL>
__device__ __forceinline__ void ph_lru(unsigned char* lds, const bf16_t* proj, const float* conv_w, const float* conv_b, const bf16_t* wt, const float* b_r, const float* b_i,
                                       const float* lam, float2* sum, bf16_t* mix) {
    const int tid = tid_opaque(), lane = tid & 63, wave = __builtin_amdgcn_readfirstlane(tid >> 6), fr = lane & 15, fq = lane >> 4;
    bf16_t* XC = (bf16_t*)(lds + wave * LRU_SLOT);
    float* AUa = (float*)(lds + wave * LRU_SLOT + 9216);
    float* AUu = AUa + 1024;
    const int ch = wave * 64 + lane;
    const float cw0 = conv_w[ch], cw1 = conv_w[512 + ch], cw2 = conv_w[1024 + ch], cw3 = conv_w[1536 + ch], cb = conv_b[ch];
    bf16x8 wr[4][2], wi[4][2];
    float br[4], bi[4], spl[4];
#pragma unroll
    for (int nt = 0; nt < 4; ++nt) {
#pragma unroll
        for (int ks = 0; ks < 2; ++ks) {
            wr[nt][ks] = *(const bf16x8*)(wt + ((size_t)(0 * 8 + wave) * 64 + nt * 16 + fr) * 64 + ks * 32 + fq * 8);
            wi[nt][ks] = *(const bf16x8*)(wt + ((size_t)(1 * 8 + wave) * 64 + nt * 16 + fr) * 64 + ks * 32 + fq * 8);
        }
        const int cd = wave * 64 + nt * 16 + fr;
        br[nt] = b_r[cd]; bi[nt] = b_i[cd];
        const float nl = -lam[cd]; spl[nt] = fmaxf(nl, 0.f) + log1pf(expf(-fabsf(nl)));
    }
    for (int unit = blockIdx.x; unit < BATCH * (SEQ / 64); unit += gridDim.x) {
        const int b = unit >> 7, chunk = unit & 127;
        const size_t tokbase = (size_t)b * SEQ + chunk * 64;
        {
            float xm3 = 0.f, xm2 = 0.f, xm1 = 0.f;
            if (chunk > 0) { xm3 = bf2f(proj[(tokbase - 3) * AB_IN + 1536 + ch]); xm2 = bf2f(proj[(tokbase - 2) * AB_IN + 1536 + ch]); xm1 = bf2f(proj[(tokbase - 1) * AB_IN + 1536 + ch]); }
#pragma unroll 8
            for (int i = 0; i < 64; ++i) {
                const float x = bf2f(proj[(tokbase + i) * AB_IN + 1536 + ch]);
                const float y = cb + cw0 * xm3 + cw1 * xm2 + cw2 * xm1 + cw3 * x;
                XC[i * 72 + lane] = (bf16_t)f2bf(y);
                xm3 = xm2; xm2 = xm1; xm1 = x;
            }
        }
        float hst = 0.f, ap = 1.f;
        if (FINAL) {
            for (int j = 0; j < chunk; ++j) { const float2 sj = sum[(size_t)(b * 128 + j) * 512 + ch]; hst = sj.x * hst + sj.y; }
        }
        WAVE_LDS_FENCE();
#pragma unroll 1
        for (int mt = 0; mt < 4; ++mt) {
            const bf16x8 a0 = *(const bf16x8*)(XC + (mt * 16 + fr) * 72 + fq * 8), a1 = *(const bf16x8*)(XC + (mt * 16 + fr) * 72 + 32 + fq * 8);
#pragma unroll
            for (int nt = 0; nt < 4; ++nt) {
                f32x4 cr = MFMA16(a0, wr[nt][0], ((f32x4){0.f, 0.f, 0.f, 0.f})); cr = MFMA16(a1, wr[nt][1], cr);
                f32x4 ci = MFMA16(a0, wi[nt][0], ((f32x4){0.f, 0.f, 0.f, 0.f})); ci = MFMA16(a1, wi[nt][1], ci);
#pragma unroll
                for (int rg = 0; rg < 4; ++rg) {
                    const int tokl = fq * 4 + rg, d = nt * 16 + fr;
                    const float r = 1.f / (1.f + __expf(-(cr[rg] + br[nt]))), ig = 1.f / (1.f + __expf(-(ci[rg] + bi[nt])));
                    const float la = -8.0f * r * spl[nt];
                    const float xv = bf2f(XC[(mt * 16 + tokl) * 72 + d]);
                    AUa[tokl * 64 + d] = __expf(la);
                    AUu[tokl * 64 + d] = sqrtf(-expm1f(2.0f * la)) * (ig * xv);
                }
            }
            WAVE_LDS_FENCE();
#pragma unroll
            for (int tl = 0; tl < 16; ++tl) {
                const float a = AUa[tl * 64 + lane], u = AUu[tl * 64 + lane];
                hst = a * hst + u; ap *= a;
                if (FINAL) {
                    const size_t tok = tokbase + mt * 16 + tl;
                    const float g = bf2f(proj[tok * AB_IN + 2048 + ch]);
                    mix[tok * D_MODEL + 512 + ch] = (bf16_t)f2bf(gelu_tanh(g) * hst);
                }
            }
            WAVE_LDS_FENCE();
        }
        if (!FINAL) sum[(size_t)(b * 128 + chunk) * 512 + ch] = make_float2(ap, hst);
    }
}

constexpr int SWA_SC_OFF = SB_FLAG_OFF + 64;
__device__ __forceinline__ void ph_swa2(unsigned char* lds, const bf16_t* proj, const float2* rope, const float* sinks, bf16_t* mix) {
    const int tid = tid_opaque(), lane = tid & 63, wave = __builtin_amdgcn_readfirstlane(tid >> 6), fr = lane & 15, fq = lane >> 4;
    bf16_t* Ks = (bf16_t*)(lds + SB_KS_OFF);
    bf16_t* Vt = (bf16_t*)(lds + SB_VT_OFF);
    float* Zs = (float*)(lds + SB_Z_OFF + wave * 8704);
    bf16_t* Ws = (bf16_t*)(lds + SB_W_OFF + wave * 4608);
    float* SC = (float*)(lds + SWA_SC_OFF + wave * 256);
    float* LS = SC + 32;
    const int qs = lane >> 1, hs = lane & 1, g = wave >> 1, qh = wave & 1;
    for (int unit = blockIdx.x; unit < BATCH * 4 * (SEQ / 64); unit += gridDim.x) {
        const int bk = unit & 7, qb = unit >> 3, b = bk >> 2, kv = bk & 3, hq = kv * 4 + g, t0 = qb * 64;
        const size_t rowbase = (size_t)b * SEQ;
        bf16x8 qf[2][2];
#pragma unroll
        for (int mt = 0; mt < 2; ++mt) {
            const size_t tok = rowbase + t0 + 32 * qh + mt * 16 + fr;
            const v4u r0 = *(const v4u*)(proj + tok * C_IN + hq * 64 + fq * 8), r1 = *(const v4u*)(proj + tok * C_IN + hq * 64 + 32 + fq * 8);
            const unsigned w0[4] = {r0.x, r0.y, r0.z, r0.w}, w1[4] = {r1.x, r1.y, r1.z, r1.w};
            unsigned o0[4], o1[4];
#pragma unroll
            for (int j2 = 0; j2 < 4; ++j2) {
                const float4 cs = *(const float4*)(rope + tok * 32 + fq * 8 + j2 * 2);
                const float a0 = bflo(w0[j2]), a1 = bfhi(w0[j2]), c0 = bflo(w1[j2]), c1 = bfhi(w1[j2]);
                o0[j2] = pk2((a0 * cs.x - c0 * cs.y) * 0.125f, (a1 * cs.z - c1 * cs.w) * 0.125f);
                o1[j2] = pk2((c0 * cs.x + a0 * cs.y) * 0.125f, (c1 * cs.z + a1 * cs.w) * 0.125f);
            }
            v4u p0; p0.x = o0[0]; p0.y = o0[1]; p0.z = o0[2]; p0.w = o0[3];
            v4u p1; p1.x = o1[0]; p1.y = o1[1]; p1.z = o1[2]; p1.w = o1[3];
            qf[mt][0] = __builtin_bit_cast(bf16x8, p0); qf[mt][1] = __builtin_bit_cast(bf16x8, p1);
        }
        f32x4 o[2][4];
#pragma unroll
        for (int mt = 0; mt < 2; ++mt)
#pragma unroll
            for (int nt = 0; nt < 4; ++nt) o[mt][nt] = (f32x4){0.f, 0.f, 0.f, 0.f};
        float mrun = sinks[hq], lrun = 1.f;
        const int t_row = t0 + 32 * qh + qs;
        for (int kt = qb - 2; kt <= qb; ++kt) {
            if (kt < 0) continue;
            __syncthreads();
            {
                const int r = tid >> 3, c = tid & 7;
                const size_t tok = rowbase + kt * 64 + r;
                if (c < 4) {
                    const v4u r0 = *(const v4u*)(proj + tok * C_IN + 1024 + kv * 64 + c * 8), r1 = *(const v4u*)(proj + tok * C_IN + 1024 + kv * 64 + 32 + c * 8);
                    const unsigned w0[4] = {r0.x, r0.y, r0.z, r0.w}, w1[4] = {r1.x, r1.y, r1.z, r1.w};
                    unsigned o0[4], o1[4];
#pragma unroll
                    for (int j2 = 0; j2 < 4; ++j2) {
                        const float4 cs = *(const float4*)(rope + tok * 32 + c * 8 + j2 * 2);
                        const float a0 = bflo(w0[j2]), a1 = bfhi(w0[j2]), c0 = bflo(w1[j2]), c1 = bfhi(w1[j2]);
                        o0[j2] = pk2(a0 * cs.x - c0 * cs.y, a1 * cs.z - c1 * cs.w);
                        o1[j2] = pk2(c0 * cs.x + a0 * cs.y, c1 * cs.z + a1 * cs.w);
                    }
                    v4u p0; p0.x = o0[0]; p0.y = o0[1]; p0.z = o0[2]; p0.w = o0[3];
                    v4u p1; p1.x = o1[0]; p1.y = o1[1]; p1.z = o1[2]; p1.w = o1[3];
                    *(v4u*)(Ks + r * 72 + c * 8) = p0; *(v4u*)(Ks + r * 72 + 32 + c * 8) = p1;
                } else {
                    const int cc = c - 4;
                    const v4u v0 = *(const v4u*)(proj + tok * C_IN + 1280 + kv * 64 + cc * 16), v1 = *(const v4u*)(proj + tok * C_IN + 1280 + kv * 64 + cc * 16 + 8);
                    bf16_t* vp = Vt + (cc * 16) * 72 + r;
                    vp[0 * 72] = (bf16_t)(v0.x & 0xffffu); vp[1 * 72] = (bf16_t)(v0.x >> 16); vp[2 * 72] = (bf16_t)(v0.y & 0xffffu); vp[3 * 72] = (bf16_t)(v0.y >> 16);
                    vp[4 * 72] = (bf16_t)(v0.z & 0xffffu); vp[5 * 72] = (bf16_t)(v0.z >> 16); vp[6 * 72] = (bf16_t)(v0.w & 0xffffu); vp[7 * 72] = (bf16_t)(v0.w >> 16);
                    vp[8 * 72] = (bf16_t)(v1.x & 0xffffu); vp[9 * 72] = (bf16_t)(v1.x >> 16); vp[10 * 72] = (bf16_t)(v1.y & 0xffffu); vp[11 * 72] = (bf16_t)(v1.y >> 16);
                    vp[12 * 72] = (bf16_t)(v1.z & 0xffffu); vp[13 * 72] = (bf16_t)(v1.z >> 16); vp[14 * 72] = (bf16_t)(v1.w & 0xffffu); vp[15 * 72] = (bf16_t)(v1.w >> 16);
                }
            }
            __syncthreads();
#pragma unroll
            for (int nt = 0; nt < 4; ++nt) {
                const bf16x8 b0 = *(const bf16x8*)(Ks + (nt * 16 + fr) * 72 + fq * 8), b1 = *(const bf16x8*)(Ks + (nt * 16 + fr) * 72 + 32 + fq * 8);
#pragma unroll
                for (int mt = 0; mt < 2; ++mt) {
                    f32x4 z4 = MFMA16(qf[mt][0], b0, ((f32x4){0.f, 0.f, 0.f, 0.f}));
                    z4 = MFMA16(qf[mt][1], b1, z4);
#pragma unroll
                    for (int rg = 0; rg < 4; ++rg) Zs[(mt * 16 + fq * 4 + rg) * 68 + nt * 16 + fr] = z4[rg];
                }
            }
            WAVE_LDS_FENCE();
            float zz[32];
#pragma unroll
            for (int k4 = 0; k4 < 8; ++k4) { const f32x4 v = *(const f32x4*)(Zs + qs * 68 + hs * 32 + k4 * 4); zz[k4 * 4 + 0] = v[0]; zz[k4 * 4 + 1] = v[1]; zz[k4 * 4 + 2] = v[2]; zz[k4 * 4 + 3] = v[3]; }
            const int s0 = kt * 64 + hs * 32;
            float tmx = -INFINITY;
#pragma unroll
            for (int i = 0; i < 32; ++i) { const int s = s0 + i; const bool valid = (s <= t_row) && (t_row - s < 128); zz[i] = valid ? zz[i] : -INFINITY; tmx = fmaxf(tmx, zz[i]); }
            tmx = fmaxf(tmx, __shfl_xor(tmx, 1));
            const float mnew = fmaxf(mrun, tmx);
            const float scl = __expf(mrun - mnew);
            float psum = 0.f;
            unsigned pw[16];
#pragma unroll
            for (int i = 0; i < 32; i += 2) { const float p0 = __expf(zz[i] - mnew), p1 = __expf(zz[i + 1] - mnew); psum += p0 + p1; pw[i >> 1] = pk2(p0, p1); }
            psum += __shfl_xor(psum, 1);
            lrun = lrun * scl + psum; mrun = mnew;
#pragma unroll
            for (int k4 = 0; k4 < 4; ++k4) { v4u w4; w4.x = pw[k4 * 4]; w4.y = pw[k4 * 4 + 1]; w4.z = pw[k4 * 4 + 2]; w4.w = pw[k4 * 4 + 3]; *(v4u*)(Ws + qs * 72 + hs * 32 + k4 * 8) = w4; }
            if (hs == 0) SC[qs] = scl;
            WAVE_LDS_FENCE();
#pragma unroll
            for (int mt = 0; mt < 2; ++mt) {
                const f32x4 sc4 = *(const f32x4*)(SC + mt * 16 + fq * 4);
#pragma unroll
                for (int nt = 0; nt < 4; ++nt) { o[mt][nt][0] *= sc4[0]; o[mt][nt][1] *= sc4[1]; o[mt][nt][2] *= sc4[2]; o[mt][nt][3] *= sc4[3]; }
            }
#pragma unroll
            for (int ks = 0; ks < 2; ++ks) {
                const bf16x8 a0 = *(const bf16x8*)(Ws + fr * 72 + ks * 32 + fq * 8), a1 = *(const bf16x8*)(Ws + (16 + fr) * 72 + ks * 32 + fq * 8);
#pragma unroll
                for (int nt = 0; nt < 4; ++nt) {
                    const bf16x8 bv = *(const bf16x8*)(Vt + (nt * 16 + fr) * 72 + ks * 32 + fq * 8);
                    o[0][nt] = MFMA16(a0, bv, o[0][nt]); o[1][nt] = MFMA16(a1, bv, o[1][nt]);
                }
            }
            WAVE_LDS_FENCE();
        }
        if (hs == 0) LS[qs] = 1.f / lrun;
        WAVE_LDS_FENCE();
#pragma unroll
        for (int mt = 0; mt < 2; ++mt) {
            const f32x4 li = *(const f32x4*)(LS + mt * 16 + fq * 4);
#pragma unroll
            for (int nt = 0; nt < 4; ++nt)
#pragma unroll
                for (int rg = 0; rg < 4; ++rg) Ws[(mt * 16 + fq * 4 + rg) * 72 + nt * 16 + fr] = (bf16_t)f2bf(o[mt][nt][rg] * li[rg]);
        }
        WAVE_LDS_FENCE();
#pragma unroll
        for (int i = 0; i < 4; ++i) { const int id = i * 64 + lane, row = id >> 3, c = id & 7;
            *(v4u*)(mix + (rowbase + t0 + 32 * qh + row) * D_MODEL + hq * 64 + c * 8) = *(const v4u*)(Ws + row * 72 + c * 8); }
    }
    __syncthreads();
}

struct Args {
    const void* in[27];
    float* out;
    unsigned char* ws;
};

__global__ void __launch_bounds__(NTHREADS, 2) fwd_megakernel(Args args) {
    extern __shared__ __attribute__((aligned(16))) unsigned char lds[];
    cg::grid_group grid = cg::this_grid();
    if (threadIdx.x < 16) ((LAS unsigned*)((LAS unsigned char*)lds + BARST_OFF))[threadIdx.x] = 0u;
    __syncthreads();
    const XcdBarrier xbar = xcd_barrier_post((unsigned*)(args.ws + WS_CTL) + CW_BAR, (volatile LAS unsigned*)((LAS unsigned char*)lds + BARST_OFF));
#define GRID_BAR() xcd_barrier(xbar)
    const float* x_in = (const float*)args.in[0];
    const float* p_in = (const float*)args.in[1];
    const int* positions = (const int*)args.in[2];
    const float* w_in_ab = (const float*)args.in[3];
    const float* w_out_ab = (const float*)args.in[4];
    const float* conv_w = (const float*)args.in[5];
    const float* conv_b = (const float*)args.in[6];
    const float* lru_w_r = (const float*)args.in[7];
    const float* lru_b_r = (const float*)args.in[8];
    const float* lru_w_i = (const float*)args.in[9];
    const float* lru_b_i = (const float*)args.in[10];
    const float* lru_lambda = (const float*)args.in[11];
    const float* w_qkv_c = (const float*)args.in[12];
    const float* w_out_c = (const float*)args.in[13];
    const float* sinks_c = (const float*)args.in[14];
    const float* ln_mix_g = (const float*)args.in[15];
    const float* ln_mix_b = (const float*)args.in[16];
    const float* ln_ffn_g = (const float*)args.in[17];
    const float* ln_ffn_b = (const float*)args.in[18];
    const float* w_router = (const float*)args.in[19];
    const float* b_router = (const float*)args.in[20];
    const float* exp_w_gate = (const float*)args.in[21];
    const float* exp_w_up = (const float*)args.in[22];
    const float* exp_w_down = (const float*)args.in[23];
    const float* ple_w_proj = (const float*)args.in[24];
    const float* ple_w_gate = (const float*)args.in[25];
    const float* ple_b_gate = (const float*)args.in[26];
    float* out = args.out;
    unsigned char* ws = args.ws;
    bf16_t* W_IN = (bf16_t*)(ws + WS_W_IN); bf16_t* W_OUTAB = (bf16_t*)(ws + WS_W_OUTAB); bf16_t* W_QKV = (bf16_t*)(ws + WS_W_QKV); bf16_t* W_OUTC = (bf16_t*)(ws + WS_W_OUTC);
    bf16_t* W_PLEG = (bf16_t*)(ws + WS_W_PLEG); bf16_t* W_PLEP = (bf16_t*)(ws + WS_W_PLEP);
    bf16_t* PROJ = (bf16_t*)(ws + WS_PROJ); bf16_t* MIX = (bf16_t*)(ws + WS_MIX); bf16_t* XNA = (bf16_t*)(ws + WS_XNA); bf16_t* XNB = (bf16_t*)(ws + WS_XNB);
    bf16_t* PP = (bf16_t*)(ws + WS_PP); bf16_t* PB = (bf16_t*)(ws + WS_PB);
    int* EIDX = (int*)(ws + WS_EIDX); float* GATEW = (float*)(ws + WS_GATEW); int* LIST = (int*)(ws + WS_LIST); int* POS = (int*)(ws + WS_POS);
    unsigned* CTL = (unsigned*)(ws + WS_CTL);
    float2* ROPE = (float2*)(ws + WS_ROPE);
    float2* LRUSUM = (float2*)(ws + WS_LRUSUM); bf16_t* LRUW = (bf16_t*)(ws + WS_LRUW);
    bf16_t* W_GU = (bf16_t*)(ws + WS_W_GU); bf16_t* W_DN = (bf16_t*)(ws + WS_W_DN); bf16_t* XS = (bf16_t*)(ws + WS_XS); bf16_t* HB = (bf16_t*)(ws + WS_H);
    float* HOUT = (float*)(ws + WS_PROJ);
    const int tid = threadIdx.x, lane = tid & 63, wave = __builtin_amdgcn_readfirstlane(tid >> 6);
    LAS unsigned char* ldsl = (LAS unsigned char*)lds;

    ph_convert_experts(ldsl, lnd(exp_w_gate), lnd(exp_w_up), lnd(exp_w_down), lnd(W_GU), lnd(W_DN));
    {
        LAS float* scr = (LAS float*)(ldsl + wave * 16384);
        const int gw = blockIdx.x * NWAVES + wave, NGW = gridDim.x * NWAVES;
        constexpr int I_IN = 16 * 80, I_SQ = 16 * 32, I_QKV = 16 * 48, I_PP = 4 * 32;
        constexpr int NITEMS = I_IN + I_SQ + I_QKV + I_SQ + 2 * I_SQ + 2 * I_PP + 32;
        for (int it = gw; it < NITEMS; it += NGW) {
            int r = it;
            if (r < I_IN) { p0_transpose_item(w_in_ab, 1024, 2560, W_IN, 0, scr, r, lane); continue; } r -= I_IN;
            if (r < I_SQ) { p0_transpose_item(w_out_ab, 1024, 1024, W_OUTAB, 0, scr, r, lane); continue; } r -= I_SQ;
            if (r < I_QKV) { p0_transpose_item(w_qkv_c, 1024, 1536, W_QKV, 0, scr, r, lane); continue; } r -= I_QKV;
            if (r < I_SQ) { p0_transpose_item(w_out_c, 1024, 1024, W_OUTC, 0, scr, r, lane); continue; } r -= I_SQ;
            if (r < I_SQ) { p0_transpose_item(ple_w_gate, 1024, 1024, W_PLEG, 0, scr, r, lane); continue; } r -= I_SQ;
            if (r < I_SQ) { p0_transpose_item(ple_w_gate + (size_t)1024 * 1024, 1024, 1024, W_PLEG + (size_t)1024 * 1024, 0, scr, r, lane); continue; } r -= I_SQ;
            if (r < I_PP) { p0_transpose_item(ple_w_proj, 256, 1024, W_PLEP, 0, scr, r, lane); continue; } r -= I_PP;
            if (r < I_PP) { p0_transpose_item(ple_w_proj + (size_t)256 * 1024, 256, 1024, W_PLEP + (size_t)1024 * 256, 0, scr, r, lane); continue; } r -= I_PP;
            {
                const int mtx = r >> 1; const float* src = (mtx < 8 ? lru_w_r + mtx * 4096 : lru_w_i + (mtx - 8) * 4096);
                p0_transpose_item(src, 64, 64, LRUW + (size_t)mtx * 4096, 0, scr, r & 1, lane);
            }
        }
        for (int idx = blockIdx.x * NTHREADS + tid; idx < NTOK * 32; idx += gridDim.x * NTHREADS) {
            const int i = idx & 31, tok = idx >> 5;
            const float ang = (float)positions[tok] * powf(10000.0f, -(float)i / 32.0f);
            ROPE[idx] = make_float2(cosf(ang), sinf(ang));
        }
        for (int m = gw; m < NTOK; m += NGW) row1024_to_bf16(x_in + (size_t)m * D_MODEL, XNA + (size_t)m * D_MODEL, lane);
        for (int m = gw; m < 2 * NTOK; m += NGW) {
            const f32x4 v = *((const f32x4*)(p_in + (size_t)m * PLE_DIM) + lane);
            v2u w; w.x = pk2(v[0], v[1]); w.y = pk2(v[2], v[3]);
            *((v2u*)(PB + (size_t)m * PLE_DIM) + lane) = w;
        }
    }
    grid.sync();

#pragma unroll
    for (int layer = 0; layer < 2; ++layer) {
        const float* xin = (layer == 0) ? x_in : out;
        if (layer == 0) {
            pg8::Gemm g{XNA, W_IN, NTOK, AB_IN, D_MODEL}; pg8::StaticOrder S; S.init(NTOK, AB_IN, (int)gridDim.x, (int)blockIdx.x);
            pg8::EpiBf16<0> E{PROJ, AB_IN, nullptr, 0, 0, 1.f};
            pg8::gemm_phase<pg8::EpiBf16<0>, pg8::StaticOrder, PG8_ALIGN, PG8_SP2>(ldsl, g, S, E);
        } else {
            pg8::Gemm g{XNA, W_QKV, NTOK, C_IN, D_MODEL}; pg8::StaticOrder S; S.init(NTOK, C_IN, (int)gridDim.x, (int)blockIdx.x);
            pg8::EpiBf16<0> E{PROJ, C_IN, nullptr, 0, 0, 1.f};
            pg8::gemm_phase<pg8::EpiBf16<0>, pg8::StaticOrder, PG8_ALIGN, PG8_SP2>(ldsl, g, S, E);
        }
        {
            pg8::Gemm g{PB + (size_t)layer * NTOK * PLE_DIM, W_PLEP + (size_t)layer * 1024 * 256, NTOK, D_MODEL, PLE_DIM}; pg8::StaticOrder S; S.init(NTOK, D_MODEL, (int)gridDim.x, (int)blockIdx.x);
            pg8::EpiBf16<0> E{PP, D_MODEL, nullptr, 0, 0, 1.f};
            pg8::gemm_phase<pg8::EpiBf16<0>, pg8::StaticOrder, PG8_ALIGN, PG8_SP2>(ldsl, g, S, E);
        }
        GRID_BAR();
        if (layer == 0) {
            ph_lru<false>(lds, lnd(PROJ), lnd(conv_w), lnd(conv_b), lnd(LRUW), lnd(lru_b_r), lnd(lru_b_i), lnd(lru_lambda), lnd(LRUSUM), lnd(MIX));
            GRID_BAR();
            ph_sb_attn2(lds, lnd(PROJ), lnd(MIX));
            ph_lru<true>(lds, lnd(PROJ), lnd(conv_w), lnd(conv_b), lnd(LRUW), lnd(lru_b_r), lnd(lru_b_i), lnd(lru_lambda), lnd(LRUSUM), lnd(MIX));
        } else {
            ph_swa2(lds, lnd(PROJ), lnd(ROPE), lnd(sinks_c), lnd(MIX));
        }
        GRID_BAR();
        {
            pg8::Gemm g{MIX, layer == 0 ? W_OUTAB : W_OUTC, NTOK, D_MODEL, D_MODEL}; pg8::StaticOrder S; S.init(NTOK, D_MODEL, (int)gridDim.x, (int)blockIdx.x);
            EpiF32 E{HOUT, D_MODEL};
            pg8::gemm_phase<EpiF32, pg8::StaticOrder, PG8_ALIGN, PG8_SP2>(ldsl, g, S, E);
        }
        GRID_BAR();
        ph_res_ln<false>(lnd(xin), lnd(HOUT), lnd(ln_mix_g + layer * D_MODEL), lnd(ln_mix_b + layer * D_MODEL), lnd(out), lnd(XNA), (const float*)nullptr, (const float*)nullptr, (int*)nullptr, (float*)nullptr);
        if (layer == 1) ph_convert_experts(ldsl, lnd(exp_w_gate + (size_t)N_EXP * D_MODEL * D_FF), lnd(exp_w_up + (size_t)N_EXP * D_MODEL * D_FF), lnd(exp_w_down + (size_t)N_EXP * D_FF * D_MODEL), lnd(W_GU), lnd(W_DN));
        GRID_BAR();
        ph_route(lds, lnd(out), lnd(w_router), lnd(b_router), lnd(GATEW), lnd(CTL + CW_CNT + 16 * layer), lnd(LIST));
        GRID_BAR();
        ph_permute(lds, lnd(CTL + CW_CNT + 16 * layer), lnd(LIST), lnd(XNA), lnd(XS), lnd(POS));
        GRID_BAR();
        {
            moe_offsets(lds, lnd(CTL + CW_CNT + 16 * layer));
            MoeOrder S{(const LAS int*)(ldsl + MISC_OFF + 2048), (int)gridDim.x, (int)blockIdx.x};
            pg8::Gemm g{XS, W_GU, 0, 0, D_MODEL};
            EpiGU E{HB};
            pg8::gemm_phase<EpiGU, MoeOrder, PG8_ALIGN, PG8_SP2>(ldsl, g, S, E);
        }
        GRID_BAR();
        {
            MoeOrder S{(const LAS int*)(ldsl + MISC_OFF + 2048), (int)gridDim.x, (int)blockIdx.x};
            pg8::Gemm g{HB, W_DN, 0, 0, D_FF};
            EpiBf16N E{XS, D_MODEL};
            pg8::gemm_phase<EpiBf16N, MoeOrder, PG8_ALIGN, PG8_SP2>(ldsl, g, S, E);
        }
        GRID_BAR();
        ph_combine_ln(lnd(out), lnd(XS), lnd(POS), lnd(GATEW), lnd(ln_ffn_g + layer * D_MODEL), lnd(ln_ffn_b + layer * D_MODEL), lnd(out), lnd(XNB));
        GRID_BAR();
        {
            pg8::Gemm g{XNB, W_PLEG + (size_t)layer * 1024 * 1024, NTOK, D_MODEL, D_MODEL}; pg8::StaticOrder S; S.init(NTOK, D_MODEL, (int)gridDim.x, (int)blockIdx.x);
            EpiPle E{out, PP, XNA, ple_b_gate + layer * D_MODEL};
            pg8::gemm_phase<EpiPle, pg8::StaticOrder, PG8_ALIGN, PG8_SP2>(ldsl, g, S, E);
        }
        if (layer == 0) GRID_BAR();
    }
}
}

extern "C" void kernel_launch(void* const* d_in, const int* in_sizes, int n_in, void* d_out, int out_size, void* d_ws, size_t ws_size,
                              hipStream_t stream) {
    static int grid_blocks = 0;
    if (grid_blocks == 0) {
        int dev = 0, cus = 0, per_cu = 0;
        (void)hipGetDevice(&dev);
        (void)hipDeviceGetAttribute(&cus, hipDeviceAttributeMultiprocessorCount, dev);
        if (hipFuncSetAttribute((const void*)fwd_megakernel, hipFuncAttributeMaxDynamicSharedMemorySize, LDS_BYTES) != hipSuccess)
            fprintf(stderr, "kernel_launch: hipFuncSetAttribute failed\n");
        if (hipOccupancyMaxActiveBlocksPerMultiprocessor(&per_cu, (const void*)fwd_megakernel, NTHREADS, LDS_BYTES) != hipSuccess || per_cu < 1) {
            fprintf(stderr, "kernel_launch: occupancy query gave %d\n", per_cu);
            per_cu = 1;
        }
        (void)hipGetLastError();
        grid_blocks = cus * 1;
        if (n_in != 27 || ws_size < WS_END) fprintf(stderr, "kernel_launch: unexpected n_in %d / ws %zu\n", n_in, ws_size);
    }
    if (hipMemsetAsync((char*)d_ws + WS_CTL, 0, CTL_ZERO_BYTES, stream) != hipSuccess) fprintf(stderr, "kernel_launch: hipMemsetAsync failed\n");
    Args a{};
    for (int i = 0; i < 27; ++i) a.in[i] = d_in[i];
    a.out = (float*)d_out;
    a.ws = (unsigned char*)d_ws;
    void* kargs[] = {&a};
    hipError_t e = hipLaunchCooperativeKernel((const void*)fwd_megakernel, dim3(grid_blocks), dim3(NTHREADS), kargs, LDS_BYTES, stream);
    if (e != hipSuccess) fprintf(stderr, "cooperative launch failed: %s (grid %d)\n", hipGetErrorString(e), grid_blocks);
}
```

```cpp
#include <hip/hip_runtime.h>
#include <cstdint>
#include <cstdio>
namespace pg8 {
#define PG8_LAS __attribute__((address_space(3)))
typedef unsigned short bf16_t;
typedef short bf16x8 __attribute__((ext_vector_type(8)));
typedef float f32x4 __attribute__((ext_vector_type(4)));
typedef unsigned u32x4 __attribute__((ext_vector_type(4)));
constexpr int BM = 256, BK = 64, HALF = 128, HTB = HALF * BK * 2  , STAGE_BYTES = 8 * HTB, NXCD = 8, WGM = 8;

__host__ __device__ __forceinline__ int lds_byte(int r, int c) { const int st = (r >> 4) * 2 + (c >> 5), rr = r & 15, cc = c & 31, ob = rr * 64 + cc * 2; return st * 1024 + (ob ^ (((ob >> 9) & 1) << 5)); }
__host__ __device__ __forceinline__ void stage_rc(int b, int& R, int& C) { const int st = b / 1024, sb = b % 1024, swz = sb ^ (((sb >> 9) & 1) << 5); R = (st >> 1) * 16 + swz / 64; C = (st & 1) * 32 + (swz % 64) / 2; }
__host__ __device__ __forceinline__ int perm32(int rho) { const int n = rho >> 4, i = rho & 15; return 8 * (i >> 2) + 4 * n + (i & 3); }

struct Unit { int pm, pn; };
struct Gemm { const bf16_t* A; const bf16_t* Bt; int M, N, K; };

struct StaticOrder {
    int nM, nN, nwg, G, c;
    __host__ __device__ void init(int M, int N, int G_, int c_) { nM = M / BM; nN = N / BM; nwg = nM * nN; G = G_; c = c_; }
    __host__ __device__ bool next(int i, Unit& u) const {
        const long L = (long)i * G + c; if (L >= nwg) return false;
        int wgid = (int)L; { const int q = nwg / NXCD, r = nwg % NXCD, xcd = wgid % NXCD, off = wgid / NXCD; wgid = (xcd < r ? xcd * (q + 1) : r * (q + 1) + (xcd - r) * q) + off; }
        const int nig = WGM * nN, gid = wgid / nig, fm = gid * WGM, gsz = (nM - fm) < WGM ? (nM - fm) : WGM;
        u.pm = fm + ((wgid % nig) % gsz); u.pn = (wgid % nig) / gsz; return true;
    }
    __device__ __forceinline__ void a_ready(const Unit&) const {}
    __device__ __forceinline__ void done(const Unit&) const {}
};

__device__ __forceinline__ unsigned cvt_pk_bf16(float lo, float hi) { unsigned r; asm volatile("v_cvt_pk_bf16_f32 %0, %1, %2" : "=v"(r) : "v"(lo), "v"(hi)); return r; }
typedef float f32x2 __attribute__((ext_vector_type(2)));
__device__ __forceinline__ f32x2 gelu_pk(f32x2 v) {
    const f32x2 av = __builtin_elementwise_abs(v), d = av * 0.2316418882f + 1.0f;
    f32x2 t; t.x = __builtin_amdgcn_rcpf(d.x); t.y = __builtin_amdgcn_rcpf(d.y);
    f32x2 q = t * 0.5307027145f + (-0.7265760135f); q = q * t + 0.7107068705f; q = q * t + (-0.142248368f); q = q * t + 0.127414796f; q = q * t;
    const f32x2 s = (v * v) * (-0.72134752044f);
    f32x2 e; e.x = __builtin_amdgcn_exp2f(s.x); e.y = __builtin_amdgcn_exp2f(s.y);
    const f32x2 m = v * (q * e), r = v - m;
    f32x2 o; o.x = v.x < 0.f ? m.x : r.x; o.y = v.y < 0.f ? m.y : r.y; return o;
}

template <int ACT  > struct EpiBf16 {
    static constexpr bool PERM = true, AFTER_DRAIN = false; static_assert(ACT == 0 || ACT == 1, "EpiBf16: ACT is 0 (none) or 1 (gelu_pk)");
    bf16_t* O; int ldc; const float* bias; int split_cols; size_t split_stride; float scale0;
    __device__ __forceinline__ void operator()(const f32x4 (&acc)[2][2][4][2], const Unit& u, int wr, int wc, int fr, int fq) const {
        const int row0 = u.pm * BM + wr * 64 + fr; int colt = u.pn * BM; bf16_t* base = O;
        float sc = 1.f; if (split_cols) { const int t = colt / split_cols; base += (size_t)t * split_stride; colt -= t * split_cols; if (t == 0) sc = scale0; }
        const int col0 = colt + wc * 32 + 8 * fq, bcol0 = u.pn * BM + wc * 32 + 8 * fq;
        f32x4 bv[2][2];
#pragma unroll
        for (int bj = 0; bj < 2; ++bj)
#pragma unroll
            for (int n = 0; n < 2; ++n) bv[bj][n] = bias ? *(const f32x4*)(bias + bcol0 + bj * HALF + 4 * n) : (f32x4){0.f, 0.f, 0.f, 0.f};
#pragma unroll
        for (int ai = 0; ai < 2; ++ai)
#pragma unroll
            for (int m = 0; m < 4; ++m) { bf16_t* rowp = base + (size_t)(row0 + ai * HALF + m * 16) * ldc + col0;
#pragma unroll
                for (int bj = 0; bj < 2; ++bj) { f32x4 v0 = acc[ai][bj][m][0] + bv[bj][0], v1 = acc[ai][bj][m][1] + bv[bj][1];
                    if (ACT == 1) { f32x2 a = gelu_pk((f32x2){v0[0], v0[1]}), b = gelu_pk((f32x2){v0[2], v0[3]}), c = gelu_pk((f32x2){v1[0], v1[1]}), d = gelu_pk((f32x2){v1[2], v1[3]});
                        v0 = (f32x4){a.x, a.y, b.x, b.y}; v1 = (f32x4){c.x, c.y, d.x, d.y}; }
                    v0 = v0 * sc; v1 = v1 * sc; u32x4 w; w.x = cvt_pk_bf16(v0[0], v0[1]); w.y = cvt_pk_bf16(v0[2], v0[3]); w.z = cvt_pk_bf16(v1[0], v1[1]); w.w = cvt_pk_bf16(v1[2], v1[3]);
                    *(u32x4*)(rowp + bj * HALF) = w; } }
    }
};

struct PanelStats {
    unsigned* xbuf;
    unsigned* cnt;
    unsigned* tmo;
    int ntn; float eps;
    unsigned code;
    __device__ __forceinline__ bool run(const f32x4 (&v)[2][2][4][2], const Unit& u, int wr, int wc, int fr, int fq, PG8_LAS unsigned char* lds, int wid, int lane) const {
        typedef float f32x2v __attribute__((ext_vector_type(2)));
        PG8_LAS f32x2v* P = (PG8_LAS f32x2v*)lds;
        PG8_LAS f32x2v* S = (PG8_LAS f32x2v*)(lds + 8192);
        PG8_LAS unsigned* flag = (PG8_LAS unsigned*)(lds + 8192 + 2048);
#pragma unroll
        for (int ai = 0; ai < 2; ++ai)
#pragma unroll
            for (int m = 0; m < 4; ++m) {
                float s = 0.f;
#pragma unroll
                for (int bj = 0; bj < 2; ++bj)
#pragma unroll
                    for (int n = 0; n < 2; ++n) { const f32x4 x = v[ai][bj][m][n]; s += (x[0] + x[1]) + (x[2] + x[3]); }
                s += __shfl_xor(s, 16); s += __shfl_xor(s, 32);
                const float mw = s * (1.0f / 64.0f); float q = 0.f;
#pragma unroll
                for (int bj = 0; bj < 2; ++bj)
#pragma unroll
                    for (int n = 0; n < 2; ++n) { const f32x4 d = v[ai][bj][m][n] - mw; q += (d[0] * d[0] + d[1] * d[1]) + (d[2] * d[2] + d[3] * d[3]); }
                q += __shfl_xor(q, 16); q += __shfl_xor(q, 32);
                if (fq == 0) P[(ai * HALF + wr * 64 + m * 16 + fr) * 4 + wc] = (f32x2v){mw, q};
            }
        asm volatile("s_waitcnt lgkmcnt(0)" ::: "memory"); __builtin_amdgcn_s_barrier(); asm volatile("" ::: "memory");
#if defined(BROKEN_EXCHANGE_NO_WAIT)
#warning BROKEN CONTROL BUILD: the row-statistics exchange does not wait; results are wrong by design
        if (blockIdx.x >= 64) { const long long t0_ = clock64(); while (clock64() - t0_ < 60000) __builtin_amdgcn_s_sleep(8); }
#endif
        const int row = wid * 32 + (lane & 31);
        if (lane < 32) {
            const f32x2v a = P[row * 4 + 0], b = P[row * 4 + 1], c = P[row * 4 + 2], d = P[row * 4 + 3];
            const float mt = (a.x + b.x + c.x + d.x) * 0.25f;
            const float da = a.x - mt, db = b.x - mt, dc = c.x - mt, dd = d.x - mt;
            const float m2 = (a.y + b.y) + (c.y + d.y) + 64.0f * ((da * da + db * db) + (dc * dc + dd * dd));
            unsigned long long* slot = (unsigned long long*)xbuf + ((size_t)(u.pm * BM + row) * 4 + u.pn);
            __hip_atomic_store(slot, ((unsigned long long)__float_as_uint(m2) << 32) | __float_as_uint(mt), __ATOMIC_RELAXED, __HIP_MEMORY_SCOPE_AGENT);
        }
        asm volatile("s_waitcnt vmcnt(0)" ::: "memory");
        if (lane == 0) __hip_atomic_fetch_add(cnt + 64 * u.pm, 1u, __ATOMIC_RELAXED, __HIP_MEMORY_SCOPE_AGENT);
        if (wid == 0) {
            bool dead = false; const unsigned long long t0 = __builtin_amdgcn_s_memrealtime(); const unsigned want = 8u * (unsigned)ntn;
            for (;;) {
#if defined(BROKEN_EXCHANGE_NO_WAIT)
                break;
#endif
                if ((unsigned)__builtin_amdgcn_readfirstlane(__hip_atomic_load(cnt + 64 * u.pm, __ATOMIC_RELAXED, __HIP_MEMORY_SCOPE_AGENT)) >= want) break;
                if (__builtin_amdgcn_s_memrealtime() - t0 > 2000000ull) {
                    if (lane == 0) { unsigned expect = 0u; __hip_atomic_compare_exchange_strong(tmo + 1, &expect, code | (unsigned)(u.pm & 0xff), __ATOMIC_RELAXED, __ATOMIC_RELAXED, __HIP_MEMORY_SCOPE_AGENT);
                                     __hip_atomic_store(tmo, 1u, __ATOMIC_RELAXED, __HIP_MEMORY_SCOPE_AGENT); }
                    dead = true; break; }
                __builtin_amdgcn_s_sleep(2);
            }
            __builtin_amdgcn_fence(__ATOMIC_ACQUIRE, "agent");
            if (lane == 0) flag[0] = dead ? 1u : 0u;
        }
        asm volatile("s_waitcnt vmcnt(0) lgkmcnt(0)" ::: "memory"); __builtin_amdgcn_s_barrier(); asm volatile("" ::: "memory");
        const bool bad = flag[0] != 0u;
        if (lane < 32) {
            const unsigned long long* slot = (const unsigned long long*)xbuf + (size_t)(u.pm * BM + row) * 4; float mt[4], m2[4]; float ms = 0.f;
#pragma unroll
            for (int t = 0; t < 4; ++t) { if (t < ntn) { const unsigned long long w = __hip_atomic_load(slot + t, __ATOMIC_RELAXED, __HIP_MEMORY_SCOPE_AGENT); mt[t] = __uint_as_float((unsigned)w); m2[t] = __uint_as_float((unsigned)(w >> 32)); } else { mt[t] = 0.f; m2[t] = 0.f; } ms += mt[t]; }
            const float mean = ms / (float)ntn; float q = 0.f;
#pragma unroll
            for (int t = 0; t < 4; ++t) if (t < ntn) { const float dm = mt[t] - mean; q += m2[t] + 256.0f * dm * dm; }
            S[row] = (f32x2v){mean, 1.0f / sqrtf(q / (256.0f * (float)ntn) + eps)};
        }
        asm volatile("s_waitcnt lgkmcnt(0)" ::: "memory"); __builtin_amdgcn_s_barrier(); asm volatile("" ::: "memory");
        return bad;
    }
};
struct EpiLnRes {
    static constexpr bool PERM = false, AFTER_DRAIN = true;
    const float* base; float* out; int ldc; const float* bias; PanelStats st; unsigned poison;
    __device__ __forceinline__ void fused(f32x4 (&acc)[2][2][4][2], const Unit& u, int wr, int wc, int fr, int fq, PG8_LAS unsigned char* lds, int wid, int lane) const {
        typedef float f32x2v __attribute__((ext_vector_type(2)));
        const PG8_LAS f32x2v* S = (const PG8_LAS f32x2v*)(lds + 8192);
        const int col0 = u.pn * BM + wc * 32 + 4 * fq;
#pragma unroll
        for (int bj = 0; bj < 2; ++bj)
#pragma unroll
            for (int n = 0; n < 2; ++n) { const f32x4 bv = bias ? *(const f32x4*)(bias + col0 + bj * HALF + n * 16) : (f32x4){0.f, 0.f, 0.f, 0.f};
#pragma unroll
                for (int ai = 0; ai < 2; ++ai)
#pragma unroll
                    for (int m = 0; m < 4; ++m) acc[ai][bj][m][n] += bv; }
        f32x4 pre[4][2][2];
#pragma unroll
        for (int m = 0; m < 4; ++m) { const size_t off = (size_t)(u.pm * BM + wr * 64 + m * 16 + fr) * ldc + col0;
#pragma unroll
            for (int bj = 0; bj < 2; ++bj)
#pragma unroll
                for (int n = 0; n < 2; ++n) pre[m][bj][n] = *(const f32x4*)(base + off + bj * HALF + n * 16); }
        const bool bad = st.run(acc, u, wr, wc, fr, fq, lds, wid, lane) || poison != 0u;
        const float qnan = __builtin_nanf("");
#pragma unroll
        for (int ai = 0; ai < 2; ++ai)
#pragma unroll
            for (int m = 0; m < 4; ++m) { const int r = ai * HALF + wr * 64 + m * 16 + fr; const f32x2v sr = S[r]; const size_t off = (size_t)(u.pm * BM + r) * ldc + col0;
#pragma unroll
                for (int bj = 0; bj < 2; ++bj)
#pragma unroll
                    for (int n = 0; n < 2; ++n) { const f32x4 bs = ai == 0 ? pre[m][bj][n] : *(const f32x4*)(base + off + bj * HALF + n * 16); f32x4 o = bs + (acc[ai][bj][m][n] - sr.x) * sr.y;
                        if (bad) o = (f32x4){qnan, qnan, qnan, qnan}; *(f32x4*)(out + off + bj * HALF + n * 16) = o; }
                if (m & 1) asm volatile("" ::: "memory"); }
    }
};
struct EpiLnResLn {
    static constexpr bool PERM = false, AFTER_DRAIN = true;
    const float* base; float* out; bf16_t* xn; int ldc; const float* bias; PanelStats st1, st2; unsigned poison;
    __device__ __forceinline__ void fused(f32x4 (&acc)[2][2][4][2], const Unit& u, int wr, int wc, int fr, int fq, PG8_LAS unsigned char* lds, int wid, int lane) const {
        typedef float f32x2v __attribute__((ext_vector_type(2))); typedef unsigned u32x2v __attribute__((ext_vector_type(2)));
        const PG8_LAS f32x2v* S = (const PG8_LAS f32x2v*)(lds + 8192);
        const int col0 = u.pn * BM + wc * 32 + 4 * fq;
#pragma unroll
        for (int bj = 0; bj < 2; ++bj)
#pragma unroll
            for (int n = 0; n < 2; ++n) { const f32x4 bv = bias ? *(const f32x4*)(bias + col0 + bj * HALF + n * 16) : (f32x4){0.f, 0.f, 0.f, 0.f};
#pragma unroll
                for (int ai = 0; ai < 2; ++ai)
#pragma unroll
                    for (int m = 0; m < 4; ++m) acc[ai][bj][m][n] += bv; }
        bool bad = st1.run(acc, u, wr, wc, fr, fq, lds, wid, lane) || poison != 0u;
        const float qnan = __builtin_nanf("");
#pragma unroll
        for (int ai = 0; ai < 2; ++ai)
#pragma unroll
            for (int m = 0; m < 4; ++m) { const int r = ai * HALF + wr * 64 + m * 16 + fr; const f32x2v sr = S[r]; const size_t off = (size_t)(u.pm * BM + r) * ldc + col0;
#pragma unroll
                for (int bj = 0; bj < 2; ++bj)
#pragma unroll
                    for (int n = 0; n < 2; ++n) { const f32x4 bs = *(const f32x4*)(base + off + bj * HALF + n * 16); acc[ai][bj][m][n] = bs + (acc[ai][bj][m][n] - sr.x) * sr.y; }
                asm volatile("" : "+v"(acc[ai][0][m][0]), "+v"(acc[ai][0][m][1]), "+v"(acc[ai][1][m][0]), "+v"(acc[ai][1][m][1]));
                if (m & 1) asm volatile("" ::: "memory"); }
        const bool bad1 = bad;
        bad = st2.run(acc, u, wr, wc, fr, fq, lds, wid, lane) || bad;
#pragma unroll
        for (int ai = 0; ai < 2; ++ai)
#pragma unroll
            for (int m = 0; m < 4; ++m) { const int r = ai * HALF + wr * 64 + m * 16 + fr; const f32x2v sr = S[r]; const size_t off = (size_t)(u.pm * BM + r) * ldc + col0;
#pragma unroll
                for (int bj = 0; bj < 2; ++bj)
#pragma unroll
                    for (int n = 0; n < 2; ++n) { const f32x4 x1 = acc[ai][bj][m][n]; *(f32x4*)(out + off + bj * HALF + n * 16) = bad1 ? (f32x4){qnan, qnan, qnan, qnan} : x1;
                        const f32x4 o = (x1 - sr.x) * sr.y; u32x2v w; w.x = cvt_pk_bf16(o[0], o[1]); w.y = cvt_pk_bf16(o[2], o[3]);
                        if (bad) { w.x = 0x7fc07fc0u; w.y = 0x7fc07fc0u; } *(u32x2v*)(xn + off + bj * HALF + n * 16) = w; }
                asm volatile("" ::: "memory"); }
    }
};

template <class Epi, class Sched, bool ALIGN_EPI = false, bool SP2 = false>
__device__ __forceinline__ void gemm_phase(PG8_LAS unsigned char* lds, const Gemm g, const Sched& S, const Epi& E) {
    int tid_ = threadIdx.x; asm volatile("" : "+v"(tid_));
    const int tid = tid_, wid = __builtin_amdgcn_readfirstlane(tid >> 6), lane = tid & 63, wr = wid >> 2, wc = wid & 3, fr = lane & 15, fq = lane >> 4;
    const int K = g.K, nt = K / BK;
    unsigned voffA[2], voffB[2];
#pragma unroll
    for (int i = 0; i < 2; ++i) { int R, C; stage_rc(tid * 16 + i * 8192, R, C); const int Rb = Epi::PERM ? ((R & ~31) + perm32(R & 31)) : R;
        voffA[i] = (unsigned)(R * K + C) * 2u; voffB[i] = (unsigned)(Rb * K + C) * 2u; }
    const size_t kstep = (size_t)(BK * 2);
    const size_t hstep = (size_t)HALF * K * 2;
    const size_t tstep = 2 * hstep;
    const unsigned ldsw = (unsigned)wid * 1024u;
    const int aoff = lds_byte(wr * 64 + fr, fq * 8), boff = lds_byte(wc * 32 + fr, fq * 8);
#define PG8_SA(b, h) (((b) * 2 + (h)) * HTB)
#define PG8_SB(b, h) ((4 + (b) * 2 + (h)) * HTB)
#define PG8_STAGE(bufoff, gbase, voff) do { _Pragma("unroll") for (int _i = 0; _i < 2; ++_i) \
        __builtin_amdgcn_global_load_lds((const unsigned*)((const char*)(gbase) + (voff)[_i]), (PG8_LAS unsigned*)(lds + (bufoff) + ldsw + _i * 8192), 16, 0, 0); } while (0)
#define PG8_LDA(dst, b, h) do { _Pragma("unroll") for (int m = 0; m < 4; ++m) _Pragma("unroll") for (int k = 0; k < 2; ++k) dst[m][k] = *(const PG8_LAS bf16x8*)(lds + PG8_SA(b, h) + aoff + m * 2048 + k * 1024); } while (0)
#define PG8_LDB(dst, b, h) do { _Pragma("unroll") for (int n = 0; n < 2; ++n) _Pragma("unroll") for (int k = 0; k < 2; ++k) dst[n][k] = *(const PG8_LAS bf16x8*)(lds + PG8_SB(b, h) + boff + n * 2048 + k * 1024); } while (0)
#define PG8_MMA(ai, bj, At, Bt) do { __builtin_amdgcn_s_setprio(1); _Pragma("unroll") for (int m = 0; m < 4; ++m) _Pragma("unroll") for (int n = 0; n < 2; ++n) _Pragma("unroll") for (int k = 0; k < 2; ++k) \
        acc[ai][bj][m][n] = __builtin_amdgcn_mfma_f32_16x16x32_bf16(Bt[n][k], At[m][k], acc[ai][bj][m][n], 0, 0, 0); __builtin_amdgcn_s_setprio(0); } while (0)
#define PG8_WAIT_V(n) asm volatile("s_waitcnt vmcnt(" #n ")" ::: "memory")
#define PG8_WAIT_L(n) asm volatile("s_waitcnt lgkmcnt(" #n ")" ::: "memory")
#define PG8_BAR __builtin_amdgcn_s_barrier()
#define PG8_SCHED __builtin_amdgcn_sched_barrier(0)
    Unit cur, nxt; int ui = 0;
    if (!S.next(0, cur)) return;
    f32x4 acc[2][2][4][2];
#pragma unroll
    for (int a = 0; a < 2; ++a)
#pragma unroll
        for (int b = 0; b < 2; ++b)
#pragma unroll
            for (int m = 0; m < 4; ++m)
#pragma unroll
                for (int n = 0; n < 2; ++n) acc[a][b][m][n] = (f32x4){0.f, 0.f, 0.f, 0.f};
    bf16x8 At[4][2], B0[2][2], B1[2][2];
    const char* cA = (const char*)g.A + (size_t)cur.pm * tstep; const char* cB = (const char*)g.Bt + (size_t)cur.pn * tstep;
    S.a_ready(cur);
    if constexpr (SP2) {
        PG8_STAGE(PG8_SB(0, 0), cB, voffB); PG8_STAGE(PG8_SB(0, 1), cB + hstep, voffB); PG8_STAGE(PG8_SA(0, 0), cA, voffA); PG8_STAGE(PG8_SA(0, 1), cA + hstep, voffA);
        if (wr == 1) PG8_BAR;
        PG8_WAIT_V(2); PG8_BAR;
        PG8_STAGE(PG8_SB(1, 0), cB + kstep, voffB); PG8_STAGE(PG8_SA(1, 0), cA + kstep, voffA); PG8_STAGE(PG8_SB(1, 1), cB + hstep + kstep, voffB);
        PG8_WAIT_V(6); PG8_BAR;
    } else {
        PG8_STAGE(PG8_SB(0, 0), cB, voffB); PG8_STAGE(PG8_SA(0, 0), cA, voffA); PG8_STAGE(PG8_SB(0, 1), cB + hstep, voffB); PG8_STAGE(PG8_SA(0, 1), cA + hstep, voffA);
        if (wr == 1) PG8_BAR;
        PG8_WAIT_V(4); PG8_BAR;
        PG8_STAGE(PG8_SB(1, 0), cB + kstep, voffB); PG8_STAGE(PG8_SA(1, 0), cA + kstep, voffA); PG8_STAGE(PG8_SB(1, 1), cB + hstep + kstep, voffB);
        PG8_WAIT_V(6); PG8_BAR;
    }
    for (;;) {
        const bool has_next = S.next(ui + 1, nxt);
        const char* nA = has_next ? (const char*)g.A + (size_t)nxt.pm * tstep : cA; const char* nB = has_next ? (const char*)g.Bt + (size_t)nxt.pn * tstep : cB;
        for (int t = 0; t < nt; t += 2) {
            const bool last = (t == nt - 2);
            const char* a1 = cA + (size_t)(t + 1) * kstep;
            const char* a2 = last ? nA : cA + (size_t)(t + 2) * kstep; const char* b2 = last ? nB : cB + (size_t)(t + 2) * kstep;
            const char* a3 = a2 + kstep; const char* b3 = b2 + kstep;
            if (last && has_next) S.a_ready(nxt);
            if constexpr (SP2) {
            PG8_LDB(B0, 0, 0); PG8_LDB(B1, 0, 1); PG8_SCHED; PG8_LDA(At, 0, 0); PG8_STAGE(PG8_SA(1, 1), a1 + hstep, voffA);
            PG8_WAIT_V(8); PG8_WAIT_L(0); PG8_BAR; PG8_MMA(0, 0, At, B0); PG8_MMA(0, 1, At, B1); PG8_BAR; PG8_SCHED;
            PG8_LDA(At, 0, 1); PG8_STAGE(PG8_SB(0, 0), b2, voffB); PG8_STAGE(PG8_SB(0, 1), b2 + hstep, voffB); PG8_STAGE(PG8_SA(0, 0), a2, voffA);
            PG8_WAIT_V(8); PG8_WAIT_L(0); PG8_BAR; PG8_MMA(1, 0, At, B0); PG8_MMA(1, 1, At, B1); PG8_BAR; PG8_SCHED;
            PG8_LDB(B0, 1, 0); PG8_LDB(B1, 1, 1); PG8_SCHED; PG8_LDA(At, 1, 0); PG8_STAGE(PG8_SA(0, 1), a2 + hstep, voffA);
            PG8_WAIT_V(8); PG8_WAIT_L(0); PG8_BAR; PG8_MMA(0, 0, At, B0); PG8_MMA(0, 1, At, B1); PG8_BAR; PG8_SCHED;
            PG8_LDA(At, 1, 1); PG8_STAGE(PG8_SB(1, 0), b3, voffB); PG8_STAGE(PG8_SB(1, 1), b3 + hstep, voffB); PG8_STAGE(PG8_SA(1, 0), a3, voffA);
            PG8_WAIT_V(8); PG8_WAIT_L(0); PG8_BAR; PG8_MMA(1, 0, At, B0); PG8_MMA(1, 1, At, B1); PG8_BAR; PG8_SCHED;
            } else {
            PG8_LDB(B0, 0, 0); PG8_SCHED; PG8_LDA(At, 0, 0); PG8_STAGE(PG8_SA(1, 1), a1 + hstep, voffA);
            PG8_WAIT_L(8); PG8_BAR; PG8_WAIT_L(0); PG8_MMA(0, 0, At, B0); PG8_BAR; PG8_SCHED;
            PG8_LDB(B1, 0, 1); PG8_STAGE(PG8_SB(0, 0), b2, voffB);
            PG8_BAR; PG8_WAIT_L(0); PG8_MMA(0, 1, At, B1); PG8_BAR;
            PG8_LDA(At, 0, 1); PG8_STAGE(PG8_SA(0, 0), a2, voffA);
            PG8_BAR; PG8_WAIT_L(0); PG8_MMA(1, 0, At, B0); PG8_BAR; PG8_SCHED;
            PG8_STAGE(PG8_SB(0, 1), b2 + hstep, voffB);
            PG8_WAIT_V(6); PG8_BAR; PG8_MMA(1, 1, At, B1); PG8_BAR;
            PG8_LDB(B0, 1, 0); PG8_SCHED; PG8_LDA(At, 1, 0); PG8_STAGE(PG8_SA(0, 1), a2 + hstep, voffA);
            PG8_WAIT_L(8); PG8_BAR; PG8_WAIT_L(0); PG8_MMA(0, 0, At, B0); PG8_BAR; PG8_SCHED;
            PG8_LDB(B1, 1, 1); PG8_STAGE(PG8_SB(1, 0), b3, voffB);
            PG8_BAR; PG8_WAIT_L(0); PG8_MMA(0, 1, At, B1); PG8_BAR;
            PG8_LDA(At, 1, 1); PG8_STAGE(PG8_SA(1, 0), a3, voffA);
            PG8_BAR; PG8_WAIT_L(0); PG8_MMA(1, 0, At, B0); PG8_BAR; PG8_SCHED;
            PG8_STAGE(PG8_SB(1, 1), b3 + hstep, voffB);
            PG8_WAIT_V(6); PG8_BAR; PG8_MMA(1, 1, At, B1); PG8_BAR;
            }
        }
        if constexpr (ALIGN_EPI) { if (wr == 0) PG8_BAR; }
        if constexpr (!Epi::AFTER_DRAIN) { E(acc, cur, wr, wc, fr, fq); S.done(cur); }
        if (!has_next) break;
#pragma unroll
        for (int a = 0; a < 2; ++a)
#pragma unroll
            for (int b = 0; b < 2; ++b)
#pragma unroll
                for (int m = 0; m < 4; ++m)
#pragma unroll
                    for (int n = 0; n < 2; ++n) acc[a][b][m][n] = (f32x4){0.f, 0.f, 0.f, 0.f};
        cur = nxt; cA = nA; cB = nB; ++ui;
        if constexpr (ALIGN_EPI) { if (wr == 1) PG8_BAR; }
    }
    PG8_WAIT_V(0);
    if constexpr (!ALIGN_EPI) { if (wr == 0) PG8_BAR; }
    PG8_BAR;
    if constexpr (Epi::AFTER_DRAIN) { E.fused(acc, cur, wr, wc, fr, fq, lds, wid, lane); S.done(cur); }
#undef PG8_SA
#undef PG8_SB
#undef PG8_STAGE
#undef PG8_LDA
#undef PG8_LDB
#undef PG8_MMA
#undef PG8_WAIT_V
#undef PG8_WAIT_L
#undef PG8_BAR
#undef PG8_SCHED
}
}

#ifndef PG8_SP2
#define PG8_SP2 true
#endif
#ifndef PG8_ALIGN
#define PG8_ALIGN true
#endif

namespace {
constexpr int D_MODEL = 1024, BATCH = 2, SEQ = 8192, NTOK = BATCH * SEQ;
constexpr int AB_IN = 2560, C_IN = 1536;
constexpr int N_EXP = 16, D_FF = 512, PLE_DIM = 256;
constexpr float ALPHA = 1.4142135623730951f;
constexpr float LN_EPS = 1e-5f;
constexpr int NTHREADS = 512, NWAVES = 8;
constexpr int LDS_BYTES = 147456;
#define LAS __attribute__((address_space(3)))
#define GAS __attribute__((address_space(1)))
typedef unsigned short bf16_t;
typedef unsigned v4u __attribute__((ext_vector_type(4)));
typedef unsigned v2u __attribute__((ext_vector_type(2)));
typedef float f32x4 __attribute__((ext_vector_type(4)));

constexpr size_t MiB = 1u << 20;
constexpr size_t WS_CTL = 0;
constexpr size_t WS_W_IN = 1 * MiB, WS_W_OUTAB = 6 * MiB, WS_W_QKV = 8 * MiB, WS_W_OUTC = 11 * MiB, WS_W_PLEG = 13 * MiB, WS_W_PLEP = 17 * MiB;
constexpr size_t WS_W_GU = 18 * MiB, WS_W_DN = 50 * MiB;
constexpr size_t WS_PROJ = 66 * MiB;
constexpr size_t WS_MIX = 146 * MiB;
constexpr size_t WS_XNA = 182 * MiB, WS_XNB = 214 * MiB;
constexpr size_t WS_PP = 246 * MiB;
constexpr size_t WS_PB = 278 * MiB;
constexpr size_t WS_EIDX = 294 * MiB, WS_GATEW = 295 * MiB, WS_LIST = 296 * MiB, WS_POS = 297 * MiB;
constexpr size_t WS_LRUSUM = 298 * MiB, WS_LRUW = 299 * MiB;
constexpr size_t WS_ROPE = 300 * MiB;
constexpr size_t WS_WRT = 304 * MiB;
constexpr size_t WS_END = 305 * MiB;
constexpr size_t WS_XS = WS_PROJ;
constexpr size_t WS_H = WS_MIX;
constexpr int MISC_OFF = 131072;
constexpr int CW_CNT = 64;

__device__ __forceinline__ float softplusf(float z) { return fmaxf(z, 0.f) + log1pf(expf(-fabsf(z))); }
__device__ __forceinline__ float sigmoidf_(float z) { return 1.f / (1.f + expf(-z)); }
__device__ __forceinline__ float wave_sum(float v) {
#pragma unroll
    for (int o = 1; o < 64; o <<= 1) v += __shfl_xor(v, o);
    return v;
}
__device__ __forceinline__ float gelu_tanh(float x) {
    const float c = 0.7978845608028654f;
    return 0.5f * x * (1.f + tanhf(c * (x + 0.044715f * x * x * x)));
}
__device__ __forceinline__ unsigned f2bf(float f) { unsigned u = __builtin_bit_cast(unsigned, f); return (u + 0x7fffu + ((u >> 16) & 1u)) >> 16; }
__device__ __forceinline__ unsigned pk2(float lo, float hi) { return f2bf(lo) | (f2bf(hi) << 16); }
__device__ __forceinline__ float bf2f(bf16_t v) { return __uint_as_float((unsigned)v << 16); }
__device__ __forceinline__ float bflo(unsigned w) { return __uint_as_float(w << 16); }
__device__ __forceinline__ float bfhi(unsigned w) { return __uint_as_float(w & 0xffff0000u); }
template <class T> __device__ __forceinline__ T* lnd(T* p) { asm volatile("" : "+s"(p)); return p; }
__device__ __forceinline__ int tid_opaque() { int t = threadIdx.x; asm volatile("" : "+v"(t)); return t; }
__device__ __forceinline__ int bid_opaque() { int t = blockIdx.x; asm volatile("" : "+s"(t)); return t; }
typedef short bf16x8 __attribute__((ext_vector_type(8)));
#define MFMA16(a, b, c) __builtin_amdgcn_mfma_f32_16x16x32_bf16((a), (b), (c), 0, 0, 0)
#define XB_TMO      128
#define XB_XCNT(j)  (256  + 64 * (j))
#define XB_XSUB(j)  (1280 + 64 * (j))
#define XB_XGEN(j)  (2304 + 64 * (j))
#define XB_TOP      3328
#define XB_TOPGEN   3392
#define XCD_BAR_WORDS 3456
#define XB_SPIN_CAP (1u << 18)

__device__ __forceinline__ unsigned xb_ld(unsigned* p)              { return __hip_atomic_load(p, __ATOMIC_RELAXED, __HIP_MEMORY_SCOPE_AGENT); }
__device__ __forceinline__ unsigned xb_add(unsigned* p, unsigned v) { return __hip_atomic_fetch_add(p, v, __ATOMIC_RELAXED, __HIP_MEMORY_SCOPE_AGENT); }
__device__ __forceinline__ unsigned xb_xcc_id() { return (unsigned)__builtin_amdgcn_s_getreg((3 << 11) | 20) & 0xFu; }
#define XB_SPIN(cond, bar) do { unsigned _sp = 0; while (cond) { __builtin_amdgcn_s_sleep(1); \
    if ((++_sp & 255u) == 0u) { if (xb_ld(&(bar)[XB_TMO])) break; if (_sp > XB_SPIN_CAP) { atomicAdd(&(bar)[XB_TMO], 1u); break; } } } } while (0)

struct XcdBarrier {
    unsigned* bar; unsigned x;
    volatile LAS unsigned* st;
};

__device__ __forceinline__ XcdBarrier xcd_barrier_post(unsigned* bar, volatile LAS unsigned* st) {
    XcdBarrier b; b.bar = bar; b.x = xb_xcc_id(); b.st = st;
    if (threadIdx.x == 0) (void)xb_add(&bar[XB_XCNT(b.x)], 1u);
    return b;
}
__device__ __forceinline__ void xcd_barrier_complete(unsigned* bar, unsigned x, unsigned& nloc, unsigned& nx) {
    const unsigned G = gridDim.x * gridDim.y * gridDim.z;
    unsigned sum, cnt, mine, sp = 0u;
    for (;;) {
        sum = 0u; cnt = 0u; mine = 0u;
#pragma unroll
        for (unsigned j = 0; j < 16; ++j) { const unsigned c = xb_ld(&bar[XB_XCNT(j)]); sum += c; cnt += (c > 0u) ? 1u : 0u; mine = (j == x) ? c : mine; }
        if (sum == G) break;
        __builtin_amdgcn_s_sleep(1);
        if ((++sp & 255u) == 0u) { if (xb_ld(&bar[XB_TMO])) break; if (sp > XB_SPIN_CAP) { atomicAdd(&bar[XB_TMO], 1u); break; } }
    }
    nloc = mine > 0u ? mine : 1u; nx = cnt > 0u ? cnt : 1u;
}

__device__ __forceinline__ void xcd_barrier(const XcdBarrier& b) {
    asm volatile("s_waitcnt vmcnt(0)" ::: "memory");
    __syncthreads();
    if (threadIdx.x == 0) {
        unsigned* bar = b.bar;
        __builtin_amdgcn_s_waitcnt(0);
        unsigned nloc = b.st[0], nx = b.st[1];
        if (nloc == 0u) { xcd_barrier_complete(bar, b.x, nloc, nx); b.st[0] = nloc; b.st[1] = nx; }
        const unsigned old = xb_add(&bar[XB_XSUB(b.x)], 1u);
        const unsigned gen = old / nloc;
        if (old + 1u == (gen + 1u) * nloc) {
            __builtin_amdgcn_fence(__ATOMIC_RELEASE, "agent");
            asm volatile("s_waitcnt vmcnt(0)" ::: "memory");
            const unsigned og = xb_add(&bar[XB_TOP], 1u);
            const unsigned tg = og / nx;
            if (og + 1u == (tg + 1u) * nx) xb_add(&bar[XB_TOPGEN], 1u);
            else XB_SPIN(xb_ld(&bar[XB_TOPGEN]) == tg, bar);
            __builtin_amdgcn_fence(__ATOMIC_ACQUIRE, "agent");
            xb_add(&bar[XB_XGEN(b.x)], 1u);
            asm volatile("s_waitcnt vmcnt(0)" ::: "memory");
        } else {
            XB_SPIN(xb_ld(&bar[XB_XGEN(b.x)]) == gen, bar);
            __builtin_amdgcn_fence(__ATOMIC_ACQUIRE, "agent");
            asm volatile("s_waitcnt vmcnt(0)" ::: "memory");
        }
    }
    __syncthreads();
}

constexpr int CW_BAR = 4096;
constexpr int CTL_ZERO_BYTES = 32768;
constexpr int BARST_OFF = LDS_BYTES - 64;

struct EpiF32 {
    static constexpr bool PERM = false, AFTER_DRAIN = false;
    float* O; int ldc;
    __device__ __forceinline__ void operator()(const pg8::f32x4 (&acc)[2][2][4][2], const pg8::Unit& u, int wr, int wc, int fr, int fq) const {
        const int row0 = u.pm * 256 + wr * 64 + fr, col0 = u.pn * 256 + wc * 32 + 4 * fq;
#pragma unroll
        for (int ai = 0; ai < 2; ++ai)
#pragma unroll
            for (int m = 0; m < 4; ++m) { float* rowp = O + (size_t)(row0 + ai * 128 + m * 16) * ldc + col0;
#pragma unroll
                for (int bj = 0; bj < 2; ++bj)
#pragma unroll
                    for (int n = 0; n < 2; ++n) *(pg8::f32x4*)(rowp + bj * 128 + n * 16) = acc[ai][bj][m][n]; }
    }
};
struct EpiPle {
    static constexpr bool PERM = false, AFTER_DRAIN = false;
    float* X; const bf16_t* PP; bf16_t* XB; const float* bias;
    __device__ __forceinline__ void operator()(const pg8::f32x4 (&acc)[2][2][4][2], const pg8::Unit& u, int wr, int wc, int fr, int fq) const {
        const int row0 = u.pm * 256 + wr * 64 + fr, col0 = u.pn * 256 + wc * 32 + 4 * fq;
        pg8::f32x4 bv[2][2];
#pragma unroll
        for (int bj = 0; bj < 2; ++bj)
#pragma unroll
            for (int n = 0; n < 2; ++n) bv[bj][n] = *(const pg8::f32x4*)(bias + col0 + bj * 128 + n * 16);
#pragma unroll
        for (int ai = 0; ai < 2; ++ai)
#pragma unroll
            for (int m = 0; m < 4; ++m) { const size_t off = (size_t)(row0 + ai * 128 + m * 16) * D_MODEL + col0;
#pragma unroll
                for (int bj = 0; bj < 2; ++bj)
#pragma unroll
                    for (int n = 0; n < 2; ++n) { const size_t o = off + bj * 128 + n * 16;
                        const pg8::f32x4 x2 = *(const pg8::f32x4*)(X + o); const v2u pw = *(const v2u*)(PP + o);
                        const pg8::f32x4 z = acc[ai][bj][m][n] + bv[bj][n];
                        pg8::f32x4 r;
                        r[0] = x2[0] + bflo(pw.x) * __builtin_amdgcn_rcpf(1.f + __expf(-z[0]));
                        r[1] = x2[1] + bfhi(pw.x) * __builtin_amdgcn_rcpf(1.f + __expf(-z[1]));
                        r[2] = x2[2] + bflo(pw.y) * __builtin_amdgcn_rcpf(1.f + __expf(-z[2]));
                        r[3] = x2[3] + bfhi(pw.y) * __builtin_amdgcn_rcpf(1.f + __expf(-z[3]));
                        *(pg8::f32x4*)(X + o) = r; v2u w; w.x = pk2(r[0], r[1]); w.y = pk2(r[2], r[3]); *(v2u*)(XB + o) = w; } }
    }
};

struct EpiGU {
    static constexpr bool PERM = true, AFTER_DRAIN = false;
    bf16_t* H;
    __device__ __forceinline__ void operator()(const pg8::f32x4 (&acc)[2][2][4][2], const pg8::Unit& u, int wr, int wc, int fr, int fq) const {
        const int row0 = u.pm * 256 + wr * 64 + fr, col0 = (u.pn & 3) * 128 + wc * 32 + 8 * fq;
#pragma unroll
        for (int ai = 0; ai < 2; ++ai)
#pragma unroll
            for (int m = 0; m < 4; ++m) { bf16_t* rowp = H + (size_t)(row0 + ai * 128 + m * 16) * D_FF + col0;
                float hv[8];
#pragma unroll
                for (int n = 0; n < 2; ++n)
#pragma unroll
                    for (int j = 0; j < 4; ++j) { const float g = acc[ai][0][m][n][j], up = acc[ai][1][m][n][j]; hv[n * 4 + j] = g * __builtin_amdgcn_rcpf(1.f + __expf(-g)) * up; }
                v4u w; w.x = pk2(hv[0], hv[1]); w.y = pk2(hv[2], hv[3]); w.z = pk2(hv[4], hv[5]); w.w = pk2(hv[6], hv[7]);
                *(v4u*)rowp = w; }
    }
};
struct EpiBf16N {
    static constexpr bool PERM = true, AFTER_DRAIN = false;
    bf16_t* O; int ldc;
    __device__ __forceinline__ void operator()(const pg8::f32x4 (&acc)[2][2][4][2], const pg8::Unit& u, int wr, int wc, int fr, int fq) const {
        const int row0 = u.pm * 256 + wr * 64 + fr, col0 = (u.pn & 3) * 256 + wc * 32 + 8 * fq;
#pragma unroll
        for (int ai = 0; ai < 2; ++ai)
#pragma unroll
            for (int m = 0; m < 4; ++m) { bf16_t* rowp = O + (size_t)(row0 + ai * 128 + m * 16) * ldc + col0;
#pragma unroll
                for (int bj = 0; bj < 2; ++bj) { const pg8::f32x4 v0 = acc[ai][bj][m][0], v1 = acc[ai][bj][m][1];
                    v4u w; w.x = pk2(v0[0], v0[1]); w.y = pk2(v0[2], v0[3]); w.z = pk2(v1[0], v1[1]); w.w = pk2(v1[2], v1[3]);
                    *(v4u*)(rowp + bj * 128) = w; } }
    }
};
struct MoeOrder {
    const LAS int* tile_off;
    int G, c;
    __device__ __forceinline__ bool next(int i, pg8::Unit& u) const {
        const int T = tile_off[16];
        const int L = i * G + c; if (L >= T * 4) return false;
        const int rt = L >> 2; int e = 0;
#pragma unroll
        for (int k = 1; k < 16; ++k) e += (rt >= tile_off[k]) ? 1 : 0;
        u.pm = rt; u.pn = __builtin_amdgcn_readfirstlane(e * 4 + (L & 3)); return true;
    }
    __device__ __forceinline__ void a_ready(const pg8::Unit&) const {}
    __device__ __forceinline__ void done(const pg8::Unit&) const {}
};

typedef float f32x2_t __attribute__((ext_vector_type(2))); typedef __bf16 bf16x2_t __attribute__((ext_vector_type(2)));
__device__ __forceinline__ unsigned cvtpk(float lo, float hi) { f32x2_t v = {lo, hi}; bf16x2_t b = __builtin_convertvector(v, bf16x2_t); return __builtin_bit_cast(unsigned, b); }
__device__ __forceinline__ void tr_tile(const float* W, int K, int N, bf16_t* WT, int k0, int n0, int drow0, LAS unsigned char* scr, int lane) {
    const int c4 = lane & 15, kr = lane >> 4;
    f32x4 va[8], vb[8];
#pragma unroll
    for (int it = 0; it < 8; ++it) {
        const float* src = W + (size_t)(k0 + 8 * it + 2 * kr) * N + n0 + 4 * c4;
        va[it] = *(const f32x4*)src; vb[it] = *(const f32x4*)(src + N);
    }
    LAS unsigned* T = (LAS unsigned*)scr;
#pragma unroll
    for (int it = 0; it < 8; ++it) {
        const int kd = 4 * it + kr;
#pragma unroll
        for (int i = 0; i < 4; ++i) T[(4 * c4 + i) * 34 + kd] = cvtpk(va[it][i], vb[it][i]);
    }
    asm volatile("s_waitcnt lgkmcnt(0)" ::: "memory");
#pragma unroll
    for (int it = 0; it < 8; ++it) {
        const int id = it * 64 + lane, n = id >> 3, ch = id & 7;
        const LAS v2u* tp = (const LAS v2u*)(T + n * 34 + ch * 4);
        const v2u lo = tp[0], hi = tp[1];
        v4u o; o.x = lo.x; o.y = lo.y; o.z = hi.x; o.w = hi.y;
        *(v4u*)(WT + (size_t)(drow0 + n) * K + k0 + 8 * ch) = o;
    }
    asm volatile("s_waitcnt lgkmcnt(0)" ::: "memory");
}
__device__ __forceinline__ void tr_item(const float* W, int K, int N, bf16_t* WT, int row_off, LAS unsigned char* scr, int tile, int lane) {
    const int nblk = N / 64, kb = tile / nblk, nb = tile % nblk;
    tr_tile(W, K, N, WT, 64 * kb, 64 * nb, row_off + 64 * nb, scr, lane);
}
__device__ __forceinline__ void row1024_to_bf16(const float* xrow, bf16_t* orow, int lane) {
    const f32x4* xr = (const f32x4*)xrow + lane;
    v2u* o8 = (v2u*)orow + lane;
#pragma unroll
    for (int j = 0; j < 4; ++j) { const f32x4 v = xr[64 * j]; v2u w; w.x = pk2(v[0], v[1]); w.y = pk2(v[2], v[3]); o8[64 * j] = w; }
}

template <bool ROUTER>
__device__ __forceinline__ void ph_res_ln(const float* x, const float* h, const float* g, const float* bta, float* out, bf16_t* outb, const float* w_router,
                                          const float* b_router, int* eidx, float* gatew) {
    const int tid0 = tid_opaque(), lane = tid0 & 63, wave = tid0 >> 6;
    for (int row = bid_opaque() * 8 + wave; row < NTOK; row += gridDim.x * 8) {
        asm volatile("" ::: "memory");
        const float4* xr = (const float4*)(x + (size_t)row * D_MODEL);
        const float4* hr = (const float4*)(h + (size_t)row * D_MODEL);
        float4 v[4];
        float s = 0.f;
#pragma unroll
        for (int j = 0; j < 4; ++j) {
            const float4 a = xr[lane + 64 * j], c = hr[lane + 64 * j];
            v[j] = make_float4(ALPHA * a.x + c.x, ALPHA * a.y + c.y, ALPHA * a.z + c.z, ALPHA * a.w + c.w);
            s += (v[j].x + v[j].y) + (v[j].z + v[j].w);
        }
        const float mean = wave_sum(s) * (1.f / D_MODEL);
        float s2 = 0.f;
#pragma unroll
        for (int j = 0; j < 4; ++j) {
            v[j].x -= mean; v[j].y -= mean; v[j].z -= mean; v[j].w -= mean;
            s2 += (v[j].x * v[j].x + v[j].y * v[j].y) + (v[j].z * v[j].z + v[j].w * v[j].w);
        }
        const float rstd = 1.f / sqrtf(wave_sum(s2) * (1.f / D_MODEL) + LN_EPS);
        float4* orow = (float4*)(out + (size_t)row * D_MODEL);
        v2u* brow = (v2u*)(outb + (size_t)row * D_MODEL);
#pragma unroll
        for (int j = 0; j < 4; ++j) {
            const float4 gg = ((const float4*)g)[lane + 64 * j], bb = ((const float4*)bta)[lane + 64 * j];
            v[j] = make_float4(v[j].x * rstd * gg.x + bb.x, v[j].y * rstd * gg.y + bb.y, v[j].z * rstd * gg.z + bb.z, v[j].w * rstd * gg.w + bb.w);
            orow[lane + 64 * j] = v[j];
            v2u w; w.x = pk2(v[j].x, v[j].y); w.y = pk2(v[j].z, v[j].w); brow[lane + 64 * j] = w;
        }
        if (ROUTER) {
            float lg[16];
#pragma unroll
            for (int e = 0; e < 16; ++e) lg[e] = 0.f;
#pragma unroll
            for (int j = 0; j < 4; ++j) {
                const float xv[4] = {v[j].x, v[j].y, v[j].z, v[j].w};
#pragma unroll
                for (int k = 0; k < 4; ++k) {
                    const int d = 4 * (lane + 64 * j) + k;
                    const float4* wr = (const float4*)(w_router + d * 16);
#pragma unroll
                    for (int q4 = 0; q4 < 4; ++q4) {
                        const float4 w = wr[q4];
                        lg[q4 * 4 + 0] += xv[k] * w.x; lg[q4 * 4 + 1] += xv[k] * w.y; lg[q4 * 4 + 2] += xv[k] * w.z; lg[q4 * 4 + 3] += xv[k] * w.w;
                    }
                }
            }
#pragma unroll
            for (int e = 0; e < 16; ++e) lg[e] = wave_sum(lg[e]) + b_router[e];
            if (lane == 0) {
                float mx = lg[0];
#pragma unroll
                for (int e = 1; e < 16; ++e) mx = fmaxf(mx, lg[e]);
                float p[16], sum = 0.f;
#pragma unroll
                for (int e = 0; e < 16; ++e) { p[e] = expf(lg[e] - mx); sum += p[e]; }
                const float inv = 1.f / sum;
#pragma unroll
                for (int e = 0; e < 16; ++e) p[e] *= inv;
                int gsel = 0; float gbest = -1.f;
#pragma unroll
                for (int gq = 0; gq < 4; ++gq) {
                    float m1 = -1.f, m2 = -1.f;
#pragma unroll
                    for (int k = 0; k < 4; ++k) { const float pv = p[gq * 4 + k]; if (pv > m1) { m2 = m1; m1 = pv; } else if (pv > m2) { m2 = pv; } }
                    const float sc = m1 + m2;
                    if (sc > gbest) { gbest = sc; gsel = gq; }
                }
                float m1 = -1.f, m2 = -1.f; int i1 = 0, i2 = 0;
#pragma unroll
                for (int gq = 0; gq < 4; ++gq) {
                    if (gq == gsel) {
#pragma unroll
                        for (int k = 0; k < 4; ++k) { const float pv = p[gq * 4 + k]; if (pv > m1) { m2 = m1; i2 = i1; m1 = pv; i1 = k; } else if (pv > m2) { m2 = pv; i2 = k; } }
                    }
                }
                const float wsum = m1 + m2;
                eidx[row * 2 + 0] = gsel * 4 + i1; eidx[row * 2 + 1] = gsel * 4 + i2;
                gatew[row * 2 + 0] = m1 / wsum; gatew[row * 2 + 1] = m2 / wsum;
            }
        }
    }
}
__device__ __forceinline__ void ph_moe_naive(unsigned char* lds, const float* x, const int* eidx, const float* gatew, const float* wg, const float* wu, const float* wd, float* m) {
    float* xs = (float*)(lds + 65536);
    float* hs = (float*)(lds + 65536 + 4096);
    const int tid = tid_opaque();
    for (int tok = bid_opaque(); tok < NTOK; tok += gridDim.x) {
        __syncthreads();
        xs[tid] = x[(size_t)tok * D_MODEL + tid]; xs[tid + 512] = x[(size_t)tok * D_MODEL + tid + 512];
        float o0 = 0.f, o1 = 0.f;
        for (int kk = 0; kk < 2; ++kk) {
            const int e = eidx[tok * 2 + kk];
            const float gw = gatew[tok * 2 + kk];
            const float* wge = wg + (size_t)e * D_MODEL * D_FF;
            const float* wue = wu + (size_t)e * D_MODEL * D_FF;
            const float* wde = wd + (size_t)e * D_FF * D_MODEL;
            __syncthreads();
            float g0 = 0.f, u0 = 0.f;
#pragma unroll 4
            for (int d = 0; d < 1024; ++d) {
                const float xv = xs[d];
                g0 += xv * wge[(size_t)d * D_FF + tid];
                u0 += xv * wue[(size_t)d * D_FF + tid];
            }
            hs[tid] = g0 * sigmoidf_(g0) * u0 * gw;
            __syncthreads();
#pragma unroll 4
            for (int f = 0; f < 512; ++f) {
                const float hv = hs[f];
                o0 += hv * wde[(size_t)f * D_MODEL + tid];
                o1 += hv * wde[(size_t)f * D_MODEL + tid + 512];
            }
        }
        m[(size_t)tok * D_MODEL + tid] = o0; m[(size_t)tok * D_MODEL + tid + 512] = o1;
    }
}
__device__ __forceinline__ void ph_route(LAS unsigned char* lds, const bf16_t* x1b, const bf16_t* wrt, const float* b_router, float* gatew, unsigned* cnt, int* list) {
    const int tid = tid_opaque(), lane = tid & 63, wave = __builtin_amdgcn_readfirstlane(tid >> 6), fr = lane & 15, fq = lane >> 4;
    LAS float* part = (LAS float*)lds;
    LAS int* s_e = (LAS int*)(lds + MISC_OFF);
    LAS int* s_rank = s_e + 128;
    LAS int* s_cnt = s_rank + 128;
    LAS int* s_base = s_cnt + 16;
    for (int base = bid_opaque() * 64; base < NTOK; base += gridDim.x * 64) {
        __syncthreads();
        if (tid < 16) s_cnt[tid] = 0;
        {
            const int mt = wave & 3, kh = wave >> 2;
            f32x4 acc = (f32x4){0.f, 0.f, 0.f, 0.f};
            const bf16_t* xrow = x1b + (size_t)(base + mt * 16 + fr) * D_MODEL + kh * 512 + fq * 8;
            const bf16_t* wh = wrt + fr * 1024 + kh * 512 + fq * 8;
#pragma unroll 8
            for (int ks = 0; ks < 16; ++ks) {
                const bf16x8 a = *(const bf16x8*)(xrow + ks * 32), bh = *(const bf16x8*)(wh + ks * 32), bl = *(const bf16x8*)(wh + 16 * 1024 + ks * 32);
                acc = MFMA16(a, bh, acc); acc = MFMA16(a, bl, acc);
            }
#pragma unroll
            for (int rg = 0; rg < 4; ++rg) part[(kh * 64 + mt * 16 + fq * 4 + rg) * 16 + fr] = acc[rg];
        }
        __syncthreads();
        if (tid < 64) {
            const int row = base + tid;
            float lg[16];
#pragma unroll
            for (int q4 = 0; q4 < 4; ++q4) {
                const f32x4 p0 = *(const LAS f32x4*)(part + tid * 16 + q4 * 4), p1 = *(const LAS f32x4*)(part + (64 + tid) * 16 + q4 * 4);
                const f32x4 bb = *(const f32x4*)(b_router + q4 * 4);
                lg[q4 * 4 + 0] = p0[0] + p1[0] + bb[0]; lg[q4 * 4 + 1] = p0[1] + p1[1] + bb[1]; lg[q4 * 4 + 2] = p0[2] + p1[2] + bb[2]; lg[q4 * 4 + 3] = p0[3] + p1[3] + bb[3];
            }
            float mx = lg[0];
#pragma unroll
            for (int e = 1; e < 16; ++e) mx = fmaxf(mx, lg[e]);
            float p[16], sum = 0.f;
#pragma unroll
            for (int e = 0; e < 16; ++e) { p[e] = __expf(lg[e] - mx); sum += p[e]; }
            const float inv = 1.f / sum;
#pragma unroll
            for (int e = 0; e < 16; ++e) p[e] *= inv;
            int gsel = 0; float gbest = -1.f;
#pragma unroll
            for (int gq = 0; gq < 4; ++gq) {
                float m1 = -1.f, m2 = -1.f;
#pragma unroll
                for (int k = 0; k < 4; ++k) { const float pv = p[gq * 4 + k]; if (pv > m1) { m2 = m1; m1 = pv; } else if (pv > m2) { m2 = pv; } }
                const float sc = m1 + m2;
                if (sc > gbest) { gbest = sc; gsel = gq; }
            }
            float m1 = -1.f, m2 = -1.f; int i1 = 0, i2 = 0;
#pragma unroll
            for (int gq = 0; gq < 4; ++gq) {
                if (gq == gsel) {
#pragma unroll
                    for (int k = 0; k < 4; ++k) { const float pv = p[gq * 4 + k]; if (pv > m1) { m2 = m1; i2 = i1; m1 = pv; i1 = k; } else if (pv > m2) { m2 = pv; i2 = k; } }
                }
            }
            const int e1 = gsel * 4 + i1, e2 = gsel * 4 + i2;
            const float wsum = m1 + m2;
            gatew[row * 2 + 0] = m1 / wsum; gatew[row * 2 + 1] = m2 / wsum;
            s_e[tid * 2 + 0] = e1; s_e[tid * 2 + 1] = e2;
            s_rank[tid * 2 + 0] = __hip_atomic_fetch_add(&s_cnt[e1], 1, __ATOMIC_RELAXED, __HIP_MEMORY_SCOPE_WORKGROUP);
            s_rank[tid * 2 + 1] = __hip_atomic_fetch_add(&s_cnt[e2], 1, __ATOMIC_RELAXED, __HIP_MEMORY_SCOPE_WORKGROUP);
        }
        __syncthreads();
        if (tid < 16) s_base[tid] = (int)__hip_atomic_fetch_add(cnt + tid, (unsigned)s_cnt[tid], __ATOMIC_RELAXED, __HIP_MEMORY_SCOPE_AGENT);
        __syncthreads();
        if (tid < 128) { const int e = s_e[tid]; list[e * NTOK + s_base[e] + s_rank[tid]] = (base + (tid >> 1)) * 2 + (tid & 1); }
    }
    __syncthreads();
}
__device__ __forceinline__ void moe_offsets(LAS unsigned char* lds, const unsigned* cnt) {
    LAS int* t_off = (LAS int*)(lds + MISC_OFF + 2048);
    __syncthreads();
    if (threadIdx.x == 0) {
        int acc = 0;
        for (int e = 0; e < 16; ++e) { const int c = (int)__hip_atomic_load(cnt + e, __ATOMIC_RELAXED, __HIP_MEMORY_SCOPE_AGENT); t_off[e] = acc; t_off[32 + e] = c; acc += (c + 255) >> 8; }
        t_off[16] = acc;
    }
    __syncthreads();
}
__device__ __forceinline__ void ph_permute(LAS unsigned char* lds, const unsigned* cnt, const int* list, const bf16_t* x1b, bf16_t* xs, int* pos) {
    moe_offsets(lds, cnt);
    const LAS int* t_off = (const LAS int*)(lds + MISC_OFF + 2048);
    const int tid = tid_opaque(), lane = tid & 63, wave = tid >> 6;
    const int R = t_off[16] * 256;
    for (int r = bid_opaque() * NWAVES + wave; r < R; r += gridDim.x * NWAVES) {
        const int rt = r >> 8; int e = 0;
#pragma unroll
        for (int k = 1; k < 16; ++k) e += (rt >= t_off[k]) ? 1 : 0;
        const int i = r - t_off[e] * 256;
        if (i < t_off[32 + e]) {
            const int ent = list[e * NTOK + i], tok = ent >> 1;
            const v4u* src = (const v4u*)(x1b + (size_t)tok * D_MODEL);
            v4u* dst = (v4u*)(xs + (size_t)r * D_MODEL);
            dst[lane] = src[lane]; dst[lane + 64] = src[lane + 64];
            if (lane == 0) pos[ent] = r;
        }
    }
}
__device__ __forceinline__ void ph_combine_ln(const float* x, const bf16_t* Y, const int* pos, const float* gatew, const float* g, const float* bta, float* out, bf16_t* outb) {
    const int tid0 = tid_opaque(), lane = tid0 & 63, wave = tid0 >> 6;
    for (int row = bid_opaque() * 8 + wave; row < NTOK; row += gridDim.x * 8) {
        asm volatile("" ::: "memory");
        const int p0 = pos[row * 2], p1 = pos[row * 2 + 1];
        const float w0 = gatew[row * 2], w1 = gatew[row * 2 + 1];
        const float4* xr = (const float4*)(x + (size_t)row * D_MODEL);
        const v2u* y0 = (const v2u*)(Y + (size_t)p0 * D_MODEL);
        const v2u* y1 = (const v2u*)(Y + (size_t)p1 * D_MODEL);
        float4 v[4];
        float s = 0.f;
#pragma unroll
        for (int j = 0; j < 4; ++j) {
            const float4 a = xr[lane + 64 * j]; const v2u a0 = y0[lane + 64 * j], a1 = y1[lane + 64 * j];
            v[j] = make_float4(ALPHA * a.x + (w0 * bflo(a0.x) + w1 * bflo(a1.x)), ALPHA * a.y + (w0 * bfhi(a0.x) + w1 * bfhi(a1.x)),
                               ALPHA * a.z + (w0 * bflo(a0.y) + w1 * bflo(a1.y)), ALPHA * a.w + (w0 * bfhi(a0.y) + w1 * bfhi(a1.y)));
            s += (v[j].x + v[j].y) + (v[j].z + v[j].w);
        }
        const float mean = wave_sum(s) * (1.f / D_MODEL);
        float s2 = 0.f;
#pragma unroll
        for (int j = 0; j < 4; ++j) {
            v[j].x -= mean; v[j].y -= mean; v[j].z -= mean; v[j].w -= mean;
            s2 += (v[j].x * v[j].x + v[j].y * v[j].y) + (v[j].z * v[j].z + v[j].w * v[j].w);
        }
        const float rstd = 1.f / sqrtf(wave_sum(s2) * (1.f / D_MODEL) + LN_EPS);
        float4* orow = (float4*)(out + (size_t)row * D_MODEL);
        v2u* brow = (v2u*)(outb + (size_t)row * D_MODEL);
#pragma unroll
        for (int j = 0; j < 4; ++j) {
            const float4 gg = ((const float4*)g)[lane + 64 * j], bb = ((const float4*)bta)[lane + 64 * j];
            v[j] = make_float4(v[j].x * rstd * gg.x + bb.x, v[j].y * rstd * gg.y + bb.y, v[j].z * rstd * gg.z + bb.z, v[j].w * rstd * gg.w + bb.w);
            orow[lane + 64 * j] = v[j];
            v2u w; w.x = pk2(v[j].x, v[j].y); w.y = pk2(v[j].z, v[j].w); brow[lane + 64 * j] = w;
        }
    }
}
__device__ __forceinline__ void ph_convert_experts(LAS unsigned char* ldsl, const float* wg, const float* wu, const float* wd, bf16_t* W_GU, bf16_t* W_DN) {
    const int tid = tid_opaque(), lane = tid & 63, wave = __builtin_amdgcn_readfirstlane(tid >> 6);
    LAS unsigned char* scr = ldsl + wave * 16384;
    const int gw = bid_opaque() * NWAVES + wave, NGW = gridDim.x * NWAVES;
    for (int it = gw; it < 16 * 384; it += NGW) {
        const int e = it / 384, r = it % 384;
        if (r < 256) {
            const int bj = r >> 7, tile = r & 127, kb = tile >> 3, nb = tile & 7, n0 = 64 * nb;
            const float* W = (bj ? wu : wg) + (size_t)e * D_MODEL * D_FF;
            tr_tile(W, 1024, 512, W_GU + (size_t)e * 1024 * 1024, 64 * kb, n0, 256 * (n0 >> 7) + 128 * bj + (n0 & 127), scr, lane);
        } else {
            tr_item(wd + (size_t)e * D_FF * D_MODEL, 512, 1024, W_DN + (size_t)e * 1024 * 512, 0, scr, r - 256, lane);
        }
    }
}

#define WAVE_LDS_FENCE() asm volatile("s_waitcnt lgkmcnt(0)" ::: "memory")

constexpr int SB_KS_OFF = 0, SB_VT_OFF = 9216, SB_Z_OFF = 18432, SB_W_OFF = SB_Z_OFF + 8 * 8704, SB_FLAG_OFF = SB_W_OFF + 8 * 4608;
constexpr float SB_THR = 104.0f;
__device__ __forceinline__ void ph_sb_attn2(LAS unsigned char* lds, const bf16_t* proj, bf16_t* mix) {
    const int tid = tid_opaque(), lane = tid & 63, wave = __builtin_amdgcn_readfirstlane(tid >> 6), fr = lane & 15, fq = lane >> 4;
    LAS bf16_t* Ks = (LAS bf16_t*)(lds + SB_KS_OFF);
    LAS bf16_t* Vt = (LAS bf16_t*)(lds + SB_VT_OFF);
    LAS float* Zs = (LAS float*)(lds + SB_Z_OFF + wave * 8704);
    LAS bf16_t* Ws = (LAS bf16_t*)(lds + SB_W_OFF + wave * 4608);
    volatile LAS int* flags = (volatile LAS int*)(lds + SB_FLAG_OFF);
    const int qs = lane >> 1, hs = lane & 1;
    for (int unit = bid_opaque(); unit < BATCH * 8 * (SEQ / 256); unit += gridDim.x) {
        const int bh = unit & 15, qc = unit >> 4, b = bh >> 3, h = bh & 7, q0 = qc * 256;
        const size_t rowbase = (size_t)b * SEQ;
        bf16x8 qf[2][2];
#pragma unroll
        for (int mt = 0; mt < 2; ++mt)
#pragma unroll
            for (int ks = 0; ks < 2; ++ks) {
                const v4u raw = *(const v4u*)(proj + (rowbase + q0 + 32 * wave + mt * 16 + fr) * AB_IN + h * 64 + ks * 32 + fq * 8);
                v4u sc;
                sc.x = pk2(bflo(raw.x) * 0.125f, bfhi(raw.x) * 0.125f); sc.y = pk2(bflo(raw.y) * 0.125f, bfhi(raw.y) * 0.125f);
                sc.z = pk2(bflo(raw.z) * 0.125f, bfhi(raw.z) * 0.125f); sc.w = pk2(bflo(raw.w) * 0.125f, bfhi(raw.w) * 0.125f);
                qf[mt][ks] = __builtin_bit_cast(bf16x8, sc);
            }
        f32x4 o[2][4];
#pragma unroll
        for (int mt = 0; mt < 2; ++mt)
#pragma unroll
            for (int nt = 0; nt < 4; ++nt) o[mt][nt] = (f32x4){0.f, 0.f, 0.f, 0.f};
        float carry = 0.f;
        const int t_row = q0 + 32 * wave + qs, tmax_w = q0 + 32 * wave + 31;
        bool wave_done = false;
        for (int kt = (q0 >> 6) + 3; kt >= 0; --kt) {
            {
                const int r = tid >> 3, c = tid & 7;
                const bf16_t* rp = proj + (rowbase + kt * 64 + r) * AB_IN + h * 64 + c * 8;
                const v4u kv = *(const v4u*)(rp + 512); const v4u vv = *(const v4u*)(rp + 1024);
                *(LAS v4u*)(Ks + r * 72 + c * 8) = kv;
                LAS bf16_t* vp = Vt + (c * 8) * 72 + r;
                vp[0 * 72] = (bf16_t)(vv.x & 0xffffu); vp[1 * 72] = (bf16_t)(vv.x >> 16); vp[2 * 72] = (bf16_t)(vv.y & 0xffffu); vp[3 * 72] = (bf16_t)(vv.y >> 16);
                vp[4 * 72] = (bf16_t)(vv.z & 0xffffu); vp[5 * 72] = (bf16_t)(vv.z >> 16); vp[6 * 72] = (bf16_t)(vv.w & 0xffffu); vp[7 * 72] = (bf16_t)(vv.w >> 16);
            }
            __syncthreads();
            if (!wave_done && kt * 64 < tmax_w) {
#pragma unroll
                for (int nt = 0; nt < 4; ++nt) {
                    const bf16x8 b0 = *(const LAS bf16x8*)(Ks + (nt * 16 + fr) * 72 + fq * 8), b1 = *(const LAS bf16x8*)(Ks + (nt * 16 + fr) * 72 + 32 + fq * 8);
#pragma unroll
                    for (int mt = 0; mt < 2; ++mt) {
                        f32x4 z4 = MFMA16(qf[mt][0], b0, ((f32x4){0.f, 0.f, 0.f, 0.f}));
                        z4 = MFMA16(qf[mt][1], b1, z4);
#pragma unroll
                        for (int rg = 0; rg < 4; ++rg) Zs[(mt * 16 + fq * 4 + rg) * 68 + nt * 16 + fr] = z4[rg];
                    }
                }
                WAVE_LDS_FENCE();
                float zz[32];
#pragma unroll
                for (int k4 = 0; k4 < 8; ++k4) { const f32x4 v = *(const LAS f32x4*)(Zs + qs * 68 + hs * 32 + k4 * 4); zz[k4 * 4 + 0] = v[0]; zz[k4 * 4 + 1] = v[1]; zz[k4 * 4 + 2] = v[2]; zz[k4 * 4 + 3] = v[3]; }
                const int s0 = kt * 64 + hs * 32;
                float run = 0.f;
                float lw[32];
#pragma unroll
                for (int i = 31; i >= 0; --i) {
                    const float z = zz[i];
                    const float sp = fmaxf(z, 0.f) + __logf(1.f + __expf(-fabsf(z)));
                    const bool valid = (s0 + i) < t_row;
                    lw[i] = valid ? (z - sp - run) : -INFINITY;
                    run += valid ? sp : 0.f;
                }
                const float other = __shfl_xor(run, 1);
                const float base = carry + (hs == 0 ? other : 0.f);
                carry += run + other;
                unsigned pw[16];
#pragma unroll
                for (int i = 0; i < 32; i += 2) pw[i >> 1] = pk2(__expf(lw[i] - base), __expf(lw[i + 1] - base));
#pragma unroll
                for (int k4 = 0; k4 < 4; ++k4) { v4u w4; w4.x = pw[k4 * 4]; w4.y = pw[k4 * 4 + 1]; w4.z = pw[k4 * 4 + 2]; w4.w = pw[k4 * 4 + 3]; *(LAS v4u*)(Ws + qs * 72 + hs * 32 + k4 * 8) = w4; }
                WAVE_LDS_FENCE();
#pragma unroll
                for (int ks = 0; ks < 2; ++ks) {
                    const bf16x8 a0 = *(const LAS bf16x8*)(Ws + fr * 72 + ks * 32 + fq * 8), a1 = *(const LAS bf16x8*)(Ws + (16 + fr) * 72 + ks * 32 + fq * 8);
#pragma unroll
                    for (int nt = 0; nt < 4; ++nt) {
                        const bf16x8 bv = *(const LAS bf16x8*)(Vt + (nt * 16 + fr) * 72 + ks * 32 + fq * 8);
                        o[0][nt] = MFMA16(a0, bv, o[0][nt]); o[1][nt] = MFMA16(a1, bv, o[1][nt]);
                    }
                }
                wave_done = __all(carry > SB_THR) != 0;
            }
            if (lane == 0) flags[wave] = wave_done ? 1 : 0;
            __syncthreads();
            int nd = 0;
#pragma unroll
            for (int w8 = 0; w8 < 8; ++w8) nd += flags[w8];
            if (nd == 8) break;
        }
        WAVE_LDS_FENCE();
#pragma unroll
        for (int mt = 0; mt < 2; ++mt)
#pragma unroll
            for (int nt = 0; nt < 4; ++nt)
#pragma unroll
                for (int rg = 0; rg < 4; ++rg) Ws[(mt * 16 + fq * 4 + rg) * 72 + nt * 16 + fr] = (bf16_t)f2bf(o[mt][nt][rg]);
        WAVE_LDS_FENCE();
#pragma unroll
        for (int i = 0; i < 4; ++i) { const int id = i * 64 + lane, row = id >> 3, c = id & 7;
            *(v4u*)(mix + (rowbase + q0 + 32 * wave + row) * D_MODEL + h * 64 + c * 8) = *(const LAS v4u*)(Ws + row * 72 + c * 8); }
        __syncthreads();
    }
}

constexpr int LRU_SLOT = 17408;
template <bool FINAL>
__device__ __forceinline__ void ph_lru(LAS unsigned char* lds, const bf16_t* proj, const float* conv_w, const float* conv_b, const bf16_t* wt, const float* b_r, const float* b_i,
                                       const float* lam, float2* sum, bf16_t* mix) {
    const int tid = tid_opaque(), lane = tid & 63, wave = __builtin_amdgcn_readfirstlane(tid >> 6), fr = lane & 15, fq = lane >> 4;
    LAS bf16_t* XC = (LAS bf16_t*)(lds + wave * LRU_SLOT);
    LAS float* AUa = (LAS float*)(lds + wave * LRU_SLOT + 9216);
    LAS float* AUu = AUa + 1024;
    const int ch = wave * 64 + lane;
    const float cw0 = conv_w[ch], cw1 = conv_w[512 + ch], cw2 = conv_w[1024 + ch], cw3 = conv_w[1536 + ch], cb = conv_b[ch];
    bf16x8 wr[4][2], wi[4][2];
    float br[4], bi[4], spl[4];
#pragma unroll
    for (int nt = 0; nt < 4; ++nt) {
#pragma unroll
        for (int ks = 0; ks < 2; ++ks) {
            wr[nt][ks] = *(const bf16x8*)(wt + ((size_t)(0 * 8 + wave) * 64 + nt * 16 + fr) * 64 + ks * 32 + fq * 8);
            wi[nt][ks] = *(const bf16x8*)(wt + ((size_t)(1 * 8 + wave) * 64 + nt * 16 + fr) * 64 + ks * 32 + fq * 8);
        }
        const int cd = wave * 64 + nt * 16 + fr;
        br[nt] = b_r[cd]; bi[nt] = b_i[cd];
        const float nl = -lam[cd]; spl[nt] = fmaxf(nl, 0.f) + log1pf(expf(-fabsf(nl)));
    }
    for (int unit = bid_opaque(); unit < BATCH * (SEQ / 64); unit += gridDim.x) {
        const int b = unit >> 7, chunk = unit & 127;
        const size_t tokbase = (size_t)b * SEQ + chunk * 64;
        {
            float xm3 = 0.f, xm2 = 0.f, xm1 = 0.f;
            if (chunk > 0) { xm3 = bf2f(proj[(tokbase - 3) * AB_IN + 1536 + ch]); xm2 = bf2f(proj[(tokbase - 2) * AB_IN + 1536 + ch]); xm1 = bf2f(proj[(tokbase - 1) * AB_IN + 1536 + ch]); }
#pragma unroll 8
            for (int i = 0; i < 64; ++i) {
                const float x = bf2f(proj[(tokbase + i) * AB_IN + 1536 + ch]);
                const float y = cb + cw0 * xm3 + cw1 * xm2 + cw2 * xm1 + cw3 * x;
                XC[i * 72 + lane] = (bf16_t)f2bf(y);
                xm3 = xm2; xm2 = xm1; xm1 = x;
            }
        }
        float hst = 0.f, ap = 1.f;
        if (FINAL) {
            for (int j = 0; j < chunk; ++j) { const float2 sj = sum[(size_t)(b * 128 + j) * 512 + ch]; hst = sj.x * hst + sj.y; }
        }
        WAVE_LDS_FENCE();
#pragma unroll 1
        for (int mt = 0; mt < 4; ++mt) {
            const bf16x8 a0 = *(const LAS bf16x8*)(XC + (mt * 16 + fr) * 72 + fq * 8), a1 = *(const LAS bf16x8*)(XC + (mt * 16 + fr) * 72 + 32 + fq * 8);
#pragma unroll
            for (int nt = 0; nt < 4; ++nt) {
                f32x4 cr = MFMA16(a0, wr[nt][0], ((f32x4){0.f, 0.f, 0.f, 0.f})); cr = MFMA16(a1, wr[nt][1], cr);
                f32x4 ci = MFMA16(a0, wi[nt][0], ((f32x4){0.f, 0.f, 0.f, 0.f})); ci = MFMA16(a1, wi[nt][1], ci);
#pragma unroll
                for (int rg = 0; rg < 4; ++rg) {
                    const int tokl = fq * 4 + rg, d = nt * 16 + fr;
                    const float r = 1.f / (1.f + __expf(-(cr[rg] + br[nt]))), ig = 1.f / (1.f + __expf(-(ci[rg] + bi[nt])));
                    const float la = -8.0f * r * spl[nt];
                    const float xv = bf2f(XC[(mt * 16 + tokl) * 72 + d]);
                    AUa[tokl * 64 + d] = __expf(la);
                    AUu[tokl * 64 + d] = sqrtf(-expm1f(2.0f * la)) * (ig * xv);
                }
            }
            WAVE_LDS_FENCE();
#pragma unroll
            for (int tl = 0; tl < 16; ++tl) {
                const float a = AUa[tl * 64 + lane], u = AUu[tl * 64 + lane];
                hst = a * hst + u; ap *= a;
                if (FINAL) {
                    const size_t tok = tokbase + mt * 16 + tl;
                    const float g = bf2f(proj[tok * AB_IN + 2048 + ch]);
                    mix[tok * D_MODEL + 512 + ch] = (bf16_t)f2bf(gelu_tanh(g) * hst);
                }
            }
            WAVE_LDS_FENCE();
        }
        if (!FINAL) sum[(size_t)(b * 128 + chunk) * 512 + ch] = make_float2(ap, hst);
    }
}

constexpr int SWA_SC_OFF = SB_FLAG_OFF + 64;
__device__ __forceinline__ void ph_swa2(LAS unsigned char* lds, const bf16_t* proj, const float2* rope, const float* sinks, bf16_t* mix) {
    const int tid = tid_opaque(), lane = tid & 63, wave = __builtin_amdgcn_readfirstlane(tid >> 6), fr = lane & 15, fq = lane >> 4;
    LAS bf16_t* Ks = (LAS bf16_t*)(lds + SB_KS_OFF);
    LAS bf16_t* Vt = (LAS bf16_t*)(lds + SB_VT_OFF);
    LAS float* Zs = (LAS float*)(lds + SB_Z_OFF + wave * 8704);
    LAS bf16_t* Ws = (LAS bf16_t*)(lds + SB_W_OFF + wave * 4608);
    LAS float* SC = (LAS float*)(lds + SWA_SC_OFF + wave * 256);
    LAS float* LS = SC + 32;
    const int qs = lane >> 1, hs = lane & 1, g = wave >> 1, qh = wave & 1;
    for (int unit = bid_opaque(); unit < BATCH * 4 * (SEQ / 64); unit += gridDim.x) {
        const int bk = unit & 7, qb = unit >> 3, b = bk >> 2, kv = bk & 3, hq = kv * 4 + g, t0 = qb * 64;
        const size_t rowbase = (size_t)b * SEQ;
        bf16x8 qf[2][2];
#pragma unroll
        for (int mt = 0; mt < 2; ++mt) {
            const size_t tok = rowbase + t0 + 32 * qh + mt * 16 + fr;
            const v4u r0 = *(const v4u*)(proj + tok * C_IN + hq * 64 + fq * 8), r1 = *(const v4u*)(proj + tok * C_IN + hq * 64 + 32 + fq * 8);
            const unsigned w0[4] = {r0.x, r0.y, r0.z, r0.w}, w1[4] = {r1.x, r1.y, r1.z, r1.w};
            unsigned o0[4], o1[4];
#pragma unroll
            for (int j2 = 0; j2 < 4; ++j2) {
                const float4 cs = *(const float4*)(rope + tok * 32 + fq * 8 + j2 * 2);
                const float a0 = bflo(w0[j2]), a1 = bfhi(w0[j2]), c0 = bflo(w1[j2]), c1 = bfhi(w1[j2]);
                o0[j2] = pk2((a0 * cs.x - c0 * cs.y) * 0.125f, (a1 * cs.z - c1 * cs.w) * 0.125f);
                o1[j2] = pk2((c0 * cs.x + a0 * cs.y) * 0.125f, (c1 * cs.z + a1 * cs.w) * 0.125f);
            }
            v4u p0; p0.x = o0[0]; p0.y = o0[1]; p0.z = o0[2]; p0.w = o0[3];
            v4u p1; p1.x = o1[0]; p1.y = o1[1]; p1.z = o1[2]; p1.w = o1[3];
            qf[mt][0] = __builtin_bit_cast(bf16x8, p0); qf[mt][1] = __builtin_bit_cast(bf16x8, p1);
        }
        f32x4 o[2][4];
#pragma unroll
        for (int mt = 0; mt < 2; ++mt)
#pragma unroll
            for (int nt = 0; nt < 4; ++nt) o[mt][nt] = (f32x4){0.f, 0.f, 0.f, 0.f};
        float mrun = sinks[hq], lrun = 1.f;
        const int t_row = t0 + 32 * qh + qs;
        for (int kt = qb - 2; kt <= qb; ++kt) {
            if (kt < 0) continue;
            __syncthreads();
            {
                const int r = tid >> 3, c = tid & 7;
                const size_t tok = rowbase + kt * 64 + r;
                if (c < 4) {
                    const v4u r0 = *(const v4u*)(proj + tok * C_IN + 1024 + kv * 64 + c * 8), r1 = *(const v4u*)(proj + tok * C_IN + 1024 + kv * 64 + 32 + c * 8);
                    const unsigned w0[4] = {r0.x, r0.y, r0.z, r0.w}, w1[4] = {r1.x, r1.y, r1.z, r1.w};
                    unsigned o0[4], o1[4];
#pragma unroll
                    for (int j2 = 0; j2 < 4; ++j2) {
                        const float4 cs = *(const float4*)(rope + tok * 32 + c * 8 + j2 * 2);
                        const float a0 = bflo(w0[j2]), a1 = bfhi(w0[j2]), c0 = bflo(w1[j2]), c1 = bfhi(w1[j2]);
                        o0[j2] = pk2(a0 * cs.x - c0 * cs.y, a1 * cs.z - c1 * cs.w);
                        o1[j2] = pk2(c0 * cs.x + a0 * cs.y, c1 * cs.z + a1 * cs.w);
                    }
                    v4u p0; p0.x = o0[0]; p0.y = o0[1]; p0.z = o0[2]; p0.w = o0[3];
                    v4u p1; p1.x = o1[0]; p1.y = o1[1]; p1.z = o1[2]; p1.w = o1[3];
                    *(LAS v4u*)(Ks + r * 72 + c * 8) = p0; *(LAS v4u*)(Ks + r * 72 + 32 + c * 8) = p1;
                } else {
                    const int cc = c - 4;
                    const v4u v0 = *(const v4u*)(proj + tok * C_IN + 1280 + kv * 64 + cc * 16), v1 = *(const v4u*)(proj + tok * C_IN + 1280 + kv * 64 + cc * 16 + 8);
                    LAS bf16_t* vp = Vt + (cc * 16) * 72 + r;
                    vp[0 * 72] = (bf16_t)(v0.x & 0xffffu); vp[1 * 72] = (bf16_t)(v0.x >> 16); vp[2 * 72] = (bf16_t)(v0.y & 0xffffu); vp[3 * 72] = (bf16_t)(v0.y >> 16);
                    vp[4 * 72] = (bf16_t)(v0.z & 0xffffu); vp[5 * 72] = (bf16_t)(v0.z >> 16); vp[6 * 72] = (bf16_t)(v0.w & 0xffffu); vp[7 * 72] = (bf16_t)(v0.w >> 16);
                    vp[8 * 72] = (bf16_t)(v1.x & 0xffffu); vp[9 * 72] = (bf16_t)(v1.x >> 16); vp[10 * 72] = (bf16_t)(v1.y & 0xffffu); vp[11 * 72] = (bf16_t)(v1.y >> 16);
                    vp[12 * 72] = (bf16_t)(v1.z & 0xffffu); vp[13 * 72] = (bf16_t)(v1.z >> 16); vp[14 * 72] = (bf16_t)(v1.w & 0xffffu); vp[15 * 72] = (bf16_t)(v1.w >> 16);
                }
            }
            __syncthreads();
#pragma unroll
            for (int nt = 0; nt < 4; ++nt) {
                const bf16x8 b0 = *(const LAS bf16x8*)(Ks + (nt * 16 + fr) * 72 + fq * 8), b1 = *(const LAS bf16x8*)(Ks + (nt * 16 + fr) * 72 + 32 + fq * 8);
#pragma unroll
                for (int mt = 0; mt < 2; ++mt) {
                    f32x4 z4 = MFMA16(qf[mt][0], b0, ((f32x4){0.f, 0.f, 0.f, 0.f}));
                    z4 = MFMA16(qf[mt][1], b1, z4);
#pragma unroll
                    for (int rg = 0; rg < 4; ++rg) Zs[(mt * 16 + fq * 4 + rg) * 68 + nt * 16 + fr] = z4[rg];
                }
            }
            WAVE_LDS_FENCE();
            float zz[32];
#pragma unroll
            for (int k4 = 0; k4 < 8; ++k4) { const f32x4 v = *(const LAS f32x4*)(Zs + qs * 68 + hs * 32 + k4 * 4); zz[k4 * 4 + 0] = v[0]; zz[k4 * 4 + 1] = v[1]; zz[k4 * 4 + 2] = v[2]; zz[k4 * 4 + 3] = v[3]; }
            const int s0 = kt * 64 + hs * 32;
            float tmx = -INFINITY;
#pragma unroll
            for (int i = 0; i < 32; ++i) { const int s = s0 + i; const bool valid = (s <= t_row) && (t_row - s < 128); zz[i] = valid ? zz[i] : -INFINITY; tmx = fmaxf(tmx, zz[i]); }
            tmx = fmaxf(tmx, __shfl_xor(tmx, 1));
            const float mnew = fmaxf(mrun, tmx);
            const float scl = __expf(mrun - mnew);
            float psum = 0.f;
            unsigned pw[16];
#pragma unroll
            for (int i = 0; i < 32; i += 2) { const float p0 = __expf(zz[i] - mnew), p1 = __expf(zz[i + 1] - mnew); psum += p0 + p1; pw[i >> 1] = pk2(p0, p1); }
            psum += __shfl_xor(psum, 1);
            lrun = lrun * scl + psum; mrun = mnew;
#pragma unroll
            for (int k4 = 0; k4 < 4; ++k4) { v4u w4; w4.x = pw[k4 * 4]; w4.y = pw[k4 * 4 + 1]; w4.z = pw[k4 * 4 + 2]; w4.w = pw[k4 * 4 + 3]; *(LAS v4u*)(Ws + qs * 72 + hs * 32 + k4 * 8) = w4; }
            if (hs == 0) SC[qs] = scl;
            WAVE_LDS_FENCE();
#pragma unroll
            for (int mt = 0; mt < 2; ++mt) {
                const f32x4 sc4 = *(const LAS f32x4*)(SC + mt * 16 + fq * 4);
#pragma unroll
                for (int nt = 0; nt < 4; ++nt) { o[mt][nt][0] *= sc4[0]; o[mt][nt][1] *= sc4[1]; o[mt][nt][2] *= sc4[2]; o[mt][nt][3] *= sc4[3]; }
            }
#pragma unroll
            for (int ks = 0; ks < 2; ++ks) {
                const bf16x8 a0 = *(const LAS bf16x8*)(Ws + fr * 72 + ks * 32 + fq * 8), a1 = *(const LAS bf16x8*)(Ws + (16 + fr) * 72 + ks * 32 + fq * 8);
#pragma unroll
                for (int nt = 0; nt < 4; ++nt) {
                    const bf16x8 bv = *(const LAS bf16x8*)(Vt + (nt * 16 + fr) * 72 + ks * 32 + fq * 8);
                    o[0][nt] = MFMA16(a0, bv, o[0][nt]); o[1][nt] = MFMA16(a1, bv, o[1][nt]);
                }
            }
            WAVE_LDS_FENCE();
        }
        if (hs == 0) LS[qs] = 1.f / lrun;
        WAVE_LDS_FENCE();
#pragma unroll
        for (int mt = 0; mt < 2; ++mt) {
            const f32x4 li = *(const LAS f32x4*)(LS + mt * 16 + fq * 4);
#pragma unroll
            for (int nt = 0; nt < 4; ++nt)
#pragma unroll
                for (int rg = 0; rg < 4; ++rg) Ws[(mt * 16 + fq * 4 + rg) * 72 + nt * 16 + fr] = (bf16_t)f2bf(o[mt][nt][rg] * li[rg]);
        }
        WAVE_LDS_FENCE();
#pragma unroll
        for (int i = 0; i < 4; ++i) { const int id = i * 64 + lane, row = id >> 3, c = id & 7;
            *(v4u*)(mix + (rowbase + t0 + 32 * qh + row) * D_MODEL + hq * 64 + c * 8) = *(const LAS v4u*)(Ws + row * 72 + c * 8); }
    }
    __syncthreads();
}

struct Args {
    const void* in[27];
    float* out;
    unsigned char* ws;
};

__global__ void __launch_bounds__(NTHREADS, 2) fwd_megakernel(Args args) {
    extern __shared__ __attribute__((aligned(16))) unsigned char lds[];
    if (threadIdx.x < 16) ((LAS unsigned*)((LAS unsigned char*)lds + BARST_OFF))[threadIdx.x] = 0u;
    __syncthreads();
    const XcdBarrier xbar = xcd_barrier_post((unsigned*)(args.ws + WS_CTL) + CW_BAR, (volatile LAS unsigned*)((LAS unsigned char*)lds + BARST_OFF));
#ifndef PROBE_A
#define PROBE_A -1
#endif
#ifndef PROBE_B
#define PROBE_B -1
#endif
    constexpr bool PROBE = (PROBE_A >= 0);
    volatile LAS unsigned long long* TS = (volatile LAS unsigned long long*)((LAS unsigned char*)lds + (LDS_BYTES - 64 - 512));
    int nst = 0;
#define STAMP() do { if (PROBE && bid_opaque() == 0 && threadIdx.x == 0) TS[nst] = __builtin_amdgcn_s_memrealtime(); ++nst; } while (0)
    STAMP();
#define GRID_BAR() do { xcd_barrier(xbar); STAMP(); } while (0)
    const float* x_in = (const float*)args.in[0];
    const float* p_in = (const float*)args.in[1];
    const int* positions = (const int*)args.in[2];
    const float* w_in_ab = (const float*)args.in[3];
    const float* w_out_ab = (const float*)args.in[4];
    const float* conv_w = (const float*)args.in[5];
    const float* conv_b = (const float*)args.in[6];
    const float* lru_w_r = (const float*)args.in[7];
    const float* lru_b_r = (const float*)args.in[8];
    const float* lru_w_i = (const float*)args.in[9];
    const float* lru_b_i = (const float*)args.in[10];
    const float* lru_lambda = (const float*)args.in[11];
    const float* w_qkv_c = (const float*)args.in[12];
    const float* w_out_c = (const float*)args.in[13];
    const float* sinks_c = (const float*)args.in[14];
    const float* ln_mix_g = (const float*)args.in[15];
    const float* ln_mix_b = (const float*)args.in[16];
    const float* ln_ffn_g = (const float*)args.in[17];
    const float* ln_ffn_b = (const float*)args.in[18];
    const float* w_router = (const float*)args.in[19];
    const float* b_router = (const float*)args.in[20];
    const float* exp_w_gate = (const float*)args.in[21];
    const float* exp_w_up = (const float*)args.in[22];
    const float* exp_w_down = (const float*)args.in[23];
    const float* ple_w_proj = (const float*)args.in[24];
    const float* ple_w_gate = (const float*)args.in[25];
    const float* ple_b_gate = (const float*)args.in[26];
    float* out = args.out;
    unsigned char* ws = args.ws;
    bf16_t* W_IN = (bf16_t*)(ws + WS_W_IN); bf16_t* W_OUTAB = (bf16_t*)(ws + WS_W_OUTAB); bf16_t* W_QKV = (bf16_t*)(ws + WS_W_QKV); bf16_t* W_OUTC = (bf16_t*)(ws + WS_W_OUTC);
    bf16_t* W_PLEG = (bf16_t*)(ws + WS_W_PLEG); bf16_t* W_PLEP = (bf16_t*)(ws + WS_W_PLEP);
    bf16_t* PROJ = (bf16_t*)(ws + WS_PROJ); bf16_t* MIX = (bf16_t*)(ws + WS_MIX); bf16_t* XNA = (bf16_t*)(ws + WS_XNA); bf16_t* XNB = (bf16_t*)(ws + WS_XNB);
    bf16_t* PP = (bf16_t*)(ws + WS_PP); bf16_t* PB = (bf16_t*)(ws + WS_PB);
    int* EIDX = (int*)(ws + WS_EIDX); float* GATEW = (float*)(ws + WS_GATEW); int* LIST = (int*)(ws + WS_LIST); int* POS = (int*)(ws + WS_POS);
    unsigned* CTL = (unsigned*)(ws + WS_CTL);
    float2* ROPE = (float2*)(ws + WS_ROPE); bf16_t* WRT = (bf16_t*)(ws + WS_WRT);
    float2* LRUSUM = (float2*)(ws + WS_LRUSUM); bf16_t* LRUW = (bf16_t*)(ws + WS_LRUW);
    bf16_t* W_GU = (bf16_t*)(ws + WS_W_GU); bf16_t* W_DN = (bf16_t*)(ws + WS_W_DN); bf16_t* XS = (bf16_t*)(ws + WS_XS); bf16_t* HB = (bf16_t*)(ws + WS_H);
    float* HOUT = (float*)(ws + WS_PROJ);
    const int tid = threadIdx.x, lane = tid & 63, wave = __builtin_amdgcn_readfirstlane(tid >> 6);
    LAS unsigned char* ldsl = (LAS unsigned char*)lds;

    ph_convert_experts(ldsl, lnd(exp_w_gate), lnd(exp_w_up), lnd(exp_w_down), lnd(W_GU), lnd(W_DN));
    {
        LAS unsigned char* scr = ldsl + wave * 16384;
        const int gw = bid_opaque() * NWAVES + wave, NGW = gridDim.x * NWAVES;
        constexpr int I_IN = 16 * 40, I_SQ = 16 * 16, I_QKV = 16 * 24, I_PP = 4 * 16;
        constexpr int NITEMS = I_IN + I_SQ + I_QKV + I_SQ + 2 * I_SQ + 2 * I_PP + 16;
        for (int it = gw; it < NITEMS; it += NGW) {
            int r = it;
            if (r < I_IN) { tr_item(w_in_ab, 1024, 2560, W_IN, 0, scr, r, lane); continue; } r -= I_IN;
            if (r < I_SQ) { tr_item(w_out_ab, 1024, 1024, W_OUTAB, 0, scr, r, lane); continue; } r -= I_SQ;
            if (r < I_QKV) { tr_item(w_qkv_c, 1024, 1536, W_QKV, 0, scr, r, lane); continue; } r -= I_QKV;
            if (r < I_SQ) { tr_item(w_out_c, 1024, 1024, W_OUTC, 0, scr, r, lane); continue; } r -= I_SQ;
            if (r < I_SQ) { tr_item(ple_w_gate, 1024, 1024, W_PLEG, 0, scr, r, lane); continue; } r -= I_SQ;
            if (r < I_SQ) { tr_item(ple_w_gate + (size_t)1024 * 1024, 1024, 1024, W_PLEG + (size_t)1024 * 1024, 0, scr, r, lane); continue; } r -= I_SQ;
            if (r < I_PP) { tr_item(ple_w_proj, 256, 1024, W_PLEP, 0, scr, r, lane); continue; } r -= I_PP;
            if (r < I_PP) { tr_item(ple_w_proj + (size_t)256 * 1024, 256, 1024, W_PLEP + (size_t)1024 * 256, 0, scr, r, lane); continue; } r -= I_PP;
            {
                const float* src = (r < 8 ? lru_w_r + r * 4096 : lru_w_i + (r - 8) * 4096);
                tr_item(src, 64, 64, LRUW + (size_t)r * 4096, 0, scr, 0, lane);
            }
        }
        for (int idx = bid_opaque() * NTHREADS + tid; idx < 16 * 1024; idx += gridDim.x * NTHREADS) {
            const int e = idx >> 10, d = idx & 1023; const float w = w_router[d * 16 + e]; const unsigned hi = f2bf(w); const float rem = w - __uint_as_float(hi << 16);
            WRT[idx] = (bf16_t)hi; WRT[16 * 1024 + idx] = (bf16_t)f2bf(rem);
        }
        for (int idx = bid_opaque() * NTHREADS + tid; idx < NTOK * 32; idx += gridDim.x * NTHREADS) {
            const int i = idx & 31, tok = idx >> 5;
            const float ang = (float)positions[tok] * powf(10000.0f, -(float)i / 32.0f);
            ROPE[idx] = make_float2(cosf(ang), sinf(ang));
        }
        for (int m = gw; m < NTOK; m += NGW) row1024_to_bf16(x_in + (size_t)m * D_MODEL, XNA + (size_t)m * D_MODEL, lane);
        for (int m = gw; m < 2 * NTOK; m += NGW) {
            const f32x4 v = *((const f32x4*)(p_in + (size_t)m * PLE_DIM) + lane);
            v2u w; w.x = pk2(v[0], v[1]); w.y = pk2(v[2], v[3]);
            *((v2u*)(PB + (size_t)m * PLE_DIM) + lane) = w;
        }
    }
    GRID_BAR();

#pragma unroll
    for (int layer = 0; layer < 2; ++layer) {
        const float* xin = (layer == 0) ? x_in : out;
        if (layer == 0) {
            pg8::Gemm g{XNA, W_IN, NTOK, AB_IN, D_MODEL}; pg8::StaticOrder S; S.init(NTOK, AB_IN, (int)gridDim.x, bid_opaque());
            pg8::EpiBf16<0> E{PROJ, AB_IN, nullptr, 0, 0, 1.f};
            pg8::gemm_phase<pg8::EpiBf16<0>, pg8::StaticOrder, PG8_ALIGN, PG8_SP2>(ldsl, g, S, E);
        } else {
            pg8::Gemm g{XNA, W_QKV, NTOK, C_IN, D_MODEL}; pg8::StaticOrder S; S.init(NTOK, C_IN, (int)gridDim.x, bid_opaque());
            pg8::EpiBf16<0> E{PROJ, C_IN, nullptr, 0, 0, 1.f};
            pg8::gemm_phase<pg8::EpiBf16<0>, pg8::StaticOrder, PG8_ALIGN, PG8_SP2>(ldsl, g, S, E);
        }
        {
            pg8::Gemm g{PB + (size_t)layer * NTOK * PLE_DIM, W_PLEP + (size_t)layer * 1024 * 256, NTOK, D_MODEL, PLE_DIM}; pg8::StaticOrder S; S.init(NTOK, D_MODEL, (int)gridDim.x, bid_opaque());
            pg8::EpiBf16<0> E{PP, D_MODEL, nullptr, 0, 0, 1.f};
            pg8::gemm_phase<pg8::EpiBf16<0>, pg8::StaticOrder, PG8_ALIGN, PG8_SP2>(ldsl, g, S, E);
        }
        GRID_BAR();
        if (layer == 0) {
            ph_lru<false>(ldsl, lnd(PROJ), lnd(conv_w), lnd(conv_b), lnd(LRUW), lnd(lru_b_r), lnd(lru_b_i), lnd(lru_lambda), lnd(LRUSUM), lnd(MIX));
            GRID_BAR();
            ph_sb_attn2(ldsl, lnd(PROJ), lnd(MIX));
            ph_lru<true>(ldsl, lnd(PROJ), lnd(conv_w), lnd(conv_b), lnd(LRUW), lnd(lru_b_r), lnd(lru_b_i), lnd(lru_lambda), lnd(LRUSUM), lnd(MIX));
        } else {
            ph_swa2(ldsl, lnd(PROJ), lnd(ROPE), lnd(sinks_c), lnd(MIX));
        }
        GRID_BAR();
        {
            pg8::Gemm g{MIX, layer == 0 ? W_OUTAB : W_OUTC, NTOK, D_MODEL, D_MODEL}; pg8::StaticOrder S; S.init(NTOK, D_MODEL, (int)gridDim.x, bid_opaque());
            EpiF32 E{HOUT, D_MODEL};
            pg8::gemm_phase<EpiF32, pg8::StaticOrder, PG8_ALIGN, PG8_SP2>(ldsl, g, S, E);
        }
        GRID_BAR();
        ph_res_ln<false>(lnd(xin), lnd(HOUT), lnd(ln_mix_g + layer * D_MODEL), lnd(ln_mix_b + layer * D_MODEL), lnd(out), lnd(XNA), (const float*)nullptr, (const float*)nullptr, (int*)nullptr, (float*)nullptr);
        if (layer == 1) ph_convert_experts(ldsl, lnd(exp_w_gate + (size_t)N_EXP * D_MODEL * D_FF), lnd(exp_w_up + (size_t)N_EXP * D_MODEL * D_FF), lnd(exp_w_down + (size_t)N_EXP * D_FF * D_MODEL), lnd(W_GU), lnd(W_DN));
        GRID_BAR();
        ph_route(ldsl, lnd(XNA), lnd(WRT), lnd(b_router), lnd(GATEW), lnd(CTL + CW_CNT + 16 * layer), lnd(LIST));
        GRID_BAR();
        ph_permute(ldsl, lnd(CTL + CW_CNT + 16 * layer), lnd(LIST), lnd(XNA), lnd(XS), lnd(POS));
        GRID_BAR();
        {
            moe_offsets(ldsl, lnd(CTL + CW_CNT + 16 * layer));
            MoeOrder S{(const LAS int*)(ldsl + MISC_OFF + 2048), (int)gridDim.x, bid_opaque()};
            pg8::Gemm g{XS, W_GU, 0, 0, D_MODEL};
            EpiGU E{HB};
            pg8::gemm_phase<EpiGU, MoeOrder, PG8_ALIGN, PG8_SP2>(ldsl, g, S, E);
        }
        GRID_BAR();
        {
            MoeOrder S{(const LAS int*)(ldsl + MISC_OFF + 2048), (int)gridDim.x, bid_opaque()};
            pg8::Gemm g{HB, W_DN, 0, 0, D_FF};
            EpiBf16N E{XS, D_MODEL};
            pg8::gemm_phase<EpiBf16N, MoeOrder, PG8_ALIGN, PG8_SP2>(ldsl, g, S, E);
        }
        GRID_BAR();
        ph_combine_ln(lnd(out), lnd(XS), lnd(POS), lnd(GATEW), lnd(ln_ffn_g + layer * D_MODEL), lnd(ln_ffn_b + layer * D_MODEL), lnd(out), lnd(XNB));
        GRID_BAR();
        {
            pg8::Gemm g{XNB, W_PLEG + (size_t)layer * 1024 * 1024, NTOK, D_MODEL, D_MODEL}; pg8::StaticOrder S; S.init(NTOK, D_MODEL, (int)gridDim.x, bid_opaque());
            EpiPle E{out, PP, XNA, ple_b_gate + layer * D_MODEL};
            pg8::gemm_phase<EpiPle, pg8::StaticOrder, PG8_ALIGN, PG8_SP2>(ldsl, g, S, E);
        }
        if (layer == 0) GRID_BAR();
    }
    if (PROBE) {
        GRID_BAR();
        if (bid_opaque() == 0 && threadIdx.x == 0) {
            const float dA = (float)(TS[PROBE_A + 1] - TS[PROBE_A]) * 0.01f;
            out[0] += dA;
            if (PROBE_B >= 0) out[1] += (float)(TS[PROBE_B + 1] - TS[PROBE_B]) * 0.01f;
        }
    }
}
}

extern "C" void kernel_launch(void* const* d_in, const int* in_sizes, int n_in, void* d_out, int out_size, void* d_ws, size_t ws_size,
                              hipStream_t stream) {
    static int grid_blocks = 0;
    if (grid_blocks == 0) {
        int dev = 0, cus = 0, per_cu = 0;
        (void)hipGetDevice(&dev);
        (void)hipDeviceGetAttribute(&cus, hipDeviceAttributeMultiprocessorCount, dev);
        if (hipFuncSetAttribute((const void*)fwd_megakernel, hipFuncAttributeMaxDynamicSharedMemorySize, LDS_BYTES) != hipSuccess)
            fprintf(stderr, "kernel_launch: hipFuncSetAttribute failed\n");
        if (hipOccupancyMaxActiveBlocksPerMultiprocessor(&per_cu, (const void*)fwd_megakernel, NTHREADS, LDS_BYTES) != hipSuccess || per_cu < 1) {
            fprintf(stderr, "kernel_launch: occupancy query gave %d\n", per_cu);
            per_cu = 1;
        }
        (void)hipGetLastError();
        grid_blocks = cus * 1;
        if (n_in != 27 || ws_size < WS_END) fprintf(stderr, "kernel_launch: unexpected n_in %d / ws %zu\n", n_in, ws_size);
    }
    if (hipMemsetAsync((char*)d_ws + WS_CTL, 0, CTL_ZERO_BYTES, stream) != hipSuccess) fprintf(stderr, "kernel_launch: hipMemsetAsync failed\n");
    Args a{};
    for (int i = 0; i < 27; ++i) a.in[i] = d_in[i];
    a.out = (float*)d_out;
    a.ws = (unsigned char*)d_ws;
    hipLaunchKernelGGL(fwd_megakernel, dim3(grid_blocks), dim3(NTHREADS), LDS_BYTES, stream, a);
    hipError_t e = hipPeekAtLastError();
    if (e != hipSuccess) fprintf(stderr, "launch failed: %s (grid %d)\n", hipGetErrorString(e), grid_blocks);
}
```
